# Optimizing an MI355X kernel written in HIP

```python
import jax
import jax.numpy as jnp
from jax import lax
import numpy as np

D_MODEL = 1024
BATCH = 8
SEQ = 2048
DEPTH = 1
DEC_BATCH = 128
DEC_SEQ = 8
PAST_LEN = 16384
PAGE_SIZE = 128

PLE_DIM = 256
D_CONV = D_MODEL // 2
CONV_WIDTH = 31
N_DN_HEADS = 4
DN_HEAD_DIM = 128
D_DN = N_DN_HEADS * DN_HEAD_DIM
SHORT_CONV = 4
CHUNK = 64
D_MIX = D_CONV + D_DN
D_IN = 3 * D_CONV + 4 * D_DN + 2 * N_DN_HEADS
EPS = 1e-6

kernel_name = 'hymba_conformer_gdn_step'


def rms_norm(x, g):
    xf = x.astype(jnp.float32)
    y = xf * lax.rsqrt(jnp.mean(xf * xf, axis=-1, keepdims=True) + EPS)
    return (y * g.astype(jnp.float32)).astype(x.dtype)


def layer_norm(x, g, b):
    xf = x.astype(jnp.float32)
    xc = xf - jnp.mean(xf, axis=-1, keepdims=True)
    y = xc * lax.rsqrt(jnp.mean(xc * xc, axis=-1, keepdims=True) + EPS)
    return (y * g.astype(jnp.float32) + b.astype(jnp.float32)).astype(x.dtype)


def l2_normalize(x):
    xf = x.astype(jnp.float32)
    return xf * lax.rsqrt(jnp.sum(xf * xf, axis=-1, keepdims=True) + EPS)


def causal_depthwise_conv(x, buf, w):
    width, ch = w.shape
    xc = jnp.concatenate([buf.astype(x.dtype), x], axis=1)
    y = lax.conv_general_dilated(xc, w[:, None, :].astype(x.dtype), window_strides=(1,),
                                 padding='VALID', dimension_numbers=('NWC', 'WIO', 'NWC'),
                                 feature_group_count=ch)
    return y, xc[:, xc.shape[1] - (width - 1):]


def gated_delta_rule(q, k, v, g, beta, s0):
    bsz, seqlen, nh, dk = q.shape
    dv = v.shape[-1]
    c = min(CHUNK, seqlen)
    n = -(-seqlen // c)
    pad = n * c - seqlen

    def blocks(t):
        t = t.astype(jnp.float32)
        t = jnp.pad(t, [(0, 0), (0, pad)] + [(0, 0)] * (t.ndim - 2))
        t = t.reshape((bsz, n, c) + t.shape[2:])
        return jnp.moveaxis(t, 3, 1)

    qb, kb, vb, gb, bb = blocks(q), blocks(k), blocks(v), blocks(g), blocks(beta)
    gc = jnp.cumsum(gb, axis=-1)
    incl = jnp.tril(jnp.ones((c, c), dtype=bool))
    strict = jnp.tril(jnp.ones((c, c), dtype=bool), -1)
    diff = gc[..., :, None] - gc[..., None, :]
    decay = jnp.where(incl, jnp.exp(jnp.where(incl, diff, 0.0)), 0.0)
    k_beta = kb * bb[..., None]
    a_mat = jnp.where(strict, jnp.einsum('bhnid,bhnjd->bhnij', k_beta, kb) * decay, 0.0)
    eye = jnp.broadcast_to(jnp.eye(c, dtype=jnp.float32), a_mat.shape)
    rhs = jnp.concatenate([vb * bb[..., None], k_beta * jnp.exp(gc)[..., None]], axis=-1)
    sol = lax.linalg.triangular_solve(eye + a_mat, rhs, left_side=True, lower=True,
                                      unit_diagonal=True)
    u, w = sol[..., :dv], sol[..., dv:]
    qk = jnp.einsum('bhnid,bhnjd->bhnij', qb, kb) * decay
    q_dec = qb * jnp.exp(gc)[..., None]
    k_dec = kb * jnp.exp(gc[..., -1:] - gc)[..., None]
    g_last = jnp.exp(gc[..., -1])

    def step(s, inp):
        qd, kd, uc, wc, qkc, gl = inp
        v_new = uc - jnp.einsum('bhik,bhkv->bhiv', wc, s)
        o = jnp.einsum('bhik,bhkv->bhiv', qd, s) + jnp.einsum('bhij,bhjv->bhiv', qkc, v_new)
        s = s * gl[..., None, None] + jnp.einsum('bhik,bhiv->bhkv', kd, v_new)
        return s, o

    xs = (jnp.moveaxis(q_dec, 2, 0), jnp.moveaxis(k_dec, 2, 0), jnp.moveaxis(u, 2, 0),
          jnp.moveaxis(w, 2, 0), jnp.moveaxis(qk, 2, 0), jnp.moveaxis(g_last, 2, 0))
    s_final, o = lax.scan(step, s0.astype(jnp.float32), xs)
    o = jnp.moveaxis(o, 0, 2)
    o = jnp.moveaxis(o, 1, 3).reshape(bsz, n * c, nh, dv)[:, :seqlen]
    return o, s_final


def hybrid_layer(x, p_emb, conv_buf, dn_buf, s0, norm_mix_g, w_in, conv_dw_w, conv_dw_b,
                 conv_ln_g, conv_ln_b, conv_pw_w, dn_conv_w, dn_a_log, dn_dt_bias, dn_norm_g,
                 w_out, ple_norm_g, ple_gate_w, ple_proj_w):
    bsz, seqlen, _ = x.shape
    h = rms_norm(x, norm_mix_g)
    proj = h @ w_in
    cuts = [int(i) for i in np.cumsum([D_CONV, D_CONV, D_CONV, 3 * D_DN, D_DN, N_DN_HEADS])]
    glu_a, glu_b, c_gate, qkv, z, b_raw, a_raw = jnp.split(proj, cuts, axis=-1)

    u = glu_a * jax.nn.sigmoid(glu_b)
    c, new_conv_buf = causal_depthwise_conv(u, conv_buf, conv_dw_w)
    c = jax.nn.silu(layer_norm(c + conv_dw_b, conv_ln_g, conv_ln_b))
    c = (c @ conv_pw_w) * jax.nn.silu(c_gate)

    qkv_c, new_dn_buf = causal_depthwise_conv(qkv, dn_buf, dn_conv_w)
    qkv_c = jax.nn.silu(qkv_c)
    q, k, v = jnp.split(qkv_c, 3, axis=-1)
    heads = (bsz, seqlen, N_DN_HEADS, DN_HEAD_DIM)
    q = l2_normalize(q.reshape(heads)) * (DN_HEAD_DIM ** -0.5)
    k = l2_normalize(k.reshape(heads))
    v = v.reshape(heads)
    beta = jax.nn.sigmoid(b_raw.astype(jnp.float32))
    g = -jnp.exp(dn_a_log.astype(jnp.float32)) * jax.nn.softplus(
        a_raw.astype(jnp.float32) + dn_dt_bias.astype(jnp.float32))
    o, s_new = gated_delta_rule(q, k, v, g, beta, s0)
    o = rms_norm(o.astype(x.dtype), dn_norm_g) * jax.nn.silu(z.reshape(heads))

    mix = jnp.concatenate([c, o.reshape(bsz, seqlen, D_DN)], axis=-1) @ w_out
    x = x + mix

    gate = jax.nn.sigmoid(rms_norm(x, ple_norm_g) @ ple_gate_w)
    x = x + gate * (p_emb.astype(x.dtype) @ ple_proj_w)
    return x, new_conv_buf, new_dn_buf, s_new


def setup_inputs(seed: int = 0) -> dict:
    key = jax.random.key(seed)
    ks = jax.random.split(key, 24)
    nrm = lambda k, shape, s: jax.random.normal(k, shape, jnp.float32) * s
    dt = jnp.exp(jax.random.uniform(ks[13], (DEPTH, N_DN_HEADS), jnp.float32,
                                    np.log(1e-3), np.log(1e-1)))
    return {
        'x_prompt': nrm(ks[0], (BATCH, SEQ, D_MODEL), 1.0),
        'x_sample': nrm(ks[1], (DEC_BATCH, DEC_SEQ, D_MODEL), 1.0),
        'state_conv': nrm(ks[2], (DEPTH, DEC_BATCH, CONV_WIDTH - 1, D_CONV), 0.5),
        'state_dn_conv': nrm(ks[3], (DEPTH, DEC_BATCH, SHORT_CONV - 1, 3 * D_DN), 1.0),
        'state_dn_S': nrm(ks[4], (DEPTH, DEC_BATCH, N_DN_HEADS, DN_HEAD_DIM, DN_HEAD_DIM), 0.1),
        'p_prompt': nrm(ks[5], (DEPTH, BATCH, SEQ, PLE_DIM), 1.0),
        'p_sample': nrm(ks[6], (DEPTH, DEC_BATCH, DEC_SEQ, PLE_DIM), 1.0),
        'norm_mix_g': 1.0 + nrm(ks[7], (DEPTH, D_MODEL), 0.02),
        'w_in': nrm(ks[8], (DEPTH, D_MODEL, D_IN), D_MODEL ** -0.5),
        'conv_dw_w': nrm(ks[9], (DEPTH, CONV_WIDTH, D_CONV), CONV_WIDTH ** -0.5),
        'conv_dw_b': nrm(ks[10], (DEPTH, D_CONV), 0.02),
        'conv_ln_g': 1.0 + nrm(ks[11], (DEPTH, D_CONV), 0.02),
        'conv_ln_b': nrm(ks[12], (DEPTH, D_CONV), 0.02),
        'conv_pw_w': nrm(ks[14], (DEPTH, D_CONV, D_CONV), D_CONV ** -0.5),
        'dn_conv_w': nrm(ks[15], (DEPTH, SHORT_CONV, 3 * D_DN), SHORT_CONV ** -0.5),
        'dn_a_log': jnp.log(jax.random.uniform(ks[16], (DEPTH, N_DN_HEADS), jnp.float32, 1.0, 16.0)),
        'dn_dt_bias': dt + jnp.log(-jnp.expm1(-dt)),
        'dn_norm_g': 1.0 + nrm(ks[17], (DEPTH, DN_HEAD_DIM), 0.02),
        'w_out': nrm(ks[18], (DEPTH, D_MIX, D_MODEL), D_MIX ** -0.5),
        'ple_norm_g': 1.0 + nrm(ks[19], (DEPTH, D_MODEL), 0.02),
        'ple_gate_w': nrm(ks[20], (DEPTH, D_MODEL, D_MODEL), D_MODEL ** -0.5),
        'ple_proj_w': nrm(ks[21], (DEPTH, PLE_DIM, D_MODEL), PLE_DIM ** -0.5),
        'final_norm_g': 1.0 + nrm(ks[22], (D_MODEL,), 0.02),
    }


def reference(x_prompt, x_sample, state_conv, state_dn_conv, state_dn_S, p_prompt, p_sample,
              norm_mix_g, w_in, conv_dw_w, conv_dw_b, conv_ln_g, conv_ln_b, conv_pw_w,
              dn_conv_w, dn_a_log, dn_dt_bias, dn_norm_g, w_out, ple_norm_g, ple_gate_w,
              ple_proj_w, final_norm_g):
    xp, xs = x_prompt, x_sample
    bp = x_prompt.shape[0]
    cp, dp, sp, cs, ds, ss = [], [], [], [], [], []
    for i in range(DEPTH):
        lw = (norm_mix_g[i], w_in[i], conv_dw_w[i], conv_dw_b[i], conv_ln_g[i], conv_ln_b[i],
              conv_pw_w[i], dn_conv_w[i], dn_a_log[i], dn_dt_bias[i], dn_norm_g[i], w_out[i],
              ple_norm_g[i], ple_gate_w[i], ple_proj_w[i])
        zc = jnp.zeros((bp, CONV_WIDTH - 1, D_CONV), xp.dtype)
        zd = jnp.zeros((bp, SHORT_CONV - 1, 3 * D_DN), xp.dtype)
        zs = jnp.zeros((bp, N_DN_HEADS, DN_HEAD_DIM, DN_HEAD_DIM), jnp.float32)
        xp, c1, d1, s1 = hybrid_layer(xp, p_prompt[i], zc, zd, zs, *lw)
        xs, c2, d2, s2 = hybrid_layer(xs, p_sample[i], state_conv[i], state_dn_conv[i],
                                      state_dn_S[i], *lw)
        cp.append(c1); dp.append(d1); sp.append(s1)
        cs.append(c2); ds.append(d2); ss.append(s2)
    y_prompt = rms_norm(xp, final_norm_g)
    y_sample = rms_norm(xs, final_norm_g)
    new_conv_prompt = jnp.stack(cp)
    new_dn_conv_prompt = jnp.stack(dp)
    new_S_prompt = jnp.stack(sp)
    new_conv_sample = jnp.stack(cs)
    new_dn_conv_sample = jnp.stack(ds)
    new_S_sample = jnp.stack(ss)
    return (y_prompt, y_sample, new_conv_prompt, new_dn_conv_prompt, new_S_prompt,
            new_conv_sample, new_dn_conv_sample, new_S_sample)
```

```cpp
#include <hip/hip_runtime.h>
#include <hip/hip_bf16.h>
#include <cstdio>
#include <cstdint>

typedef __attribute__((ext_vector_type(8))) short bf16x8;
typedef __attribute__((ext_vector_type(4))) float f32x4;
typedef unsigned short u16;
#ifndef PROBE_DUP
#define PROBE_DUP -1
#endif

constexpr int DM = 1024, NP = 16384, NS = 1024, NT = 17408, SEQ = 2048;
constexpr int DIN = 3592, DPJ = 3584;
constexpr int C_GLUA = 0, C_GLUB = 512, C_GATE = 1024, C_QKV = 1536, C_Z = 3072;
constexpr float EPS = 1e-6f;

constexpr int NF_P = 52, NF_S = 17;
constexpr size_t FRAG_P_BYTES = (size_t)NF_P * 1024, FRAG_S_BYTES = (size_t)NF_S * 1024;
constexpr size_t UF_P_BYTES = 32 * 1024, UF_S_BYTES = 8 * 1024;

constexpr size_t al256(size_t x) { return (x + 255) & ~(size_t)255; }
constexpr size_t WS_X = 0;
constexpr size_t WS_PROJ = WS_X + (size_t)NT * 1024 * 2;
constexpr size_t WS_FRAG = WS_PROJ + (size_t)NT * DPJ * 2;
constexpr size_t FRAG_TOTAL = 1024 * FRAG_P_BYTES + 512 * FRAG_S_BYTES;
constexpr size_t WS_OMIX = WS_FRAG;
constexpr size_t WS_X2B = WS_PROJ;
constexpr size_t WS_PL = WS_FRAG + (size_t)NT * 512 * 2;
constexpr size_t WS_CMIX = WS_FRAG + al256(FRAG_TOTAL);
constexpr size_t WS_WIN = WS_CMIX + (size_t)NT * 512 * 2;
constexpr size_t WS_PW = WS_WIN + (size_t)DPJ * 1024 * 2;
constexpr size_t WS_WOUT = WS_PW + 512 * 512 * 2;
constexpr size_t WS_GATE = WS_WOUT + 1024 * 1024 * 2;
constexpr size_t WS_PPROJ = WS_GATE + 1024 * 1024 * 2;
constexpr size_t WS_R1 = WS_PPROJ + 1024 * 256 * 2;
constexpr size_t WS_AB = WS_R1 + al256((size_t)NT * 4);
constexpr size_t WS_SS2 = WS_AB + (size_t)NT * 8 * 4;
constexpr size_t WS_SS3 = WS_SS2 + al256((size_t)NT * 4);
constexpr size_t WS_GLAST = WS_SS3 + al256((size_t)NT * 4);
constexpr size_t WS_BAR = WS_GLAST + al256(2560 * 4);
constexpr size_t WS_PB2 = WS_BAR + al256(3456 * 4);
constexpr size_t WS_END = WS_PB2 + (size_t)NT * 256 * 2;
constexpr size_t YS_UF = 0;
constexpr size_t YS_CACT = 1024 * UF_P_BYTES + 512 * UF_S_BYTES;
static_assert(YS_CACT + (size_t)NT * 512 * 2 <= (size_t)NT * 1024 * 4, "y scratch overflow");
static_assert(WS_PL + (size_t)NT * 1024 * 2 <= WS_CMIX, "frag alias overflow");

constexpr size_t O_Y = 0;
constexpr size_t O_NCP = (size_t)NT * 1024;
constexpr size_t O_NDP = O_NCP + 8 * 30 * 512;
constexpr size_t O_NSP = O_NDP + 8 * 3 * 1536;
constexpr size_t O_NCS = O_NSP + (size_t)8 * 4 * 128 * 128;
constexpr size_t O_NDS = O_NCS + (size_t)128 * 30 * 512;
constexpr size_t O_NSS = O_NDS + (size_t)128 * 3 * 1536;

struct Params {
  const float *x_prompt, *x_sample, *state_conv, *state_dn_conv, *state_dn_S, *p_prompt, *p_sample;
  const float *norm_mix_g, *w_in, *conv_dw_w, *conv_dw_b, *conv_ln_g, *conv_ln_b, *conv_pw_w;
  const float *dn_conv_w, *dn_a_log, *dn_dt_bias, *dn_norm_g, *w_out, *ple_norm_g, *ple_gate_w, *ple_proj_w, *final_norm_g;
  float* out;
  char* ws;
};

typedef float f32x2_t __attribute__((ext_vector_type(2)));
typedef __bf16 bf16x2_t __attribute__((ext_vector_type(2)));
__device__ __forceinline__ uint32_t pack2(float a, float b) {
  f32x2_t v = {a, b};
  bf16x2_t r = __builtin_convertvector(v, bf16x2_t);
  return __builtin_bit_cast(uint32_t, r);
}
__device__ __forceinline__ u16 f2bf(float f) { return (u16)(pack2(f, f) & 0xffffu); }
__device__ __forceinline__ float bf2f(u16 h) { return __uint_as_float(((uint32_t)h) << 16); }
__device__ __forceinline__ float bflo(uint32_t u) { return __uint_as_float(u << 16); }
__device__ __forceinline__ float bfhi(uint32_t u) { return __uint_as_float(u & 0xffff0000u); }
__device__ __forceinline__ float sigmoidf_(float x) { return __builtin_amdgcn_rcpf(1.f + __expf(-x)); }
__device__ __forceinline__ float siluf_(float x) { return x * __builtin_amdgcn_rcpf(1.f + __expf(-x)); }
__device__ __forceinline__ const float* xrow(const Params& p, int row) {
  return row < NP ? p.x_prompt + (size_t)row * DM : p.x_sample + (size_t)(row - NP) * DM;
}
__device__ __forceinline__ float wave_sum(float v) {
#pragma unroll
  for (int o = 32; o >= 1; o >>= 1) v += __shfl_xor(v, o);
  return v;
}
__device__ __forceinline__ bf16x8 mk8(uint32_t a, uint32_t b, uint32_t c, uint32_t d) {
  union { uint32_t u[4]; bf16x8 v; } t;
  t.u[0] = a; t.u[1] = b; t.u[2] = c; t.u[3] = d;
  return t.v;
}
__device__ __forceinline__ bf16x8 u4_to_b8(uint4 q) { return mk8(q.x, q.y, q.z, q.w); }
#define MFMA(a, b, c) __builtin_amdgcn_mfma_f32_16x16x32_bf16((a), (b), (c), 0, 0, 0)

template <bool DEEP = false, int MH = 4>
__device__ __forceinline__ void gemm128(const u16* __restrict__ A, int lda, const u16* __restrict__ B, int ldb,
                                        int K, char* smem, f32x4 (&acc)[4][4]) {
  const int tid = threadIdx.x, lane = tid & 63, wave = tid >> 6;
  const int wm = wave >> 1, wn = wave & 1, m = lane & 15, g = lane >> 4;
  const int nkt = K >> 6;
  uint4 ra0, ra1, ra2, ra3, rb0, rb1, rb2, rb3;
  uint4 rc0, rc1, rc2, rc3, rd0, rd1, rd2, rd3;
  const int lrow = tid >> 3, lch = tid & 7;
  const u16* gA = A + (size_t)lrow * lda + lch * 8;
  const u16* gB = B + (size_t)lrow * ldb + lch * 8;
  const int soff = lrow * 128 + ((lch ^ (lrow & 7)) << 4);
#define GLOAD(...) GLOAD_I(__VA_ARGS__)
#define SSTORE(...) SSTORE_I(__VA_ARGS__)
#define GLOAD_I(a0_, a1_, a2_, a3_, b0_, b1_, b2_, b3_, kt_)             \
  {                                                                     \
    a0_ = *(const uint4*)(gA + (kt_) * 64);                             \
    a1_ = *(const uint4*)(gA + (size_t)32 * lda + (kt_) * 64);          \
    if (MH == 4) {                                                      \
      a2_ = *(const uint4*)(gA + (size_t)64 * lda + (kt_) * 64);        \
      a3_ = *(const uint4*)(gA + (size_t)96 * lda + (kt_) * 64);        \
    }                                                                   \
    b0_ = *(const uint4*)(gB + (kt_) * 64);                             \
    b1_ = *(const uint4*)(gB + (size_t)32 * ldb + (kt_) * 64);          \
    b2_ = *(const uint4*)(gB + (size_t)64 * ldb + (kt_) * 64);          \
    b3_ = *(const uint4*)(gB + (size_t)96 * ldb + (kt_) * 64);          \
  }
#define SSTORE_I(a0_, a1_, a2_, a3_, b0_, b1_, b2_, b3_, buf_)           \
  {                                                                     \
    char* sa_ = smem + (buf_) * 32768 + soff;                           \
    *(uint4*)(sa_) = a0_;                                               \
    *(uint4*)(sa_ + 4096) = a1_;                                        \
    if (MH == 4) {                                                      \
      *(uint4*)(sa_ + 8192) = a2_;                                      \
      *(uint4*)(sa_ + 12288) = a3_;                                     \
    }                                                                   \
    *(uint4*)(sa_ + 16384) = b0_;                                       \
    *(uint4*)(sa_ + 16384 + 4096) = b1_;                                \
    *(uint4*)(sa_ + 16384 + 8192) = b2_;                                \
    *(uint4*)(sa_ + 16384 + 12288) = b3_;                               \
  }
#define GEMM_COMPUTE(buf_)                                                                   \
  {                                                                                          \
    const char* sa = smem + (buf_) * 32768;                                                  \
    const char* sb = sa + 16384;                                                             \
    _Pragma("unroll") for (int ks = 0; ks < 2; ++ks) {                                       \
      bf16x8 af[4], bfr[4];                                                                  \
      _Pragma("unroll") for (int t = 0; t < 4; ++t) {                                        \
        if (t < MH) {                                                                        \
          int ra_ = wm * (16 * MH) + t * 16 + m;                                             \
          af[t] = *(const bf16x8*)(sa + ra_ * 128 + (((ks * 4 + g) ^ (ra_ & 7)) << 4));      \
        }                                                                                    \
        int rb_ = wn * 64 + t * 16 + m;                                                      \
        bfr[t] = *(const bf16x8*)(sb + rb_ * 128 + (((ks * 4 + g) ^ (rb_ & 7)) << 4));       \
      }                                                                                      \
      _Pragma("unroll") for (int mt = 0; mt < MH; ++mt)                                      \
        _Pragma("unroll") for (int nt = 0; nt < 4; ++nt) acc[mt][nt] = MFMA(bfr[nt], af[mt], acc[mt][nt]); \
    }                                                                                        \
  }
#define SETX ra0, ra1, ra2, ra3, rb0, rb1, rb2, rb3
#define SETY rc0, rc1, rc2, rc3, rd0, rd1, rd2, rd3
  __syncthreads();
  if (DEEP) {
    GLOAD(SETX, 0)
    GLOAD(SETY, 1)
    SSTORE(SETX, 0)
    __syncthreads();
#pragma unroll 1
    for (int kt = 0; kt < nkt; kt += 2) {
      if (kt + 2 < nkt) GLOAD(SETX, kt + 2)
      GEMM_COMPUTE(0)
      SSTORE(SETY, 1)
      __syncthreads();
      if (kt + 3 < nkt) GLOAD(SETY, kt + 3)
      GEMM_COMPUTE(1)
      if (kt + 2 < nkt) SSTORE(SETX, 0)
      __syncthreads();
    }
  } else {
    GLOAD(SETX, 0)
    SSTORE(SETX, 0)
    __syncthreads();
#pragma unroll 1
    for (int kt = 0; kt < nkt; ++kt) {
      if (kt + 1 < nkt) GLOAD(SETX, kt + 1)
      GEMM_COMPUTE(kt & 1)
      if (kt + 1 < nkt) SSTORE(SETX, (kt + 1) & 1)
      __syncthreads();
    }
  }
}
__device__ __forceinline__ void gemm128_pre(const u16* __restrict__ A, int lda, const u16* __restrict__ B, int ldb,
                                        int K, char* smem, f32x4 (&acc)[4][4],
                                            const uint4& q0, const uint4& q1, const uint4& q2, const uint4& q3,
                                            const uint4& q4, const uint4& q5, const uint4& q6, const uint4& q7) {
  constexpr bool DEEP = false; constexpr int MH = 4;
  const int tid = threadIdx.x, lane = tid & 63, wave = tid >> 6;
  const int wm = wave >> 1, wn = wave & 1, m = lane & 15, g = lane >> 4;
  const int nkt = K >> 6;
  uint4 ra0, ra1, ra2, ra3, rb0, rb1, rb2, rb3;
  uint4 rc0, rc1, rc2, rc3, rd0, rd1, rd2, rd3;
  const int lrow = tid >> 3, lch = tid & 7;
  const u16* gA = A + (size_t)lrow * lda + lch * 8;
  const u16* gB = B + (size_t)lrow * ldb + lch * 8;
  const int soff = lrow * 128 + ((lch ^ (lrow & 7)) << 4);
#define GLOAD(...) GLOAD_I(__VA_ARGS__)
#define SSTORE(...) SSTORE_I(__VA_ARGS__)
#define GLOAD_I(a0_, a1_, a2_, a3_, b0_, b1_, b2_, b3_, kt_)             \
  {                                                                     \
    a0_ = *(const uint4*)(gA + (kt_) * 64);                             \
    a1_ = *(const uint4*)(gA + (size_t)32 * lda + (kt_) * 64);          \
    if (MH == 4) {                                                      \
      a2_ = *(const uint4*)(gA + (size_t)64 * lda + (kt_) * 64);        \
      a3_ = *(const uint4*)(gA + (size_t)96 * lda + (kt_) * 64);        \
    }                                                                   \
    b0_ = *(const uint4*)(gB + (kt_) * 64);                             \
    b1_ = *(const uint4*)(gB + (size_t)32 * ldb + (kt_) * 64);          \
    b2_ = *(const uint4*)(gB + (size_t)64 * ldb + (kt_) * 64);          \
    b3_ = *(const uint4*)(gB + (size_t)96 * ldb + (kt_) * 64);          \
  }
#define SSTORE_I(a0_, a1_, a2_, a3_, b0_, b1_, b2_, b3_, buf_)           \
  {                                                                     \
    char* sa_ = smem + (buf_) * 32768 + soff;                           \
    *(uint4*)(sa_) = a0_;                                               \
    *(uint4*)(sa_ + 4096) = a1_;                                        \
    if (MH == 4) {                                                      \
      *(uint4*)(sa_ + 8192) = a2_;                                      \
      *(uint4*)(sa_ + 12288) = a3_;                                     \
    }                                                                   \
    *(uint4*)(sa_ + 16384) = b0_;                                       \
    *(uint4*)(sa_ + 16384 + 4096) = b1_;                                \
    *(uint4*)(sa_ + 16384 + 8192) = b2_;                                \
    *(uint4*)(sa_ + 16384 + 12288) = b3_;                               \
  }
#define GEMM_COMPUTE(buf_)                                                                   \
  {                                                                                          \
    const char* sa = smem + (buf_) * 32768;                                                  \
    const char* sb = sa + 16384;                                                             \
    _Pragma("unroll") for (int ks = 0; ks < 2; ++ks) {                                       \
      bf16x8 af[4], bfr[4];                                                                  \
      _Pragma("unroll") for (int t = 0; t < 4; ++t) {                                        \
        if (t < MH) {                                                                        \
          int ra_ = wm * (16 * MH) + t * 16 + m;                                             \
          af[t] = *(const bf16x8*)(sa + ra_ * 128 + (((ks * 4 + g) ^ (ra_ & 7)) << 4));      \
        }                                                                                    \
        int rb_ = wn * 64 + t * 16 + m;                                                      \
        bfr[t] = *(const bf16x8*)(sb + rb_ * 128 + (((ks * 4 + g) ^ (rb_ & 7)) << 4));       \
      }                                                                                      \
      _Pragma("unroll") for (int mt = 0; mt < MH; ++mt)                                      \
        _Pragma("unroll") for (int nt = 0; nt < 4; ++nt) acc[mt][nt] = MFMA(bfr[nt], af[mt], acc[mt][nt]); \
    }                                                                                        \
  }
#define SETX ra0, ra1, ra2, ra3, rb0, rb1, rb2, rb3
#define SETY rc0, rc1, rc2, rc3, rd0, rd1, rd2, rd3
  __syncthreads();
  if (DEEP) {
    GLOAD(SETX, 0)
    GLOAD(SETY, 1)
    SSTORE(SETX, 0)
    __syncthreads();
#pragma unroll 1
    for (int kt = 0; kt < nkt; kt += 2) {
      if (kt + 2 < nkt) GLOAD(SETX, kt + 2)
      GEMM_COMPUTE(0)
      SSTORE(SETY, 1)
      __syncthreads();
      if (kt + 3 < nkt) GLOAD(SETY, kt + 3)
      GEMM_COMPUTE(1)
      if (kt + 2 < nkt) SSTORE(SETX, 0)
      __syncthreads();
    }
  } else {
    ra0 = q0; ra1 = q1; ra2 = q2; ra3 = q3; rb0 = q4; rb1 = q5; rb2 = q6; rb3 = q7;
    SSTORE(SETX, 0)
    __syncthreads();
#pragma unroll 1
    for (int kt = 0; kt < nkt; ++kt) {
      if (kt + 1 < nkt) GLOAD(SETX, kt + 1)
      GEMM_COMPUTE(kt & 1)
      if (kt + 1 < nkt) SSTORE(SETX, (kt + 1) & 1)
      __syncthreads();
    }
  }
}
#define GEMM_EPILOGUE_M(acc, m0, n0, MH_, ...)                                             \
  {                                                                                        \
    const int lane_ = threadIdx.x & 63, wave_ = threadIdx.x >> 6;                          \
    const int wm_ = wave_ >> 1, wn_ = wave_ & 1, m_ = lane_ & 15, g_ = lane_ >> 4;         \
    _Pragma("unroll") for (int mt = 0; mt < (MH_); ++mt) {                                 \
      const int row = (m0) + wm_ * (16 * (MH_)) + mt * 16 + m_;                            \
      _Pragma("unroll") for (int nt = 0; nt < 4; ++nt) {                                   \
        const int col = (n0) + wn_ * 64 + nt * 16 + g_ * 4;                                \
        f32x4 v = acc[mt][nt];                                                             \
        __VA_ARGS__                                                                        \
      }                                                                                    \
    }                                                                                      \
  }
#define GEMM_EPILOGUE(acc, m0, n0, ...) GEMM_EPILOGUE_M(acc, m0, n0, 4, __VA_ARGS__)

__device__ __forceinline__ void transpose_tile(const float* __restrict__ src, int lds_, const float* __restrict__ gv, u16* __restrict__ dst,
                               int ldd, int k0, int n0, char* smem) {
  float* t = (float*)smem;
  const int tid = threadIdx.x;
  __syncthreads();
#pragma unroll
  for (int it = 0; it < 4; ++it) {
    int k = (tid >> 4) + it * 16, n = (tid & 15) * 4;
    float4 v = *(const float4*)(src + (size_t)(k0 + k) * lds_ + n0 + n);
    float gg = gv ? gv[k0 + k] : 1.f;
    t[k * 65 + n + 0] = v.x * gg; t[k * 65 + n + 1] = v.y * gg; t[k * 65 + n + 2] = v.z * gg; t[k * 65 + n + 3] = v.w * gg;
  }
  __syncthreads();
#pragma unroll
  for (int it = 0; it < 2; ++it) {
    int n = (tid >> 3) + it * 32, kc = (tid & 7) * 8;
    uint32_t w[4];
#pragma unroll
    for (int e = 0; e < 4; ++e) w[e] = pack2(t[(kc + 2 * e) * 65 + n], t[(kc + 2 * e + 1) * 65 + n]);
    *(uint4*)(dst + (size_t)(n0 + n) * ldd + k0 + kc) = make_uint4(w[0], w[1], w[2], w[3]);
  }
}

__device__ __forceinline__ void phase0(const Params& p, int bid, int nb, char* smem) {
  const int tid = threadIdx.x, lane = tid & 63, wave = tid >> 6;
  u16* xb = (u16*)(p.ws + WS_X);
  float* r1 = (float*)(p.ws + WS_R1);
  float* ab = (float*)(p.ws + WS_AB);
  float* ss2 = (float*)(p.ws + WS_SS2);
  float* ss3 = (float*)(p.ws + WS_SS3);
  for (int i = bid * 256 + tid; i < NT; i += nb * 256) { ss2[i] = 0.f; ss3[i] = 0.f; }
  {
    u16* pb = (u16*)(p.ws + WS_PB2);
  for (int i = bid * 256 + tid; i < NT * 32; i += nb * 256) {
    int row = i >> 5, c = (i & 31) * 8;
    const float* pr = row < NP ? p.p_prompt + (size_t)row * 256 : p.p_sample + (size_t)(row - NP) * 256;
    float4 a = *(const float4*)(pr + c), bq = *(const float4*)(pr + c + 4);
    *(uint4*)(pb + (size_t)row * 256 + c) = make_uint4(pack2(a.x, a.y), pack2(a.z, a.w), pack2(bq.x, bq.y), pack2(bq.z, bq.w));
  }
  }
  for (int it = bid; it < 1536; it += nb) {
    if (it < 896) { int kt = it / 56, nt = it % 56; transpose_tile(p.w_in, DIN, p.norm_mix_g, (u16*)(p.ws + WS_WIN), 1024, kt * 64, nt * 64, smem); }
    else if (it < 960) { int j = it - 896; transpose_tile(p.conv_pw_w, 512, nullptr, (u16*)(p.ws + WS_PW), 512, (j >> 3) * 64, (j & 7) * 64, smem); }
    else if (it < 1216) { int j = it - 960; transpose_tile(p.w_out, 1024, nullptr, (u16*)(p.ws + WS_WOUT), 1024, (j >> 4) * 64, (j & 15) * 64, smem); }
    else if (it < 1472) { int j = it - 1216; transpose_tile(p.ple_gate_w, 1024, p.ple_norm_g, (u16*)(p.ws + WS_GATE), 1024, (j >> 4) * 64, (j & 15) * 64, smem); }
    else { int j = it - 1472; transpose_tile(p.ple_proj_w, 1024, nullptr, (u16*)(p.ws + WS_PPROJ), 256, (j >> 4) * 64, (j & 15) * 64, smem); }
  }
  float* tl = (float*)smem;
  __syncthreads();
#pragma unroll
  for (int it = 0; it < 4; ++it) {
    int k = tid + it * 256;
    const float4* wt = (const float4*)(p.w_in + (size_t)k * DIN + DPJ);
    float4 w0 = wt[0], w1 = wt[1];
    float gg = p.norm_mix_g[k];
    tl[0 * 1024 + k] = w0.x * gg; tl[1 * 1024 + k] = w0.y * gg; tl[2 * 1024 + k] = w0.z * gg; tl[3 * 1024 + k] = w0.w * gg;
    tl[4 * 1024 + k] = w1.x * gg; tl[5 * 1024 + k] = w1.y * gg; tl[6 * 1024 + k] = w1.z * gg; tl[7 * 1024 + k] = w1.w * gg;
  }
  __syncthreads();
  for (int row = bid * 4 + wave; row < NT; row += nb * 4) {
    const float* xr = xrow(p, row);
    float ss = 0.f;
    float d[8] = {0, 0, 0, 0, 0, 0, 0, 0};
#pragma unroll
    for (int it = 0; it < 4; ++it) {
      int k = it * 256 + lane * 4;
      float4 v = *(const float4*)(xr + k);
      ss += v.x * v.x + v.y * v.y + v.z * v.z + v.w * v.w;
      *(uint2*)(xb + (size_t)row * 1024 + k) = make_uint2(pack2(v.x, v.y), pack2(v.z, v.w));
#pragma unroll
      for (int j = 0; j < 8; ++j) {
        float4 w = *(const float4*)(tl + j * 1024 + k);
        d[j] += v.x * w.x + v.y * w.y + v.z * w.z + v.w * w.w;
      }
    }
    ss = wave_sum(ss);
#pragma unroll
    for (int j = 0; j < 8; ++j) d[j] = wave_sum(d[j]);
    float r = rsqrtf(ss * (1.f / 1024.f) + EPS);
    if (lane == 0) {
      r1[row] = r;
      *(float4*)(ab + (size_t)row * 8) = make_float4(d[0] * r, d[1] * r, d[2] * r, d[3] * r);
      *(float4*)(ab + (size_t)row * 8 + 4) = make_float4(d[4] * r, d[5] * r, d[6] * r, d[7] * r);
    }
  }
}

struct TileWalk { int q, step, total, mbase, nN; bool banded; };
__device__ __forceinline__ TileWalk tile_walk(int nN, int bid, int nb) {
  TileWalk w; w.nN = nN;
  if ((nb & 7) == 0) { w.banded = true; w.q = bid >> 3; w.step = nb >> 3; w.total = 17 * nN; w.mbase = 17 * (bid & 7); }
  else { w.banded = false; w.q = bid; w.step = nb; w.total = 136 * nN; w.mbase = 0; }
  return w;
}
__device__ __forceinline__ void tile_get(const TileWalk& w, int q, int& mt, int& nt) {
  if (w.banded) {
    if (q < 9 * w.nN) { mt = w.mbase + q % 9; nt = q / 9; }
    else { int q2 = q - 9 * w.nN; mt = w.mbase + 9 + (q2 & 7); nt = q2 >> 3; }
  } else { mt = q / w.nN; nt = q % w.nN; }
}
__device__ __forceinline__ void phase1(const Params& p, int bid, int nb, char* smem) {
  const u16* xb = (const u16*)(p.ws + WS_X);
  const u16* wt = (const u16*)(p.ws + WS_WIN);
  const float* r1 = (const float*)(p.ws + WS_R1);
  u16* proj = (u16*)(p.ws + WS_PROJ);
  const TileWalk tw = tile_walk(28, bid, nb);
  const int lrow = threadIdx.x >> 3, lch = threadIdx.x & 7;
  uint4 q0, q1, q2, q3, q4, q5, q6, q7;
#define G1_PRELOAD(m0_, n0_)                                                              \
  {                                                                                       \
    const u16* ga_ = xb + (size_t)((m0_) + lrow) * 1024 + lch * 8;                        \
    const u16* gb_ = wt + (size_t)((n0_) + lrow) * 1024 + lch * 8;                        \
    q0 = *(const uint4*)(ga_);             q1 = *(const uint4*)(ga_ + 32 * 1024);         \
    q2 = *(const uint4*)(ga_ + 64 * 1024); q3 = *(const uint4*)(ga_ + 96 * 1024);         \
    q4 = *(const uint4*)(gb_);             q5 = *(const uint4*)(gb_ + 32 * 1024);         \
    q6 = *(const uint4*)(gb_ + 64 * 1024); q7 = *(const uint4*)(gb_ + 96 * 1024);         \
  }
  int t = tw.q;
  if (t < tw.total) {
    int mt_, nt_;
    tile_get(tw, t, mt_, nt_);
    G1_PRELOAD(mt_ * 128, nt_ * 128)
  }
#pragma unroll 1
  for (; t < tw.total; t += tw.step) {
    int mt_, nt_;
    tile_get(tw, t, mt_, nt_);
    const int m0 = mt_ * 128, n0 = nt_ * 128;
    f32x4 acc[4][4];
#pragma unroll
    for (int i = 0; i < 4; ++i)
#pragma unroll
      for (int j = 0; j < 4; ++j) acc[i][j] = f32x4{0, 0, 0, 0};
    gemm128_pre(xb + (size_t)m0 * 1024, 1024, wt + (size_t)n0 * 1024, 1024, 1024, smem, acc, q0, q1, q2, q3, q4, q5, q6, q7);
    float rpre[4];
    GEMM_EPILOGUE(acc, m0, n0, { (void)v; if (nt == 0) rpre[mt] = r1[row]; })
    if (t + tw.step < tw.total) {
      int mt2, nt2;
      tile_get(tw, t + tw.step, mt2, nt2);
      G1_PRELOAD(mt2 * 128, nt2 * 128)
    }
    GEMM_EPILOGUE(acc, m0, n0, {
      const float r = rpre[mt];
      *(uint2*)(proj + (size_t)row * DPJ + col) = make_uint2(pack2(v[0] * r, v[1] * r), pack2(v[2] * r, v[3] * r));
    })
  }
}

template <bool SAMPLE>
__device__ __forceinline__ void conv_tile(const Params& p, int item, char* smem) {
  constexpr int NTK = SAMPLE ? 8 : 32;
  const int tid = threadIdx.x, lane = tid & 63, wave = tid >> 6;
  const u16* proj = (const u16*)(p.ws + WS_PROJ);
  u16* cact = (u16*)((char*)p.out + YS_CACT);
  int b, pos0, row0;
  if (SAMPLE) { b = item; pos0 = 0; row0 = NP + b * 8; }
  else { b = item >> 6; pos0 = (item & 63) * 32; row0 = b * SEQ + pos0; }
  float* Y = (float*)smem;
  const float* cw_ = p.conv_dw_w;
  const float* lng_ = p.conv_ln_g;
  const float* lnb_ = p.conv_ln_b;
  const float* cb_ = p.conv_dw_b;
  asm volatile("" : "+s"(cw_), "+s"(lng_), "+s"(lnb_), "+s"(cb_));
  const bool write_tail = SAMPLE || ((item & 63) == 63);
  constexpr int NR = NTK + 30, GR = 16, NG = (NR + GR - 1) / GR;
  __syncthreads();
#pragma unroll 1
  for (int cp = 0; cp < 2; ++cp) {
    const int c0 = tid + cp * 256;
    float w0[31];
#pragma unroll
    for (int j = 0; j < 31; ++j) w0[j] = cw_[j * 512 + c0];
    float a0[NTK];
#pragma unroll
    for (int t = 0; t < NTK; ++t) a0[t] = 0.f;
    uint32_t ca[GR], cb[GR], na[GR], nb2[GR];
#define CONV_LOAD(r_, A_, B_)                                                                   \
  {                                                                                             \
    A_ = 0; B_ = 0;                                                                             \
    if ((r_) < NR) {                                                                            \
      if (SAMPLE && (r_) < 30) {                                                                \
        A_ = __float_as_uint(p.state_conv[((size_t)b * 30 + (r_)) * 512 + c0]);                 \
      } else {                                                                                  \
        int pos_ = pos0 - 30 + (r_);                                                            \
        int pc_ = pos_ < 0 ? 0 : pos_;                                                          \
        size_t prow_ = SAMPLE ? (size_t)(row0 + (r_) - 30) : (size_t)(b * SEQ + pc_);           \
        uint32_t la_ = proj[prow_ * DPJ + C_GLUA + c0];                                         \
        uint32_t lb_ = proj[prow_ * DPJ + C_GLUB + c0];                                         \
        A_ = (!SAMPLE && pos_ < 0) ? 0u : la_;                                                  \
        B_ = (!SAMPLE && pos_ < 0) ? 0u : lb_;                                                  \
      }                                                                                         \
    }                                                                                           \
  }
#pragma unroll
    for (int rr = 0; rr < GR; ++rr) CONV_LOAD(rr, ca[rr], cb[rr])
#pragma unroll
    for (int gq = 0; gq < NG; ++gq) {
      if (gq + 1 < NG) {
#pragma unroll
        for (int rr = 0; rr < GR; ++rr) CONV_LOAD((gq + 1) * GR + rr, na[rr], nb2[rr])
      }
#pragma unroll
      for (int rr = 0; rr < GR; ++rr) {
        const int r = gq * GR + rr;
        if (r < NR) {
          float u0;
          if (SAMPLE && r < 30) u0 = __uint_as_float(ca[rr]);
          else u0 = bf2f((u16)ca[rr]) * sigmoidf_(bf2f((u16)cb[rr]));
          if (SAMPLE) {
            if (r >= 8) p.out[O_NCS + ((size_t)b * 30 + (r - 8)) * 512 + c0] = u0;
          } else {
            if (write_tail && r >= 32) p.out[O_NCP + ((size_t)b * 30 + (r - 32)) * 512 + c0] = u0;
          }
#pragma unroll
          for (int t = 0; t < NTK; ++t) {
            if (r - t >= 0 && r - t <= 30) a0[t] += w0[r - t] * u0;
          }
        }
      }
#pragma unroll
      for (int rr = 0; rr < GR; ++rr) { ca[rr] = na[rr]; cb[rr] = nb2[rr]; }
      __builtin_amdgcn_sched_barrier(0);
    }
    const float bias = cb_[c0];
#pragma unroll
    for (int t = 0; t < NTK; ++t) Y[t * 512 + c0] = a0[t] + bias;
  }
  __syncthreads();
  for (int t = wave; t < NTK; t += 4) {
    float4 v0 = *(const float4*)(Y + t * 512 + lane * 8);
    float4 v1 = *(const float4*)(Y + t * 512 + lane * 8 + 4);
    float xv[8] = {v0.x, v0.y, v0.z, v0.w, v1.x, v1.y, v1.z, v1.w};
    float s = 0.f;
#pragma unroll
    for (int e = 0; e < 8; ++e) s += xv[e];
    float mean = wave_sum(s) * (1.f / 512.f);
    float q = 0.f;
#pragma unroll
    for (int e = 0; e < 8; ++e) { xv[e] -= mean; q += xv[e] * xv[e]; }
    float rstd = rsqrtf(wave_sum(q) * (1.f / 512.f) + EPS);
    float4 g0 = *(const float4*)(lng_ + lane * 8), g1 = *(const float4*)(lng_ + lane * 8 + 4);
    float4 b0 = *(const float4*)(lnb_ + lane * 8), b1 = *(const float4*)(lnb_ + lane * 8 + 4);
    float gg[8] = {g0.x, g0.y, g0.z, g0.w, g1.x, g1.y, g1.z, g1.w};
    float bb[8] = {b0.x, b0.y, b0.z, b0.w, b1.x, b1.y, b1.z, b1.w};
    float o[8];
#pragma unroll
    for (int e = 0; e < 8; ++e) o[e] = siluf_(xv[e] * rstd * gg[e] + bb[e]);
    *(uint4*)(cact + (size_t)(row0 + t) * 512 + lane * 8) =
        make_uint4(pack2(o[0], o[1]), pack2(o[2], o[3]), pack2(o[4], o[5]), pack2(o[6], o[7]));
  }
}

template <bool SAMPLE> __device__ __forceinline__ constexpr int fidx_w(int mt, int ks) { return SAMPLE ? ks : (mt >> 1) * 26 + (mt & 1) * 4 + ks; }
template <bool SAMPLE> __device__ __forceinline__ constexpr int fidx_q(int mt, int ks) { return SAMPLE ? 4 + ks : (mt >> 1) * 26 + 8 + (mt & 1) * 4 + ks; }
template <bool SAMPLE> __device__ __forceinline__ constexpr int fidx_qk(int mt) { return SAMPLE ? 8 : (mt >> 1) * 26 + 16 + (mt & 1); }
template <bool SAMPLE> __device__ __forceinline__ constexpr int fidx_kd(int dt, int hf) { return SAMPLE ? 9 + dt : hf * 26 + 18 + dt; }

template <bool SAMPLE>
__device__ __forceinline__ void delta_prep(const Params& p, int item, char* smem) {
  constexpr int MT = SAMPLE ? 1 : 4, KS2 = SAMPLE ? 1 : 2, NI = SAMPLE ? 8 : 64;
  const int tid = threadIdx.x, lane = tid & 63, wave = tid >> 6, m = lane & 15, g = lane >> 4;
  const u16* proj = (const u16*)(p.ws + WS_PROJ);
  const float* ab = (const float*)(p.ws + WS_AB);
  int b, h, row0, pos0, chunk;
  uint4* fa; float4* uf;
  if (SAMPLE) {
    b = item >> 2; h = item & 3; row0 = NP + b * 8; pos0 = 0; chunk = 1024 + item;
    fa = (uint4*)(p.ws + WS_FRAG + 1024 * FRAG_P_BYTES + (size_t)item * FRAG_S_BYTES);
    uf = (float4*)((char*)p.out + YS_UF + 1024 * UF_P_BYTES + (size_t)item * UF_S_BYTES);
  } else {
    int bh = item >> 5, n = item & 31; b = bh >> 2; h = bh & 3; pos0 = n * 64; row0 = b * SEQ + pos0; chunk = item;
    fa = (uint4*)(p.ws + WS_FRAG + (size_t)item * FRAG_P_BYTES);
    uf = (float4*)((char*)p.out + YS_UF + (size_t)item * UF_P_BYTES);
  }
  u16* KN = (u16*)smem;
  u16* QN = KN + 64 * 136;
  float* AM = (float*)(QN + 64 * 136);
  float* gcs = AM + 64 * 64;
  float* bts = gcs + 64;
  __syncthreads();
  if (wave == 0) {
    int i = lane; float gi = 0.f, bi = 0.f;
    if (i < NI) {
      const float* abr = ab + (size_t)(row0 + i) * 8;
      bi = sigmoidf_(abr[h]);
      float a = abr[4 + h] + p.dn_dt_bias[h];
      float sp = a > 20.f ? a : log1pf(expf(a));
      gi = -expf(p.dn_a_log[h]) * sp;
    }
    float c = gi;
#pragma unroll
    for (int off = 1; off < 64; off <<= 1) { float t = __shfl_up(c, off); if (lane >= off) c += t; }
    if (!SAMPLE) { float c31 = __shfl(c, 31); if (lane >= 32) c -= c31; }
    gcs[i] = c; bts[i] = bi;
  }
  __syncthreads();
  {
    const int sec = tid >> 7, c = tid & 127;
    const int col = sec * 512 + h * 128 + c;
    u16* dstm = sec ? KN : QN;
    const float w0 = p.dn_conv_w[col], w1 = p.dn_conv_w[1536 + col], w2 = p.dn_conv_w[2 * 1536 + col], w3 = p.dn_conv_w[3 * 1536 + col];
    float rr[3];
#pragma unroll
    for (int jj = 0; jj < 3; ++jj) {
      if (SAMPLE) rr[jj] = p.state_dn_conv[((size_t)b * 3 + jj) * 1536 + col];
      else rr[jj] = (pos0 > 0) ? bf2f(proj[(size_t)(row0 - 3 + jj) * DPJ + C_QKV + col]) : 0.f;
    }
    float ra = rr[0], rb = rr[1], rc = rr[2];
    const u16* pcol = proj + (size_t)row0 * DPJ + C_QKV + col;
    u16 raw[NI];
#pragma unroll
    for (int i = 0; i < NI; ++i) raw[i] = pcol[(size_t)i * DPJ];
#pragma unroll
    for (int i = 0; i < NI; ++i) {
      float rd = bf2f(raw[i]);
      float v = siluf_(w0 * ra + w1 * rb + w2 * rc + w3 * rd);
      dstm[i * 136 + c] = f2bf(v);
      ra = rb; rb = rc; rc = rd;
    }
#pragma unroll
    for (int i = NI; i < 64; ++i) dstm[i * 136 + c] = 0;
  }
  __syncthreads();
  {
    const int i = wave * 16 + m;
    const bool valid = i < NI;
    float eq[32], ek[32];
#pragma unroll
    for (int kh = 0; kh < 8; ++kh) {
      const int cc = (kh >> 1) * 32 + (kh & 1) * 16 + 4 * g;
      uint2 kv = *(const uint2*)(KN + i * 136 + cc);
      uint2 qv = *(const uint2*)(QN + i * 136 + cc);
      ek[kh * 4] = bflo(kv.x); ek[kh * 4 + 1] = bfhi(kv.x); ek[kh * 4 + 2] = bflo(kv.y); ek[kh * 4 + 3] = bfhi(kv.y);
      eq[kh * 4] = bflo(qv.x); eq[kh * 4 + 1] = bfhi(qv.x); eq[kh * 4 + 2] = bflo(qv.y); eq[kh * 4 + 3] = bfhi(qv.y);
    }
    float sq = 0.f, sk = 0.f;
#pragma unroll
    for (int e = 0; e < 32; ++e) { sq += eq[e] * eq[e]; sk += ek[e] * ek[e]; }
    sq += __shfl_xor(sq, 16); sq += __shfl_xor(sq, 32);
    sk += __shfl_xor(sk, 16); sk += __shfl_xor(sk, 32);
    const float rq = valid ? rsqrtf(sq + EPS) * 0.08838834764831845f : 0.f;
    const float rk = valid ? rsqrtf(sk + EPS) : 0.f;
#pragma unroll
    for (int e = 0; e < 32; ++e) { eq[e] *= rq; ek[e] *= rk; }
#pragma unroll
    for (int kh = 0; kh < 8; ++kh) {
      const int cc = (kh >> 1) * 32 + (kh & 1) * 16 + 4 * g;
      *(uint2*)(KN + i * 136 + cc) = make_uint2(pack2(ek[kh * 4], ek[kh * 4 + 1]), pack2(ek[kh * 4 + 2], ek[kh * 4 + 3]));
      *(uint2*)(QN + i * 136 + cc) = make_uint2(pack2(eq[kh * 4], eq[kh * 4 + 1]), pack2(eq[kh * 4 + 2], eq[kh * 4 + 3]));
    }
    if (wave < MT) {
      const float ei = __expf(gcs[i]);
#pragma unroll
      for (int ks = 0; ks < 4; ++ks) {
        const int e0 = ks * 8;
        fa[fidx_q<SAMPLE>(wave, ks) * 64 + lane] =
            make_uint4(pack2(eq[e0] * ei, eq[e0 + 1] * ei), pack2(eq[e0 + 2] * ei, eq[e0 + 3] * ei),
                       pack2(eq[e0 + 4] * ei, eq[e0 + 5] * ei), pack2(eq[e0 + 6] * ei, eq[e0 + 7] * ei));
      }
    }
  }
  __syncthreads();
  if (wave < MT) {
    const int it = wave;
    bf16x8 knI[4], qnI[4];
#pragma unroll
    for (int ks = 0; ks < 4; ++ks) {
      knI[ks] = *(const bf16x8*)(KN + (16 * it + m) * 136 + 32 * ks + 8 * g);
      qnI[ks] = *(const bf16x8*)(QN + (16 * it + m) * 136 + 32 * ks + 8 * g);
    }
    f32x4 qkv_[4];
#pragma unroll
    for (int jt = 0; jt < 4; ++jt) qkv_[jt] = f32x4{0, 0, 0, 0};
    const float gi_n = gcs[16 * it + m];
#pragma unroll
    for (int jt = 0; jt < 4; ++jt) {
      if (jt <= it && (SAMPLE || (jt >> 1) == (it >> 1))) {
        bf16x8 knJ[4];
#pragma unroll
        for (int ks = 0; ks < 4; ++ks) knJ[ks] = *(const bf16x8*)(KN + (16 * jt + m) * 136 + 32 * ks + 8 * g);
        f32x4 aa = f32x4{0, 0, 0, 0}, qq = f32x4{0, 0, 0, 0};
#pragma unroll
        for (int ks = 0; ks < 4; ++ks) { aa = MFMA(knI[ks], knJ[ks], aa); qq = MFMA(knJ[ks], qnI[ks], qq); }
        const int jA = 16 * jt + m;
        const float gj = gcs[jA];
#pragma unroll
        for (int r = 0; r < 4; ++r) {
          const int iA = 16 * it + 4 * g + r;
          float val = (jA < iA) ? bts[iA] * __expf(gcs[iA] - gj) * aa[r] : 0.f;
          AM[iA * 64 + jA] = val;
        }
        const int iQ = 16 * it + m;
#pragma unroll
        for (int r = 0; r < 4; ++r) {
          const int jQ = 16 * jt + 4 * g + r;
          qkv_[jt][r] = (jQ <= iQ) ? __expf(gi_n - gcs[jQ]) * qq[r] : 0.f;
        }
      }
    }
    {
      const bool up = !SAMPLE && (it >> 1);
      f32x4 lo = up ? qkv_[2] : qkv_[0], hi = up ? qkv_[3] : qkv_[1];
      fa[fidx_qk<SAMPLE>(it) * 64 + lane] =
          make_uint4(pack2(lo[0], lo[1]), pack2(lo[2], lo[3]), pack2(hi[0], hi[1]), pack2(hi[2], hi[3]));
    }
  }
  {
#pragma unroll
    for (int dd = 0; dd < 2; ++dd) {
      const int dt = 2 * wave + dd;
#pragma unroll
      for (int hf = 0; hf < KS2; ++hf) {
        const float gl = gcs[SAMPLE ? 63 : 32 * hf + 31];
        float vv[8];
#pragma unroll
        for (int e = 0; e < 8; ++e) {
          const int i = 32 * hf + (e >> 2) * 16 + 4 * g + (e & 3);
          vv[e] = bf2f(KN[i * 136 + 16 * dt + m]) * __expf(gl - gcs[i]);
        }
        fa[fidx_kd<SAMPLE>(dt, hf) * 64 + lane] =
            make_uint4(pack2(vv[0], vv[1]), pack2(vv[2], vv[3]), pack2(vv[4], vv[5]), pack2(vv[6], vv[7]));
      }
    }
    if (tid == 0) {
      float* gla = (float*)(p.ws + WS_GLAST);
      if (SAMPLE) gla[2048 + item] = __expf(gcs[63]);
      else { gla[2 * item] = __expf(gcs[31]); gla[2 * item + 1] = __expf(gcs[63]); }
    }
  }
  __syncthreads();
  float x[NI];
  {
  if (tid < 128) {
    const int dv = tid;
    const int col = 1024 + h * 128 + dv;
    const float w0 = p.dn_conv_w[col], w1 = p.dn_conv_w[1536 + col], w2 = p.dn_conv_w[2 * 1536 + col], w3 = p.dn_conv_w[3 * 1536 + col];
    float rr[3];
#pragma unroll
    for (int jj = 0; jj < 3; ++jj) {
      if (SAMPLE) rr[jj] = p.state_dn_conv[((size_t)b * 3 + jj) * 1536 + col];
      else rr[jj] = (pos0 > 0) ? bf2f(proj[(size_t)(row0 - 3 + jj) * DPJ + C_QKV + col]) : 0.f;
    }
    float ra = rr[0], rb = rr[1], rc = rr[2];
    const u16* pcol = proj + (size_t)row0 * DPJ + C_QKV + col;
#pragma unroll
    for (int i = 0; i < NI; ++i) x[i] = bf2f(pcol[(size_t)i * DPJ]);
    __builtin_amdgcn_sched_barrier(0);
#pragma unroll
    for (int i = 0; i < NI; ++i) {
      float rd = x[i];
      float v = siluf_(w0 * ra + w1 * rb + w2 * rc + w3 * rd);
      x[i] = bts[i] * v;
      ra = rb; rb = rc; rc = rd;
    }
  } else {
    const int dk = tid - 128;
#pragma unroll
    for (int i = 0; i < NI; ++i) x[i] = bts[i] * __expf(gcs[i]) * bf2f(KN[i * 136 + dk]);
  }
  {
    constexpr int NSUB = SAMPLE ? 1 : 2, NLI = SAMPLE ? 8 : 32;
#pragma unroll
    for (int hf = 0; hf < NSUB; ++hf) {
      float4 ac[8], an[8];
#pragma unroll
      for (int j4 = 0; j4 < 8; ++j4) { ac[j4] = make_float4(0, 0, 0, 0); an[j4] = make_float4(0, 0, 0, 0); }
      ac[0] = *(const float4*)(AM + (32 * hf + 1) * 64 + 32 * hf);
#pragma unroll
      for (int li = 1; li < NLI; ++li) {
        if (li + 1 < NLI) {
#pragma unroll
          for (int j4 = 0; j4 < 8; ++j4)
            if (j4 < (li + 4) / 4) an[j4] = *(const float4*)(AM + (32 * hf + li + 1) * 64 + 32 * hf + j4 * 4);
        }
        float acc0 = x[32 * hf + li], acc1 = 0.f;
#pragma unroll
        for (int j4 = 0; j4 < 8; ++j4) {
          if (j4 < (li + 3) / 4) {
            float4 a = ac[j4];
            if (j4 * 4 + 0 < li) acc0 -= a.x * x[32 * hf + j4 * 4 + 0];
            if (j4 * 4 + 1 < li) acc1 -= a.y * x[32 * hf + j4 * 4 + 1];
            if (j4 * 4 + 2 < li) acc0 -= a.z * x[32 * hf + j4 * 4 + 2];
            if (j4 * 4 + 3 < li) acc1 -= a.w * x[32 * hf + j4 * 4 + 3];
          }
        }
        x[32 * hf + li] = acc0 + acc1;
#pragma unroll
        for (int j4 = 0; j4 < 8; ++j4) ac[j4] = an[j4];
        __builtin_amdgcn_sched_barrier(0);
      }
    }
  }
  }
  __syncthreads();
  u16* WM = KN;
  if (tid < 128) {
    const int dv = tid, s = dv >> 4, n = dv & 15;
#pragma unroll
    for (int mt = 0; mt < MT; ++mt)
#pragma unroll
      for (int g4 = 0; g4 < 4; ++g4) {
        const int i0 = 16 * mt + 4 * g4;
        float4 o;
        o.x = (i0 + 0 < NI) ? x[(i0 + 0 < NI) ? i0 + 0 : 0] : 0.f;
        o.y = (i0 + 1 < NI) ? x[(i0 + 1 < NI) ? i0 + 1 : 0] : 0.f;
        o.z = (i0 + 2 < NI) ? x[(i0 + 2 < NI) ? i0 + 2 : 0] : 0.f;
        o.w = (i0 + 3 < NI) ? x[(i0 + 3 < NI) ? i0 + 3 : 0] : 0.f;
        uf[(s * MT + mt) * 64 + g4 * 16 + n] = o;
      }
  } else {
    const int dk = tid - 128;
#pragma unroll
    for (int i = 0; i < 16 * MT; ++i) WM[i * 136 + dk] = (i < NI) ? f2bf(-x[(i < NI) ? i : 0]) : (u16)0;
  }
  __syncthreads();
  {
    const int mt = SAMPLE ? 0 : wave;
#pragma unroll
    for (int q = 0; q < (SAMPLE ? 1 : 4); ++q) {
      const int ks = SAMPLE ? wave : q;
      uint2 lo = *(const uint2*)(WM + (16 * mt + m) * 136 + 32 * ks + 4 * g);
      uint2 hi = *(const uint2*)(WM + (16 * mt + m) * 136 + 32 * ks + 16 + 4 * g);
      fa[fidx_w<SAMPLE>(mt, ks) * 64 + lane] = make_uint4(lo.x, lo.y, hi.x, hi.y);
    }
  }
  if (SAMPLE || (item & 31) == 31) {
    float* dst = p.out + (SAMPLE ? O_NDS : O_NDP);
    for (int idx = tid; idx < 3 * 384; idx += 256) {
      int j = idx / 384, cc = idx % 384, sec = cc >> 7, c = cc & 127;
      int col = sec * 512 + h * 128 + c;
      dst[((size_t)b * 3 + j) * 1536 + col] = bf2f(proj[(size_t)(row0 + NI - 3 + j) * DPJ + C_QKV + col]);
    }
  }
}

template <bool SAMPLE>
__device__ __forceinline__ void delta_seq(const Params& p, int item, char* smem) {
  constexpr int MT = SAMPLE ? 1 : 4, KS2 = SAMPLE ? 1 : 2, NI = SAMPLE ? 8 : 64, NC = SAMPLE ? 1 : 32;
  constexpr int NF = MT * 8 + MT * KS2 + 8 * KS2;
  static_assert(SAMPLE, "prompt chains use delta_seq_p");
  constexpr int W_OFF = 0, Q_OFF = MT * 4, QK_OFF = MT * 8, KD_OFF = MT * 8 + MT * KS2;
  constexpr int NPRE = (NF * 64 + 255) / 256;
  const int tid = threadIdx.x, lane = tid & 63, wave = tid >> 6, n = lane & 15, g = lane >> 4;
  const int bh = item >> 1, half = item & 1, b = bh >> 2, h = bh & 3;
  const int s = half * 4 + wave;
  const float* glast = (const float*)(p.ws + WS_GLAST);
  u16* ofp = (u16*)(p.ws + WS_X);
  const uint4* fa0; const float4* uf0; int chunk0, row00;
  if (SAMPLE) {
    fa0 = (const uint4*)(p.ws + WS_FRAG + 1024 * FRAG_P_BYTES + (size_t)bh * FRAG_S_BYTES);
    uf0 = (const float4*)((char*)p.out + YS_UF + 1024 * UF_P_BYTES + (size_t)bh * UF_S_BYTES);
    chunk0 = 2048 + bh; row00 = NP + b * 8;
  } else {
    fa0 = (const uint4*)(p.ws + WS_FRAG + (size_t)bh * 32 * FRAG_P_BYTES);
    uf0 = (const float4*)((char*)p.out + YS_UF + (size_t)bh * 32 * UF_P_BYTES);
    chunk0 = bh * 32; row00 = b * SEQ;
  }
  constexpr size_t FSTR = (SAMPLE ? FRAG_S_BYTES : FRAG_P_BYTES) / 16, USTR = (SAMPLE ? UF_S_BYTES : UF_P_BYTES) / 16;
  uint4* L = (uint4*)smem;
  f32x4 S[8];
  if (SAMPLE) {
    const float* s0 = p.state_dn_S + (size_t)bh * 16384;
#pragma unroll
    for (int dt = 0; dt < 8; ++dt)
#pragma unroll
      for (int r = 0; r < 4; ++r) S[dt][r] = s0[(16 * dt + 4 * g + r) * 128 + 16 * s + n];
  } else {
#pragma unroll
    for (int dt = 0; dt < 8; ++dt) S[dt] = f32x4{0, 0, 0, 0};
  }
  uint4 pre[NPRE];
  f32x4 upre[MT];
  float glpre;
#define SEQ_PREFETCH(c_)                                                                     \
  {                                                                                          \
    const uint4* fa_ = fa0 + (size_t)(c_) * FSTR;                                            \
    _Pragma("unroll") for (int q = 0; q < NPRE; ++q) {                                       \
      int idx = tid + q * 256;                                                               \
      pre[q] = (NF * 64 % 256 == 0 || idx < NF * 64) ? fa_[idx] : make_uint4(0, 0, 0, 0);   \
    }                                                                                        \
    const float4* uf_ = uf0 + (size_t)(c_) * USTR;                                           \
    _Pragma("unroll") for (int mt = 0; mt < MT; ++mt) {                                      \
      float4 t = uf_[(s * MT + mt) * 64 + lane];                                             \
      upre[mt] = f32x4{t.x, t.y, t.z, t.w};                                                  \
    }                                                                                        \
    glpre = glast[chunk0 + (c_)];                                                            \
  }
  SEQ_PREFETCH(0)
#pragma unroll 1
  for (int c = 0; c < NC; ++c) {
    __syncthreads();
#pragma unroll
    for (int q = 0; q < NPRE; ++q) {
      int idx = tid + q * 256;
      if (NF * 64 % 256 == 0 || idx < NF * 64) L[idx] = pre[q];
    }
    f32x4 accV[MT], accO[MT];
#pragma unroll
    for (int mt = 0; mt < MT; ++mt) { accV[mt] = upre[mt]; accO[mt] = f32x4{0, 0, 0, 0}; }
    const float gl = glpre;
    __syncthreads();
    if (c + 1 < NC) SEQ_PREFETCH(c + 1)
    bf16x8 Sb[4];
#pragma unroll
    for (int ks = 0; ks < 4; ++ks)
      Sb[ks] = mk8(pack2(S[2 * ks][0], S[2 * ks][1]), pack2(S[2 * ks][2], S[2 * ks][3]),
                   pack2(S[2 * ks + 1][0], S[2 * ks + 1][1]), pack2(S[2 * ks + 1][2], S[2 * ks + 1][3]));
#pragma unroll
    for (int mt = 0; mt < MT; ++mt)
#pragma unroll
      for (int ks = 0; ks < 4; ++ks) {
        accV[mt] = MFMA(u4_to_b8(L[(W_OFF + mt * 4 + ks) * 64 + lane]), Sb[ks], accV[mt]);
        accO[mt] = MFMA(u4_to_b8(L[(Q_OFF + mt * 4 + ks) * 64 + lane]), Sb[ks], accO[mt]);
        if (ks == 3) __builtin_amdgcn_sched_barrier(0);
      }
    bf16x8 Vb[KS2];
#pragma unroll
    for (int ks2 = 0; ks2 < KS2; ++ks2) {
      f32x4 lo = accV[(2 * ks2 < MT) ? 2 * ks2 : 0];
      f32x4 hi = (2 * ks2 + 1 < MT) ? accV[(2 * ks2 + 1 < MT) ? 2 * ks2 + 1 : 0] : f32x4{0, 0, 0, 0};
      Vb[ks2] = mk8(pack2(lo[0], lo[1]), pack2(lo[2], lo[3]), pack2(hi[0], hi[1]), pack2(hi[2], hi[3]));
    }
#pragma unroll
    for (int mt = 0; mt < MT; ++mt)
#pragma unroll
      for (int ks2 = 0; ks2 < KS2; ++ks2)
        accO[mt] = MFMA(u4_to_b8(L[(QK_OFF + mt * KS2 + ks2) * 64 + lane]), Vb[ks2], accO[mt]);
#pragma unroll
    for (int dt = 0; dt < 8; ++dt) {
      S[dt] = S[dt] * gl;
#pragma unroll
      for (int ks2 = 0; ks2 < KS2; ++ks2)
        S[dt] = MFMA(u4_to_b8(L[(KD_OFF + dt * KS2 + ks2) * 64 + lane]), Vb[ks2], S[dt]);
      if (dt & 1) __builtin_amdgcn_sched_barrier(0);
    }
    const int rowc = row00 + c * 64;
#pragma unroll
    for (int mt = 0; mt < MT; ++mt)
#pragma unroll
      for (int r = 0; r < 4; ++r) {
        const int i = 16 * mt + 4 * g + r;
        if (i < NI) ofp[(size_t)(rowc + i) * 512 + h * 128 + 16 * s + n] = f2bf(accO[mt][r]);
      }
  }
  float* so = p.out + (SAMPLE ? O_NSS : O_NSP) + (size_t)bh * 16384;
#pragma unroll
  for (int dt = 0; dt < 8; ++dt)
#pragma unroll
    for (int r = 0; r < 4; ++r) so[(16 * dt + 4 * g + r) * 128 + 16 * s + n] = S[dt][r];
  __syncthreads();
}


__device__ __forceinline__ void delta_seq_p(const Params& p, int item, char* smem) {
  constexpr int NFH = 26, NH = 64;
  constexpr int W_OFF = 0, Q_OFF = 8, QK_OFF = 16, KD_OFF = 18;
  constexpr int NV = NFH * 64;
  constexpr int NPRE = (NV + 255) / 256;
  const int tid = threadIdx.x, lane = tid & 63, wave = tid >> 6, n = lane & 15, g = lane >> 4;
  const int bh = item >> 1, half = item & 1, b = bh >> 2, h = bh & 3;
  const int s = half * 4 + wave;
  const float* glast = (const float*)(p.ws + WS_GLAST) + (size_t)bh * 64;
  u16* ofp = (u16*)(p.ws + WS_X);
  const uint4* fa0 = (const uint4*)(p.ws + WS_FRAG + (size_t)bh * 32 * FRAG_P_BYTES);
  const float4* uf0 = (const float4*)((char*)p.out + YS_UF + (size_t)bh * 32 * UF_P_BYTES);
  const int row00 = b * SEQ;
  uint4* L = (uint4*)smem;
  f32x4 S[8];
#pragma unroll
  for (int dt = 0; dt < 8; ++dt) S[dt] = f32x4{0, 0, 0, 0};
  uint4 PA[NPRE], PB[NPRE];
  f32x4 UA[2], UB[2];
  float GA = 0.f, GB = 0.f; (void)GA; (void)GB;
  constexpr int TOUCH_AHEAD = 8;
  uint32_t TA = 0, TB = 0, tsink = 0;
#define SEQP_TOUCH(T_, hs_)                                                                     \
  {                                                                                             \
    tsink ^= T_;                                                                                \
    const int ht_ = (hs_) + TOUCH_AHEAD;                                                        \
    if (ht_ < NH) {                                                                             \
      const int c64_ = ht_ >> 1, hf_ = ht_ & 1;                                                 \
      const uint32_t* fl_ = (const uint32_t*)(fa0 + (size_t)c64_ * (FRAG_P_BYTES / 16) + hf_ * NV);  \
      const uint32_t* ul_ = (const uint32_t*)(uf0 + (size_t)c64_ * (UF_P_BYTES / 16));            \
      uint32_t t0_ = (tid < 208) ? fl_[tid * 32] : 0u;                                          \
      uint32_t t1_ = (tid < 64) ? ul_[(((half * 4 + (tid >> 4)) * 4 + 2 * hf_ + ((tid >> 3) & 1)) * 64) * 4 + (tid & 7) * 32] : 0u; \
      T_ = t0_ ^ t1_;                                                                           \
    }                                                                                           \
  }
#define SEQP_LOAD(P_, U_, G_, hs_)                                                              \
  {                                                                                             \
    const int c64_ = (hs_) >> 1, hf_ = (hs_) & 1;                                               \
    const uint4* fa_ = fa0 + (size_t)c64_ * (FRAG_P_BYTES / 16) + hf_ * NV;                     \
    _Pragma("unroll") for (int q = 0; q < NPRE; ++q) {                                          \
      int idx = tid + q * 256;                                                                  \
      P_[q] = (idx < NV) ? fa_[idx] : make_uint4(0, 0, 0, 0);                                   \
    }                                                                                           \
    const float4* uf_ = uf0 + (size_t)c64_ * (UF_P_BYTES / 16);                                 \
    _Pragma("unroll") for (int mt = 0; mt < 2; ++mt) {                                          \
      float4 t = uf_[(s * 4 + 2 * hf_ + mt) * 64 + lane];                                       \
      U_[mt] = f32x4{t.x, t.y, t.z, t.w};                                                       \
    }                                                                                           \
  }
#define SEQP_STEP(P_, U_, G_, T_, hs_, buf_)                                                        \
  {                                                                                             \
    uint4* Lb = L + (buf_) * NV;                                                                \
    _Pragma("unroll") for (int q = 0; q < NPRE; ++q) {                                          \
      int idx = tid + q * 256;                                                                  \
      if (idx < NV) Lb[idx] = P_[q];                                                            \
    }                                                                                           \
    f32x4 accV[2], accO[2];                                                                     \
    accV[0] = U_[0]; accV[1] = U_[1];                                                           \
    accO[0] = f32x4{0, 0, 0, 0}; accO[1] = f32x4{0, 0, 0, 0};                                   \
    __syncthreads();                                                                            \
    const float gl = gls[(hs_)];                                                                \
    if ((hs_) + 2 < NH) SEQP_LOAD(P_, U_, G_, (hs_) + 2)                                        \
    bf16x8 Sb[4];                                                                               \
    _Pragma("unroll") for (int ks = 0; ks < 4; ++ks)                                            \
      Sb[ks] = mk8(pack2(S[2 * ks][0], S[2 * ks][1]), pack2(S[2 * ks][2], S[2 * ks][3]),        \
                   pack2(S[2 * ks + 1][0], S[2 * ks + 1][1]), pack2(S[2 * ks + 1][2], S[2 * ks + 1][3])); \
    _Pragma("unroll") for (int mt = 0; mt < 2; ++mt)                                            \
      _Pragma("unroll") for (int ks = 0; ks < 4; ++ks) {                                        \
        accV[mt] = MFMA(u4_to_b8(Lb[(W_OFF + mt * 4 + ks) * 64 + lane]), Sb[ks], accV[mt]);     \
        accO[mt] = MFMA(u4_to_b8(Lb[(Q_OFF + mt * 4 + ks) * 64 + lane]), Sb[ks], accO[mt]);     \
      }                                                                                         \
    __builtin_amdgcn_sched_barrier(0);                                                          \
    bf16x8 Vb = mk8(pack2(accV[0][0], accV[0][1]), pack2(accV[0][2], accV[0][3]),               \
                    pack2(accV[1][0], accV[1][1]), pack2(accV[1][2], accV[1][3]));              \
    _Pragma("unroll") for (int mt = 0; mt < 2; ++mt)                                            \
      accO[mt] = MFMA(u4_to_b8(Lb[(QK_OFF + mt) * 64 + lane]), Vb, accO[mt]);                   \
    _Pragma("unroll") for (int dt = 0; dt < 8; ++dt) {                                          \
      S[dt] = S[dt] * gl;                                                                       \
      S[dt] = MFMA(u4_to_b8(Lb[(KD_OFF + dt) * 64 + lane]), Vb, S[dt]);                         \
    }                                                                                           \
    const int rowc = row00 + (hs_) * 32;                                                        \
    _Pragma("unroll") for (int mt = 0; mt < 2; ++mt)                                            \
      _Pragma("unroll") for (int r = 0; r < 4; ++r)                                             \
        ofp[(size_t)(rowc + 16 * mt + 4 * g + r) * 512 + h * 128 + 16 * s + n] = f2bf(accO[mt][r]);   \
  }
  __syncthreads();
  float* gls = (float*)(smem + 2 * NV * 16);
  if (tid < 64) gls[tid] = glast[tid];
  SEQP_LOAD(PA, UA, GA, 0)
  SEQP_LOAD(PB, UB, GB, 1)
#pragma unroll 1
  for (int hs = 0; hs < NH; hs += 2) {
    SEQP_STEP(PA, UA, GA, TA, hs, 0)
    SEQP_STEP(PB, UB, GB, TB, hs + 1, 1)
  }
  float* so = p.out + O_NSP + (size_t)bh * 16384;
#pragma unroll
  for (int dt = 0; dt < 8; ++dt)
#pragma unroll
    for (int r = 0; r < 4; ++r) so[(16 * dt + 4 * g + r) * 128 + 16 * s + n] = S[dt][r];
  __syncthreads();
}

__device__ __forceinline__ void g2_tile(const Params& p, int t, char* smem) {
  const u16* cact = (const u16*)((const char*)p.out + YS_CACT);
  const u16* pw = (const u16*)(p.ws + WS_PW);
  const u16* proj = (const u16*)(p.ws + WS_PROJ);
  u16* cmix = (u16*)(p.ws + WS_CMIX);
  int m0 = (t >> 2) * 128, n0 = (t & 3) * 128;
  f32x4 acc[4][4];
#pragma unroll
  for (int i = 0; i < 4; ++i)
#pragma unroll
    for (int j = 0; j < 4; ++j) acc[i][j] = f32x4{0, 0, 0, 0};
  gemm128(cact + (size_t)m0 * 512, 512, pw + (size_t)n0 * 512, 512, 512, smem, acc);
  uint2 gpre[4][4];
  GEMM_EPILOGUE(acc, m0, n0, { (void)v; gpre[mt][nt] = *(const uint2*)(proj + (size_t)row * DPJ + C_GATE + col); })
  GEMM_EPILOGUE(acc, m0, n0, {
    uint2 gv = gpre[mt][nt];
    float o0 = v[0] * siluf_(bflo(gv.x)), o1 = v[1] * siluf_(bfhi(gv.x));
    float o2 = v[2] * siluf_(bflo(gv.y)), o3 = v[3] * siluf_(bfhi(gv.y));
    *(uint2*)(cmix + (size_t)row * 512 + col) = make_uint2(pack2(o0, o1), pack2(o2, o3));
  })
}


__device__ __forceinline__ void phase4(const Params& p, int bid, int nb, char* smem) {
#pragma unroll 1
  for (int it = bid; it < 544; it += nb) g2_tile(p, it, smem);
  const int tid = threadIdx.x, lane = tid & 63, wave = tid >> 6;
  const u16* ofp = (const u16*)(p.ws + WS_X);
  const u16* proj = (const u16*)(p.ws + WS_PROJ);
  u16* omix = (u16*)(p.ws + WS_OMIX);
  const int nheavy4 = (544 > nb && 544 < 2 * nb) ? 544 - nb : 0;
  if (bid < nheavy4) return;
  const int ob = bid - nheavy4, onb = nb - nheavy4;
  for (int row = ob * 4 + wave; row < NT; row += onb * 4) {
    const uint4 ov = *(const uint4*)(ofp + (size_t)row * 512 + lane * 8);
    float o[8] = {bflo(ov.x), bfhi(ov.x), bflo(ov.y), bfhi(ov.y), bflo(ov.z), bfhi(ov.z), bflo(ov.w), bfhi(ov.w)};
    float ss = 0.f;
#pragma unroll
    for (int e = 0; e < 8; ++e) ss += o[e] * o[e];
    ss += __shfl_xor(ss, 1); ss += __shfl_xor(ss, 2); ss += __shfl_xor(ss, 4); ss += __shfl_xor(ss, 8);
    float r = rsqrtf(ss * (1.f / 128.f) + EPS);
    uint4 zv = *(const uint4*)(proj + (size_t)row * DPJ + C_Z + lane * 8);
    float z[8] = {bflo(zv.x), bfhi(zv.x), bflo(zv.y), bfhi(zv.y), bflo(zv.z), bfhi(zv.z), bflo(zv.w), bfhi(zv.w)};
    float4 g0 = *(const float4*)(p.dn_norm_g + (lane & 15) * 8), g1 = *(const float4*)(p.dn_norm_g + (lane & 15) * 8 + 4);
    float gg[8] = {g0.x, g0.y, g0.z, g0.w, g1.x, g1.y, g1.z, g1.w};
    float y[8];
#pragma unroll
    for (int e = 0; e < 8; ++e) y[e] = o[e] * r * gg[e] * siluf_(z[e]);
    *(uint4*)(omix + (size_t)row * 512 + lane * 8) = make_uint4(pack2(y[0], y[1]), pack2(y[2], y[3]), pack2(y[4], y[5]), pack2(y[6], y[7]));
  }
}

__device__ __forceinline__ void ple_tile(const Params& p, int t, char* smem) {
  const u16* pb = (const u16*)(p.ws + WS_PB2);
  const u16* pp = (const u16*)(p.ws + WS_PPROJ);
  u16* pl = (u16*)(p.ws + WS_PL);
  int m0 = (t >> 3) * 128, n0 = (t & 7) * 128;
  f32x4 acc[4][4];
#pragma unroll
  for (int i = 0; i < 4; ++i)
#pragma unroll
    for (int j = 0; j < 4; ++j) acc[i][j] = f32x4{0, 0, 0, 0};
  gemm128<false>(pb + (size_t)m0 * 256, 256, pp + (size_t)n0 * 256, 256, 256, smem, acc);
  GEMM_EPILOGUE(acc, m0, n0, {
    *(uint2*)(pl + (size_t)row * 1024 + col) = make_uint2(pack2(v[0], v[1]), pack2(v[2], v[3]));
  })
}

template <int MH>
__device__ __forceinline__ void g3_unit(const Params& p, int m0, int n0, char* smem, bool do_atomic) {
  const u16* cmix = (const u16*)(p.ws + WS_CMIX);
  const u16* omix = (const u16*)(p.ws + WS_OMIX);
  const u16* wo = (const u16*)(p.ws + WS_WOUT);
  u16* x1b = (u16*)(p.ws + WS_X);
  float* ss2 = (float*)(p.ws + WS_SS2);
  float* y = p.out + O_Y;
  f32x4 acc[4][4];
#pragma unroll
  for (int i = 0; i < 4; ++i)
#pragma unroll
    for (int j = 0; j < 4; ++j) acc[i][j] = f32x4{0, 0, 0, 0};
  gemm128<false, MH>(cmix + (size_t)m0 * 512, 512, wo + (size_t)n0 * 1024, 1024, 512, smem, acc);
  gemm128<false, MH>(omix + (size_t)m0 * 512, 512, wo + (size_t)n0 * 1024 + 512, 1024, 512, smem, acc);
  float rs[4] = {0, 0, 0, 0};
  float4 xpre[4][4];
  GEMM_EPILOGUE_M(acc, m0, n0, MH, { (void)v; xpre[mt][nt] = *(const float4*)(xrow(p, row) + col); })
  GEMM_EPILOGUE_M(acc, m0, n0, MH, {
    float4 xv = xpre[mt][nt];
    float o0 = xv.x + v[0], o1 = xv.y + v[1], o2 = xv.z + v[2], o3 = xv.w + v[3];
    *(uint2*)(x1b + (size_t)row * 1024 + col) = make_uint2(pack2(o0, o1), pack2(o2, o3));
    rs[mt] += o0 * o0 + o1 * o1 + o2 * o2 + o3 * o3;
  })
  {
    const int lane = threadIdx.x & 63, wave = threadIdx.x >> 6;
#pragma unroll
    for (int mt = 0; mt < MH; ++mt) {
      float sq = rs[mt];
      sq += __shfl_xor(sq, 16); sq += __shfl_xor(sq, 32);
      if (lane < 16 && do_atomic) atomicAdd(&ss2[m0 + (wave >> 1) * (16 * MH) + mt * 16 + lane], sq);
    }
  }
}

template <int MH>
__device__ __forceinline__ void g4_unit(const Params& p, int m0, int n0, char* smem, bool do_atomic) {
  const u16* x1b = (const u16*)(p.ws + WS_X);
  const u16* pl = (const u16*)(p.ws + WS_PL);
  const u16* gt = (const u16*)(p.ws + WS_GATE);
  const float* ss2 = (const float*)(p.ws + WS_SS2);
  float* ss3 = (float*)(p.ws + WS_SS3);
  const float* y = p.out + O_Y;
  u16* x2b = (u16*)(p.ws + WS_X2B);
  f32x4 acc[4][4];
#pragma unroll
  for (int i = 0; i < 4; ++i)
#pragma unroll
    for (int j = 0; j < 4; ++j) acc[i][j] = f32x4{0, 0, 0, 0};
  gemm128<false, MH>(x1b + (size_t)m0 * 1024, 1024, gt + (size_t)n0 * 1024, 1024, 1024, smem, acc);
  float rs[4] = {0, 0, 0, 0};
  uint2 ypre[4][4];
  uint2 ppre[4][4];
  float r2pre[4];
  GEMM_EPILOGUE_M(acc, m0, n0, MH, {
    (void)v;
    ypre[mt][nt] = *(const uint2*)(x1b + (size_t)row * 1024 + col);
    ppre[mt][nt] = *(const uint2*)(pl + (size_t)row * 1024 + col);
    if (nt == 0) r2pre[mt] = ss2[row];
  })
  GEMM_EPILOGUE_M(acc, m0, n0, MH, {
    float r2 = rsqrtf(r2pre[mt] * (1.f / 1024.f) + EPS);
    uint2 xv = ypre[mt][nt];
    uint2 pv = ppre[mt][nt];
    float o0 = bflo(xv.x) + sigmoidf_(v[0] * r2) * bflo(pv.x), o1 = bfhi(xv.x) + sigmoidf_(v[1] * r2) * bfhi(pv.x);
    float o2 = bflo(xv.y) + sigmoidf_(v[2] * r2) * bflo(pv.y), o3 = bfhi(xv.y) + sigmoidf_(v[3] * r2) * bfhi(pv.y);
    *(uint2*)(x2b + (size_t)row * 1024 + col) = make_uint2(pack2(o0, o1), pack2(o2, o3));
    rs[mt] += o0 * o0 + o1 * o1 + o2 * o2 + o3 * o3;
  })
  {
    const int lane = threadIdx.x & 63, wave = threadIdx.x >> 6;
#pragma unroll
    for (int mt = 0; mt < MH; ++mt) {
      float sq = rs[mt];
      sq += __shfl_xor(sq, 16); sq += __shfl_xor(sq, 32);
      if (lane < 16 && do_atomic) atomicAdd(&ss3[m0 + (wave >> 1) * (16 * MH) + mt * 16 + lane], sq);
    }
  }
}

template <int G>
__device__ __forceinline__ void g34_tiles(const Params& p, int bid, int nb, char* smem, bool do_atomic, bool& heavy, int& nlight, int& lidx) {
  const TileWalk tw = tile_walk(8, bid, nb);
  heavy = false; nlight = nb; lidx = bid;
  if (tw.banded && tw.total > tw.step) {
    const int nfull = (tw.total / tw.step) * tw.step, rem = tw.total - nfull;
#pragma unroll 1
    for (int t = tw.q; t < nfull; t += tw.step) {
      int mt_, nt_;
      tile_get(tw, t, mt_, nt_);
      if (G == 0) g3_unit<4>(p, mt_ * 128, nt_ * 128, smem, do_atomic); else g4_unit<4>(p, mt_ * 128, nt_ * 128, smem, do_atomic);
    }
    const int nhalf = 2 * rem <= tw.step ? 2 * rem : 0;
    if (nhalf > 0) {
      if (tw.q < nhalf) {
        int mt_, nt_;
        tile_get(tw, nfull + (tw.q >> 1), mt_, nt_);
        const int m0 = mt_ * 128 + (tw.q & 1) * 64;
        if (G == 0) g3_unit<2>(p, m0, nt_ * 128, smem, do_atomic); else g4_unit<2>(p, m0, nt_ * 128, smem, do_atomic);
        heavy = true;
      }
      nlight = (tw.step - nhalf) * 8; lidx = (tw.q - nhalf) * 8 + (bid & 7);
    } else {
#pragma unroll 1
      for (int t = nfull + tw.q; t < tw.total; t += tw.step) {
        int mt_, nt_;
        tile_get(tw, t, mt_, nt_);
        if (G == 0) g3_unit<4>(p, mt_ * 128, nt_ * 128, smem, do_atomic); else g4_unit<4>(p, mt_ * 128, nt_ * 128, smem, do_atomic);
      }
    }
  } else {
#pragma unroll 1
    for (int t = tw.q; t < tw.total; t += tw.step) {
      int mt_, nt_;
      tile_get(tw, t, mt_, nt_);
      if (G == 0) g3_unit<4>(p, mt_ * 128, nt_ * 128, smem, do_atomic); else g4_unit<4>(p, mt_ * 128, nt_ * 128, smem, do_atomic);
    }
  }
}
__device__ __forceinline__ void phase5(const Params& p, int bid, int nb, char* smem, bool do_atomic = true) {
  bool heavy; int nlight, lidx;
  g34_tiles<0>(p, bid, nb, smem, do_atomic, heavy, nlight, lidx);
  if (do_atomic && !heavy) {
#pragma unroll 1
    for (int it = lidx; it < 1088; it += nlight) ple_tile(p, it, smem);
  }
}
__device__ __forceinline__ void phase6(const Params& p, int bid, int nb, char* smem, bool do_atomic = true) {
  bool heavy; int nlight, lidx;
  g34_tiles<1>(p, bid, nb, smem, do_atomic, heavy, nlight, lidx);
}

__device__ __forceinline__ void phase7(const Params& p, int bid, int nb) {
  const int tid = threadIdx.x;
  const float* ss3 = (const float*)(p.ws + WS_SS3);
  const u16* x2b = (const u16*)(p.ws + WS_X2B);
  float* y = p.out + O_Y;
  for (size_t i = (size_t)bid * 256 + tid; i < (size_t)NT * 128; i += (size_t)nb * 256) {
    const int row = (int)(i >> 7), c = (int)(i & 127) * 8;
    const float r = rsqrtf(ss3[row] * (1.f / 1024.f) + EPS);
    const uint4 v = *(const uint4*)(x2b + (size_t)row * 1024 + c);
    const float4 g0 = *(const float4*)(p.final_norm_g + c), g1 = *(const float4*)(p.final_norm_g + c + 4);
    *(float4*)(y + (size_t)row * 1024 + c) = make_float4(bflo(v.x) * r * g0.x, bfhi(v.x) * r * g0.y, bflo(v.y) * r * g0.z, bfhi(v.y) * r * g0.w);
    *(float4*)(y + (size_t)row * 1024 + c + 4) = make_float4(bflo(v.z) * r * g1.x, bfhi(v.z) * r * g1.y, bflo(v.w) * r * g1.z, bfhi(v.w) * r * g1.w);
  }
}

__device__ __forceinline__ void phase2(const Params& p, int bid, int nb, char* smem) {
#pragma unroll 1
  for (int it = bid; it < 1024; it += nb) delta_prep<false>(p, it, smem);
}
__device__ __forceinline__ void phase3(const Params& p, int bid, int nb, char* smem) {
  if (nb >= 128) {
    if (bid < 64) { delta_seq_p(p, bid, smem); return; }
    bid -= 64; nb -= 64;
  } else {
    for (int it = bid; it < 64; it += nb) delta_seq_p(p, it, smem);
  }
#pragma unroll 1
  for (int it = bid; it < 512; it += nb) conv_tile<false>(p, it, smem);
#pragma unroll 1
  for (int it = nb - 1 - bid; it < 128; it += nb) conv_tile<true>(p, it, smem);
#pragma unroll 1
  for (int it = bid; it < 512; it += nb) {
    delta_prep<true>(p, it, smem);
    __threadfence_block();
    __syncthreads();
#pragma unroll 1
    for (int hf = 0; hf < 2; ++hf) delta_seq<true>(p, 2 * it + hf, smem);
  }
}

#define XB_TMO      128
#define XB_XCNT(j)  (256  + 64 * (j))
#define XB_XSUB(j)  (1280 + 64 * (j))
#define XB_XGEN(j)  (2304 + 64 * (j))
#define XB_TOP      3328
#define XB_TOPGEN   3392
#define XCD_BAR_WORDS 3456
#define XB_SPIN_CAP (1u << 22)
__device__ __forceinline__ unsigned xb_ld(unsigned* p) { return __hip_atomic_load(p, __ATOMIC_RELAXED, __HIP_MEMORY_SCOPE_AGENT); }
__device__ __forceinline__ unsigned xb_add(unsigned* p, unsigned v) { return __hip_atomic_fetch_add(p, v, __ATOMIC_RELAXED, __HIP_MEMORY_SCOPE_AGENT); }
__device__ __forceinline__ unsigned xb_xcc_id() { return (unsigned)__builtin_amdgcn_s_getreg((3 << 11) | 20) & 0xFu; }
#define XB_SPIN(cond, bar) do { unsigned _sp = 0; while (cond) { __builtin_amdgcn_s_sleep(1); \
    if ((++_sp & 255u) == 0u) { if (xb_ld(&(bar)[XB_TMO])) break; if (_sp > XB_SPIN_CAP) { atomicAdd(&(bar)[XB_TMO], 1u); break; } } } } while (0)
struct XcdBarrier { unsigned* bar; unsigned x; unsigned nloc; unsigned nx; };
__device__ __forceinline__ void xcd_barrier_complete(unsigned* bar, unsigned x, unsigned& nloc, unsigned& nx) {
  const unsigned G = gridDim.x;
  unsigned sum, cnt, mine, sp = 0u;
  for (;;) {
    sum = 0u; cnt = 0u; mine = 0u;
#pragma unroll
    for (unsigned j = 0; j < 16; ++j) { const unsigned c = xb_ld(&bar[XB_XCNT(j)]); sum += c; cnt += (c > 0u) ? 1u : 0u; mine = (j == x) ? c : mine; }
    if (sum == G) break;
    __builtin_amdgcn_s_sleep(1);
    if ((++sp & 255u) == 0u) { if (xb_ld(&bar[XB_TMO])) break; if (sp > XB_SPIN_CAP) { atomicAdd(&bar[XB_TMO], 1u); break; } }
  }
  nloc = mine > 0u ? mine : 1u; nx = cnt > 0u ? cnt : 1u;
}
__device__ __forceinline__ void xcd_barrier(XcdBarrier& b) {
  asm volatile("s_waitcnt vmcnt(0)" ::: "memory");
  __syncthreads();
  if (threadIdx.x == 0) {
    unsigned* bar = b.bar;
    __builtin_amdgcn_s_waitcnt(0);
    if (b.nloc == 0u) xcd_barrier_complete(bar, b.x, b.nloc, b.nx);
    const unsigned nloc = b.nloc, nx = b.nx;
    const unsigned old = xb_add(&bar[XB_XSUB(b.x)], 1u);
    const unsigned gen = old / nloc;
    if (old + 1u == (gen + 1u) * nloc) {
      __builtin_amdgcn_fence(__ATOMIC_RELEASE, "agent");
      asm volatile("s_waitcnt vmcnt(0)" ::: "memory");
      const unsigned og = xb_add(&bar[XB_TOP], 1u);
      const unsigned tg = og / nx;
      if (og + 1u == (tg + 1u) * nx) xb_add(&bar[XB_TOPGEN], 1u);
      else XB_SPIN(xb_ld(&bar[XB_TOPGEN]) == tg, bar);
      __builtin_amdgcn_fence(__ATOMIC_ACQUIRE, "agent");
      xb_add(&bar[XB_XGEN(b.x)], 1u);
      asm volatile("s_waitcnt vmcnt(0)" ::: "memory");
    } else {
      XB_SPIN(xb_ld(&bar[XB_XGEN(b.x)]) == gen, bar);
      __builtin_amdgcn_fence(__ATOMIC_ACQUIRE, "agent");
      asm volatile("s_waitcnt vmcnt(0)" ::: "memory");
    }
  }
  __syncthreads();
}

template <int MODE>
__global__ void __launch_bounds__(256, 2) mega(Params p) {
  __shared__ __attribute__((aligned(16))) char smem[65536];
  const int bid = blockIdx.x, nb = gridDim.x;
  if (MODE < 0) {
    XcdBarrier gb;
    gb.bar = (unsigned*)(p.ws + WS_BAR); gb.x = xb_xcc_id(); gb.nloc = 0u; gb.nx = 0u;
    if (threadIdx.x == 0) (void)xb_add(&gb.bar[XB_XCNT(gb.x)], 1u);
    phase0(p, bid, nb, smem); xcd_barrier(gb);
    if (PROBE_DUP == 0) { phase0(p, bid, nb, smem); xcd_barrier(gb); }
    phase1(p, bid, nb, smem); xcd_barrier(gb);
    if (PROBE_DUP == 1) { phase1(p, bid, nb, smem); xcd_barrier(gb); }
    phase2(p, bid, nb, smem); xcd_barrier(gb);
    if (PROBE_DUP == 2) { phase2(p, bid, nb, smem); xcd_barrier(gb); }
    phase3(p, bid, nb, smem); xcd_barrier(gb);
    if (PROBE_DUP == 3) { phase3(p, bid, nb, smem); xcd_barrier(gb); }
    phase4(p, bid, nb, smem); xcd_barrier(gb);
    if (PROBE_DUP == 4) { phase4(p, bid, nb, smem); xcd_barrier(gb); }
    if (PROBE_DUP == 11) { phase5(p, bid, nb, smem, false); xcd_barrier(gb); }
    phase5(p, bid, nb, smem); xcd_barrier(gb);
    phase6(p, bid, nb, smem); xcd_barrier(gb);
    phase7(p, bid, nb);
  } else {
    if (MODE == 0) phase0(p, bid, nb, smem);
    if (MODE == 1) phase1(p, bid, nb, smem);
    if (MODE == 2) phase2(p, bid, nb, smem);
    if (MODE == 3) phase3(p, bid, nb, smem);
    if (MODE == 4) phase4(p, bid, nb, smem);
    if (MODE == 5) phase5(p, bid, nb, smem);
    if (MODE == 6) phase6(p, bid, nb, smem);
    if (MODE == 7) phase7(p, bid, nb);
  }
}

extern "C" void kernel_launch(void* const* d_in, const int* in_sizes, int n_in, void* d_out, int out_size, void* d_ws,
                              size_t ws_size, hipStream_t stream) {
  if (ws_size < WS_END) { fprintf(stderr, "workspace too small: %zu < %zu\n", ws_size, (size_t)WS_END); return; }
  static int grid = 0;
  if (grid == 0) {
    int dev = 0, cus = 0, per_cu = 0;
    hipGetDevice(&dev);
    hipDeviceGetAttribute(&cus, hipDeviceAttributeMultiprocessorCount, dev);
    hipOccupancyMaxActiveBlocksPerMultiprocessor(&per_cu, (const void*)mega<-1>, 256, 0);
    if (per_cu > 2) per_cu = 2;
    if (per_cu < 1 || cus < 1) { fprintf(stderr, "occupancy query failed (%d, %d)\n", cus, per_cu); grid = -1; return; }
    grid = cus * per_cu;
  }
  if (grid < 0) return;
  Params p{};
  const float** f = (const float**)&p;
  for (int i = 0; i < 23; ++i) f[i] = (const float*)d_in[i];
  p.out = (float*)d_out;
  p.ws = (char*)d_ws;
  hipMemsetAsync((char*)d_ws + WS_BAR, 0, XCD_BAR_WORDS * 4, stream);
  void* args[] = {&p};
  hipError_t e = hipLaunchCooperativeKernel((const void*)mega<-1>, dim3(grid), dim3(256), args, 0, stream);
  if (e != hipSuccess) fprintf(stderr, "cooperative launch failed: %s (grid %d)\n", hipGetErrorString(e), grid);
}
```

```cpp
#include <hip/hip_runtime.h>
#include <hip/hip_bf16.h>
#include <cstdio>
#include <cstdint>

typedef __attribute__((ext_vector_type(8))) short bf16x8;
typedef __attribute__((ext_vector_type(4))) float f32x4;
typedef unsigned short u16;
#ifndef PROBE_DUP
#define PROBE_DUP -1
#endif

constexpr int DM = 1024, NP = 16384, NS = 1024, NT = 17408, SEQ = 2048;
constexpr int DIN = 3592, DPJ = 3584;
constexpr int C_GLUA = 0, C_GLUB = 512, C_GATE = 1024, C_QKV = 1536, C_Z = 3072;
constexpr float EPS = 1e-6f;

constexpr int NF_P = 52, NF_S = 17;
constexpr size_t FRAG_P_BYTES = (size_t)NF_P * 1024, FRAG_S_BYTES = (size_t)NF_S * 1024;
constexpr size_t UF_P_BYTES = 32 * 1024, UF_S_BYTES = 8 * 1024;

constexpr size_t al256(size_t x) { return (x + 255) & ~(size_t)255; }
constexpr size_t WS_X = 0;
constexpr size_t WS_PROJ = WS_X + (size_t)NT * 1024 * 2;
constexpr size_t WS_FRAG = WS_PROJ + (size_t)NT * DPJ * 2;
constexpr size_t FRAG_TOTAL = 1024 * FRAG_P_BYTES + 512 * FRAG_S_BYTES;
constexpr size_t WS_OMIX = WS_FRAG;
constexpr size_t WS_X2B = WS_PROJ;
constexpr size_t WS_PL = WS_FRAG + (size_t)NT * 512 * 2;
constexpr size_t WS_CMIX = WS_FRAG + al256(FRAG_TOTAL);
constexpr size_t WS_WIN = WS_CMIX + (size_t)NT * 512 * 2;
constexpr size_t WS_PW = WS_WIN + (size_t)DPJ * 1024 * 2;
constexpr size_t WS_WOUT = WS_PW + 512 * 512 * 2;
constexpr size_t WS_GATE = WS_WOUT + 1024 * 1024 * 2;
constexpr size_t WS_PPROJ = WS_GATE + 1024 * 1024 * 2;
constexpr size_t WS_R1 = WS_PPROJ + 1024 * 256 * 2;
constexpr size_t WS_AB = WS_R1 + al256((size_t)NT * 4);
constexpr size_t WS_SS2 = WS_AB + (size_t)NT * 8 * 4;
constexpr size_t WS_SS3 = WS_SS2 + al256((size_t)NT * 4);
constexpr size_t WS_GLAST = WS_SS3 + al256((size_t)NT * 4);
constexpr size_t WS_BAR = WS_GLAST + al256(2560 * 4);
constexpr size_t WS_PB2 = WS_BAR + al256(3456 * 4);
constexpr size_t WS_END = WS_PB2 + (size_t)NT * 256 * 2;
constexpr size_t YS_UF = 0;
constexpr size_t YS_CACT = 1024 * UF_P_BYTES + 512 * UF_S_BYTES;
static_assert(YS_CACT + (size_t)NT * 512 * 2 <= (size_t)NT * 1024 * 4, "y scratch overflow");
static_assert(WS_PL + (size_t)NT * 1024 * 2 <= WS_CMIX, "frag alias overflow");

constexpr size_t O_Y = 0;
constexpr size_t O_NCP = (size_t)NT * 1024;
constexpr size_t O_NDP = O_NCP + 8 * 30 * 512;
constexpr size_t O_NSP = O_NDP + 8 * 3 * 1536;
constexpr size_t O_NCS = O_NSP + (size_t)8 * 4 * 128 * 128;
constexpr size_t O_NDS = O_NCS + (size_t)128 * 30 * 512;
constexpr size_t O_NSS = O_NDS + (size_t)128 * 3 * 1536;

struct Params {
  const float *x_prompt, *x_sample, *state_conv, *state_dn_conv, *state_dn_S, *p_prompt, *p_sample;
  const float *norm_mix_g, *w_in, *conv_dw_w, *conv_dw_b, *conv_ln_g, *conv_ln_b, *conv_pw_w;
  const float *dn_conv_w, *dn_a_log, *dn_dt_bias, *dn_norm_g, *w_out, *ple_norm_g, *ple_gate_w, *ple_proj_w, *final_norm_g;
  float* out;
  char* ws;
};

typedef float f32x2_t __attribute__((ext_vector_type(2)));
typedef __bf16 bf16x2_t __attribute__((ext_vector_type(2)));
__device__ __forceinline__ uint32_t pack2(float a, float b) {
  f32x2_t v = {a, b};
  bf16x2_t r = __builtin_convertvector(v, bf16x2_t);
  return __builtin_bit_cast(uint32_t, r);
}
__device__ __forceinline__ u16 f2bf(float f) { return (u16)(pack2(f, f) & 0xffffu); }
__device__ __forceinline__ float bf2f(u16 h) { return __uint_as_float(((uint32_t)h) << 16); }
__device__ __forceinline__ float bflo(uint32_t u) { return __uint_as_float(u << 16); }
__device__ __forceinline__ float bfhi(uint32_t u) { return __uint_as_float(u & 0xffff0000u); }
__device__ __forceinline__ float sigmoidf_(float x) { return __builtin_amdgcn_rcpf(1.f + __expf(-x)); }
__device__ __forceinline__ float siluf_(float x) { return x * __builtin_amdgcn_rcpf(1.f + __expf(-x)); }
__device__ __forceinline__ const float* xrow(const Params& p, int row) {
  return row < NP ? p.x_prompt + (size_t)row * DM : p.x_sample + (size_t)(row - NP) * DM;
}
__device__ __forceinline__ float wave_sum(float v) {
#pragma unroll
  for (int o = 32; o >= 1; o >>= 1) v += __shfl_xor(v, o);
  return v;
}
__device__ __forceinline__ bf16x8 mk8(uint32_t a, uint32_t b, uint32_t c, uint32_t d) {
  union { uint32_t u[4]; bf16x8 v; } t;
  t.u[0] = a; t.u[1] = b; t.u[2] = c; t.u[3] = d;
  return t.v;
}
__device__ __forceinline__ bf16x8 u4_to_b8(uint4 q) { return mk8(q.x, q.y, q.z, q.w); }
#define MFMA(a, b, c) __builtin_amdgcn_mfma_f32_16x16x32_bf16((a), (b), (c), 0, 0, 0)

template <bool DEEP = false, int MH = 4>
__device__ __forceinline__ void gemm128(const u16* __restrict__ A, int lda, const u16* __restrict__ B, int ldb,
                                        int K, char* smem, f32x4 (&acc)[4][4]) {
  const int tid = threadIdx.x, lane = tid & 63, wave = tid >> 6;
  const int wm = wave >> 1, wn = wave & 1, m = lane & 15, g = lane >> 4;
  const int nkt = K >> 6;
  uint4 ra0, ra1, ra2, ra3, rb0, rb1, rb2, rb3;
  uint4 rc0, rc1, rc2, rc3, rd0, rd1, rd2, rd3;
  const int lrow = tid >> 3, lch = tid & 7;
  const u16* gA = A + (size_t)lrow * lda + lch * 8;
  const u16* gB = B + (size_t)lrow * ldb + lch * 8;
  const int soff = lrow * 128 + ((lch ^ (lrow & 7)) << 4);
#define GLOAD(...) GLOAD_I(__VA_ARGS__)
#define SSTORE(...) SSTORE_I(__VA_ARGS__)
#define GLOAD_I(a0_, a1_, a2_, a3_, b0_, b1_, b2_, b3_, kt_)             \
  {                                                                     \
    a0_ = *(const uint4*)(gA + (kt_) * 64);                             \
    a1_ = *(const uint4*)(gA + (size_t)32 * lda + (kt_) * 64);          \
    if (MH == 4) {                                                      \
      a2_ = *(const uint4*)(gA + (size_t)64 * lda + (kt_) * 64);        \
      a3_ = *(const uint4*)(gA + (size_t)96 * lda + (kt_) * 64);        \
    }                                                                   \
    b0_ = *(const uint4*)(gB + (kt_) * 64);                             \
    b1_ = *(const uint4*)(gB + (size_t)32 * ldb + (kt_) * 64);          \
    b2_ = *(const uint4*)(gB + (size_t)64 * ldb + (kt_) * 64);          \
    b3_ = *(const uint4*)(gB + (size_t)96 * ldb + (kt_) * 64);          \
  }
#define SSTORE_I(a0_, a1_, a2_, a3_, b0_, b1_, b2_, b3_, buf_)           \
  {                                                                     \
    char* sa_ = smem + (buf_) * 32768 + soff;                           \
    *(uint4*)(sa_) = a0_;                                               \
    *(uint4*)(sa_ + 4096) = a1_;                                        \
    if (MH == 4) {                                                      \
      *(uint4*)(sa_ + 8192) = a2_;                                      \
      *(uint4*)(sa_ + 12288) = a3_;                                     \
    }                                                                   \
    *(uint4*)(sa_ + 16384) = b0_;                                       \
    *(uint4*)(sa_ + 16384 + 4096) = b1_;                                \
    *(uint4*)(sa_ + 16384 + 8192) = b2_;                                \
    *(uint4*)(sa_ + 16384 + 12288) = b3_;                               \
  }
#define GEMM_COMPUTE(buf_)                                                                   \
  {                                                                                          \
    const char* sa = smem + (buf_) * 32768;                                                  \
    const char* sb = sa + 16384;                                                             \
    _Pragma("unroll") for (int ks = 0; ks < 2; ++ks) {                                       \
      bf16x8 af[4], bfr[4];                                                                  \
      _Pragma("unroll") for (int t = 0; t < 4; ++t) {                                        \
        if (t < MH) {                                                                        \
          int ra_ = wm * (16 * MH) + t * 16 + m;                                             \
          af[t] = *(const bf16x8*)(sa + ra_ * 128 + (((ks * 4 + g) ^ (ra_ & 7)) << 4));      \
        }                                                                                    \
        int rb_ = wn * 64 + t * 16 + m;                                                      \
        bfr[t] = *(const bf16x8*)(sb + rb_ * 128 + (((ks * 4 + g) ^ (rb_ & 7)) << 4));       \
      }                                                                                      \
      _Pragma("unroll") for (int mt = 0; mt < MH; ++mt)                                      \
        _Pragma("unroll") for (int nt = 0; nt < 4; ++nt) acc[mt][nt] = MFMA(bfr[nt], af[mt], acc[mt][nt]); \
    }                                                                                        \
  }
#define SETX ra0, ra1, ra2, ra3, rb0, rb1, rb2, rb3
#define SETY rc0, rc1, rc2, rc3, rd0, rd1, rd2, rd3
  __syncthreads();
  if (DEEP) {
    GLOAD(SETX, 0)
    GLOAD(SETY, 1)
    SSTORE(SETX, 0)
    __syncthreads();
#pragma unroll 1
    for (int kt = 0; kt < nkt; kt += 2) {
      if (kt + 2 < nkt) GLOAD(SETX, kt + 2)
      GEMM_COMPUTE(0)
      SSTORE(SETY, 1)
      __syncthreads();
      if (kt + 3 < nkt) GLOAD(SETY, kt + 3)
      GEMM_COMPUTE(1)
      if (kt + 2 < nkt) SSTORE(SETX, 0)
      __syncthreads();
    }
  } else {
    GLOAD(SETX, 0)
    SSTORE(SETX, 0)
    __syncthreads();
#pragma unroll 1
    for (int kt = 0; kt < nkt; ++kt) {
      if (kt + 1 < nkt) GLOAD(SETX, kt + 1)
      GEMM_COMPUTE(kt & 1)
      if (kt + 1 < nkt) SSTORE(SETX, (kt + 1) & 1)
      __syncthreads();
    }
  }
}
#define GEMM_EPILOGUE_M(acc, m0, n0, MH_, ...)                                             \
  {                                                                                        \
    const int lane_ = threadIdx.x & 63, wave_ = threadIdx.x >> 6;                          \
    const int wm_ = wave_ >> 1, wn_ = wave_ & 1, m_ = lane_ & 15, g_ = lane_ >> 4;         \
    _Pragma("unroll") for (int mt = 0; mt < (MH_); ++mt) {                                 \
      const int row = (m0) + wm_ * (16 * (MH_)) + mt * 16 + m_;                            \
      _Pragma("unroll") for (int nt = 0; nt < 4; ++nt) {                                   \
        const int col = (n0) + wn_ * 64 + nt * 16 + g_ * 4;                                \
        f32x4 v = acc[mt][nt];                                                             \
        __VA_ARGS__                                                                        \
      }                                                                                    \
    }                                                                                      \
  }
#define GEMM_EPILOGUE(acc, m0, n0, ...) GEMM_EPILOGUE_M(acc, m0, n0, 4, __VA_ARGS__)

__device__ __forceinline__ void transpose_tile(const float* __restrict__ src, int lds_, const float* __restrict__ gv, u16* __restrict__ dst,
                               int ldd, int k0, int n0, char* smem) {
  float* t = (float*)smem;
  const int tid = threadIdx.x;
  __syncthreads();
#pragma unroll
  for (int it = 0; it < 4; ++it) {
    int k = (tid >> 4) + it * 16, n = (tid & 15) * 4;
    float4 v = *(const float4*)(src + (size_t)(k0 + k) * lds_ + n0 + n);
    float gg = gv ? gv[k0 + k] : 1.f;
    t[k * 65 + n + 0] = v.x * gg; t[k * 65 + n + 1] = v.y * gg; t[k * 65 + n + 2] = v.z * gg; t[k * 65 + n + 3] = v.w * gg;
  }
  __syncthreads();
#pragma unroll
  for (int it = 0; it < 2; ++it) {
    int n = (tid >> 3) + it * 32, kc = (tid & 7) * 8;
    uint32_t w[4];
#pragma unroll
    for (int e = 0; e < 4; ++e) w[e] = pack2(t[(kc + 2 * e) * 65 + n], t[(kc + 2 * e + 1) * 65 + n]);
    *(uint4*)(dst + (size_t)(n0 + n) * ldd + k0 + kc) = make_uint4(w[0], w[1], w[2], w[3]);
  }
}

__device__ __forceinline__ void phase0(const Params& p, int bid, int nb, char* smem) {
  const int tid = threadIdx.x, lane = tid & 63, wave = tid >> 6;
  u16* xb = (u16*)(p.ws + WS_X);
  float* r1 = (float*)(p.ws + WS_R1);
  float* ab = (float*)(p.ws + WS_AB);
  float* ss2 = (float*)(p.ws + WS_SS2);
  float* ss3 = (float*)(p.ws + WS_SS3);
  for (int i = bid * 256 + tid; i < NT; i += nb * 256) { ss2[i] = 0.f; ss3[i] = 0.f; }
  {
    u16* pb = (u16*)(p.ws + WS_PB2);
  for (int i = bid * 256 + tid; i < NT * 32; i += nb * 256) {
    int row = i >> 5, c = (i & 31) * 8;
    const float* pr = row < NP ? p.p_prompt + (size_t)row * 256 : p.p_sample + (size_t)(row - NP) * 256;
    float4 a = *(const float4*)(pr + c), bq = *(const float4*)(pr + c + 4);
    *(uint4*)(pb + (size_t)row * 256 + c) = make_uint4(pack2(a.x, a.y), pack2(a.z, a.w), pack2(bq.x, bq.y), pack2(bq.z, bq.w));
  }
  }
  for (int it = bid; it < 1536; it += nb) {
    if (it < 896) { int kt = it / 56, nt = it % 56; transpose_tile(p.w_in, DIN, p.norm_mix_g, (u16*)(p.ws + WS_WIN), 1024, kt * 64, nt * 64, smem); }
    else if (it < 960) { int j = it - 896; transpose_tile(p.conv_pw_w, 512, nullptr, (u16*)(p.ws + WS_PW), 512, (j >> 3) * 64, (j & 7) * 64, smem); }
    else if (it < 1216) { int j = it - 960; transpose_tile(p.w_out, 1024, nullptr, (u16*)(p.ws + WS_WOUT), 1024, (j >> 4) * 64, (j & 15) * 64, smem); }
    else if (it < 1472) { int j = it - 1216; transpose_tile(p.ple_gate_w, 1024, p.ple_norm_g, (u16*)(p.ws + WS_GATE), 1024, (j >> 4) * 64, (j & 15) * 64, smem); }
    else { int j = it - 1472; transpose_tile(p.ple_proj_w, 1024, nullptr, (u16*)(p.ws + WS_PPROJ), 256, (j >> 4) * 64, (j & 15) * 64, smem); }
  }
  float* tl = (float*)smem;
  __syncthreads();
#pragma unroll
  for (int it = 0; it < 4; ++it) {
    int k = tid + it * 256;
    const float4* wt = (const float4*)(p.w_in + (size_t)k * DIN + DPJ);
    float4 w0 = wt[0], w1 = wt[1];
    float gg = p.norm_mix_g[k];
    tl[0 * 1024 + k] = w0.x * gg; tl[1 * 1024 + k] = w0.y * gg; tl[2 * 1024 + k] = w0.z * gg; tl[3 * 1024 + k] = w0.w * gg;
    tl[4 * 1024 + k] = w1.x * gg; tl[5 * 1024 + k] = w1.y * gg; tl[6 * 1024 + k] = w1.z * gg; tl[7 * 1024 + k] = w1.w * gg;
  }
  __syncthreads();
  for (int row = bid * 4 + wave; row < NT; row += nb * 4) {
    const float* xr = xrow(p, row);
    float ss = 0.f;
    float d[8] = {0, 0, 0, 0, 0, 0, 0, 0};
#pragma unroll
    for (int it = 0; it < 4; ++it) {
      int k = it * 256 + lane * 4;
      float4 v = *(const float4*)(xr + k);
      ss += v.x * v.x + v.y * v.y + v.z * v.z + v.w * v.w;
      *(uint2*)(xb + (size_t)row * 1024 + k) = make_uint2(pack2(v.x, v.y), pack2(v.z, v.w));
#pragma unroll
      for (int j = 0; j < 8; ++j) {
        float4 w = *(const float4*)(tl + j * 1024 + k);
        d[j] += v.x * w.x + v.y * w.y + v.z * w.z + v.w * w.w;
      }
    }
    ss = wave_sum(ss);
#pragma unroll
    for (int j = 0; j < 8; ++j) d[j] = wave_sum(d[j]);
    float r = rsqrtf(ss * (1.f / 1024.f) + EPS);
    if (lane == 0) {
      r1[row] = r;
      *(float4*)(ab + (size_t)row * 8) = make_float4(d[0] * r, d[1] * r, d[2] * r, d[3] * r);
      *(float4*)(ab + (size_t)row * 8 + 4) = make_float4(d[4] * r, d[5] * r, d[6] * r, d[7] * r);
    }
  }
}

struct TileWalk { int q, step, total, mbase, nN; bool banded; };
__device__ __forceinline__ TileWalk tile_walk(int nN, int bid, int nb) {
  TileWalk w; w.nN = nN;
  if ((nb & 7) == 0) { w.banded = true; w.q = bid >> 3; w.step = nb >> 3; w.total = 17 * nN; w.mbase = 17 * (bid & 7); }
  else { w.banded = false; w.q = bid; w.step = nb; w.total = 136 * nN; w.mbase = 0; }
  return w;
}
__device__ __forceinline__ void tile_get(const TileWalk& w, int q, int& mt, int& nt) {
  if (w.banded) {
    if (q < 9 * w.nN) { mt = w.mbase + q % 9; nt = q / 9; }
    else { int q2 = q - 9 * w.nN; mt = w.mbase + 9 + (q2 & 7); nt = q2 >> 3; }
  } else { mt = q / w.nN; nt = q % w.nN; }
}
__device__ __forceinline__ void phase1(const Params& p, int bid, int nb, char* smem) {
  const u16* xb = (const u16*)(p.ws + WS_X);
  const u16* wt = (const u16*)(p.ws + WS_WIN);
  const float* r1 = (const float*)(p.ws + WS_R1);
  u16* proj = (u16*)(p.ws + WS_PROJ);
  const TileWalk tw = tile_walk(28, bid, nb);
  for (int t = tw.q; t < tw.total; t += tw.step) {
    int mt_, nt_;
    tile_get(tw, t, mt_, nt_);
    int m0 = mt_ * 128, n0 = nt_ * 128;
    f32x4 acc[4][4];
#pragma unroll
    for (int i = 0; i < 4; ++i)
#pragma unroll
      for (int j = 0; j < 4; ++j) acc[i][j] = f32x4{0, 0, 0, 0};
    gemm128(xb + (size_t)m0 * 1024, 1024, wt + (size_t)n0 * 1024, 1024, 1024, smem, acc);
    GEMM_EPILOGUE(acc, m0, n0, {
      float r = r1[row];
      *(uint2*)(proj + (size_t)row * DPJ + col) = make_uint2(pack2(v[0] * r, v[1] * r), pack2(v[2] * r, v[3] * r));
    })
  }
}

template <bool SAMPLE>
__device__ __forceinline__ void conv_tile(const Params& p, int item, char* smem) {
  constexpr int NTK = SAMPLE ? 8 : 32;
  const int tid = threadIdx.x, lane = tid & 63, wave = tid >> 6;
  const u16* proj = (const u16*)(p.ws + WS_PROJ);
  u16* cact = (u16*)((char*)p.out + YS_CACT);
  int b, pos0, row0;
  if (SAMPLE) { b = item; pos0 = 0; row0 = NP + b * 8; }
  else { b = item >> 6; pos0 = (item & 63) * 32; row0 = b * SEQ + pos0; }
  float* Y = (float*)smem;
  const float* cw_ = p.conv_dw_w;
  const float* lng_ = p.conv_ln_g;
  const float* lnb_ = p.conv_ln_b;
  const float* cb_ = p.conv_dw_b;
  asm volatile("" : "+s"(cw_), "+s"(lng_), "+s"(lnb_), "+s"(cb_));
  const bool write_tail = SAMPLE || ((item & 63) == 63);
  constexpr int NR = NTK + 30, GR = 16, NG = (NR + GR - 1) / GR;
  __syncthreads();
#pragma unroll 1
  for (int cp = 0; cp < 2; ++cp) {
    const int c0 = tid + cp * 256;
    float w0[31];
#pragma unroll
    for (int j = 0; j < 31; ++j) w0[j] = cw_[j * 512 + c0];
    float a0[NTK];
#pragma unroll
    for (int t = 0; t < NTK; ++t) a0[t] = 0.f;
    uint32_t ca[GR], cb[GR], na[GR], nb2[GR];
#define CONV_LOAD(r_, A_, B_)                                                                   \
  {                                                                                             \
    A_ = 0; B_ = 0;                                                                             \
    if ((r_) < NR) {                                                                            \
      if (SAMPLE && (r_) < 30) {                                                                \
        A_ = __float_as_uint(p.state_conv[((size_t)b * 30 + (r_)) * 512 + c0]);                 \
      } else {                                                                                  \
        int pos_ = pos0 - 30 + (r_);                                                            \
        int pc_ = pos_ < 0 ? 0 : pos_;                                                          \
        size_t prow_ = SAMPLE ? (size_t)(row0 + (r_) - 30) : (size_t)(b * SEQ + pc_);           \
        uint32_t la_ = proj[prow_ * DPJ + C_GLUA + c0];                                         \
        uint32_t lb_ = proj[prow_ * DPJ + C_GLUB + c0];                                         \
        A_ = (!SAMPLE && pos_ < 0) ? 0u : la_;                                                  \
        B_ = (!SAMPLE && pos_ < 0) ? 0u : lb_;                                                  \
      }                                                                                         \
    }                                                                                           \
  }
#pragma unroll
    for (int rr = 0; rr < GR; ++rr) CONV_LOAD(rr, ca[rr], cb[rr])
#pragma unroll
    for (int gq = 0; gq < NG; ++gq) {
      if (gq + 1 < NG) {
#pragma unroll
        for (int rr = 0; rr < GR; ++rr) CONV_LOAD((gq + 1) * GR + rr, na[rr], nb2[rr])
      }
#pragma unroll
      for (int rr = 0; rr < GR; ++rr) {
        const int r = gq * GR + rr;
        if (r < NR) {
          float u0;
          if (SAMPLE && r < 30) u0 = __uint_as_float(ca[rr]);
          else u0 = bf2f((u16)ca[rr]) * sigmoidf_(bf2f((u16)cb[rr]));
          if (SAMPLE) {
            if (r >= 8) p.out[O_NCS + ((size_t)b * 30 + (r - 8)) * 512 + c0] = u0;
          } else {
            if (write_tail && r >= 32) p.out[O_NCP + ((size_t)b * 30 + (r - 32)) * 512 + c0] = u0;
          }
#pragma unroll
          for (int t = 0; t < NTK; ++t) {
            if (r - t >= 0 && r - t <= 30) a0[t] += w0[r - t] * u0;
          }
        }
      }
#pragma unroll
      for (int rr = 0; rr < GR; ++rr) { ca[rr] = na[rr]; cb[rr] = nb2[rr]; }
      __builtin_amdgcn_sched_barrier(0);
    }
    const float bias = cb_[c0];
#pragma unroll
    for (int t = 0; t < NTK; ++t) Y[t * 512 + c0] = a0[t] + bias;
  }
  __syncthreads();
  for (int t = wave; t < NTK; t += 4) {
    float4 v0 = *(const float4*)(Y + t * 512 + lane * 8);
    float4 v1 = *(const float4*)(Y + t * 512 + lane * 8 + 4);
    float xv[8] = {v0.x, v0.y, v0.z, v0.w, v1.x, v1.y, v1.z, v1.w};
    float s = 0.f;
#pragma unroll
    for (int e = 0; e < 8; ++e) s += xv[e];
    float mean = wave_sum(s) * (1.f / 512.f);
    float q = 0.f;
#pragma unroll
    for (int e = 0; e < 8; ++e) { xv[e] -= mean; q += xv[e] * xv[e]; }
    float rstd = rsqrtf(wave_sum(q) * (1.f / 512.f) + EPS);
    float4 g0 = *(const float4*)(lng_ + lane * 8), g1 = *(const float4*)(lng_ + lane * 8 + 4);
    float4 b0 = *(const float4*)(lnb_ + lane * 8), b1 = *(const float4*)(lnb_ + lane * 8 + 4);
    float gg[8] = {g0.x, g0.y, g0.z, g0.w, g1.x, g1.y, g1.z, g1.w};
    float bb[8] = {b0.x, b0.y, b0.z, b0.w, b1.x, b1.y, b1.z, b1.w};
    float o[8];
#pragma unroll
    for (int e = 0; e < 8; ++e) o[e] = siluf_(xv[e] * rstd * gg[e] + bb[e]);
    *(uint4*)(cact + (size_t)(row0 + t) * 512 + lane * 8) =
        make_uint4(pack2(o[0], o[1]), pack2(o[2], o[3]), pack2(o[4], o[5]), pack2(o[6], o[7]));
  }
}

template <bool SAMPLE> __device__ __forceinline__ constexpr int fidx_w(int mt, int ks) { return SAMPLE ? ks : (mt >> 1) * 26 + (mt & 1) * 4 + ks; }
template <bool SAMPLE> __device__ __forceinline__ constexpr int fidx_q(int mt, int ks) { return SAMPLE ? 4 + ks : (mt >> 1) * 26 + 8 + (mt & 1) * 4 + ks; }
template <bool SAMPLE> __device__ __forceinline__ constexpr int fidx_qk(int mt) { return SAMPLE ? 8 : (mt >> 1) * 26 + 16 + (mt & 1); }
template <bool SAMPLE> __device__ __forceinline__ constexpr int fidx_kd(int dt, int hf) { return SAMPLE ? 9 + dt : hf * 26 + 18 + dt; }

template <bool SAMPLE>
__device__ __forceinline__ void delta_prep(const Params& p, int item, char* smem) {
  constexpr int MT = SAMPLE ? 1 : 4, KS2 = SAMPLE ? 1 : 2, NI = SAMPLE ? 8 : 64;
  const int tid = threadIdx.x, lane = tid & 63, wave = tid >> 6, m = lane & 15, g = lane >> 4;
  const u16* proj = (const u16*)(p.ws + WS_PROJ);
  const float* ab = (const float*)(p.ws + WS_AB);
  int b, h, row0, pos0, chunk;
  uint4* fa; float4* uf;
  if (SAMPLE) {
    b = item >> 2; h = item & 3; row0 = NP + b * 8; pos0 = 0; chunk = 1024 + item;
    fa = (uint4*)(p.ws + WS_FRAG + 1024 * FRAG_P_BYTES + (size_t)item * FRAG_S_BYTES);
    uf = (float4*)((char*)p.out + YS_UF + 1024 * UF_P_BYTES + (size_t)item * UF_S_BYTES);
  } else {
    int bh = item >> 5, n = item & 31; b = bh >> 2; h = bh & 3; pos0 = n * 64; row0 = b * SEQ + pos0; chunk = item;
    fa = (uint4*)(p.ws + WS_FRAG + (size_t)item * FRAG_P_BYTES);
    uf = (float4*)((char*)p.out + YS_UF + (size_t)item * UF_P_BYTES);
  }
  u16* KN = (u16*)smem;
  u16* QN = KN + 64 * 136;
  float* AM = (float*)(QN + 64 * 136);
  float* gcs = AM + 64 * 64;
  float* bts = gcs + 64;
  __syncthreads();
  if (wave == 0) {
    int i = lane; float gi = 0.f, bi = 0.f;
    if (i < NI) {
      const float* abr = ab + (size_t)(row0 + i) * 8;
      bi = sigmoidf_(abr[h]);
      float a = abr[4 + h] + p.dn_dt_bias[h];
      float sp = a > 20.f ? a : log1pf(expf(a));
      gi = -expf(p.dn_a_log[h]) * sp;
    }
    float c = gi;
#pragma unroll
    for (int off = 1; off < 64; off <<= 1) { float t = __shfl_up(c, off); if (lane >= off) c += t; }
    if (!SAMPLE) { float c31 = __shfl(c, 31); if (lane >= 32) c -= c31; }
    gcs[i] = c; bts[i] = bi;
  }
  __syncthreads();
  {
    const int sec = tid >> 7, c = tid & 127;
    const int col = sec * 512 + h * 128 + c;
    u16* dstm = sec ? KN : QN;
    const float w0 = p.dn_conv_w[col], w1 = p.dn_conv_w[1536 + col], w2 = p.dn_conv_w[2 * 1536 + col], w3 = p.dn_conv_w[3 * 1536 + col];
    float rr[3];
#pragma unroll
    for (int jj = 0; jj < 3; ++jj) {
      if (SAMPLE) rr[jj] = p.state_dn_conv[((size_t)b * 3 + jj) * 1536 + col];
      else rr[jj] = (pos0 > 0) ? bf2f(proj[(size_t)(row0 - 3 + jj) * DPJ + C_QKV + col]) : 0.f;
    }
    float ra = rr[0], rb = rr[1], rc = rr[2];
    const u16* pcol = proj + (size_t)row0 * DPJ + C_QKV + col;
    u16 raw[NI];
#pragma unroll
    for (int i = 0; i < NI; ++i) raw[i] = pcol[(size_t)i * DPJ];
#pragma unroll
    for (int i = 0; i < NI; ++i) {
      float rd = bf2f(raw[i]);
      float v = siluf_(w0 * ra + w1 * rb + w2 * rc + w3 * rd);
      dstm[i * 136 + c] = f2bf(v);
      ra = rb; rb = rc; rc = rd;
    }
#pragma unroll
    for (int i = NI; i < 64; ++i) dstm[i * 136 + c] = 0;
  }
  __syncthreads();
  {
    const int i = wave * 16 + m;
    const bool valid = i < NI;
    float eq[32], ek[32];
#pragma unroll
    for (int kh = 0; kh < 8; ++kh) {
      const int cc = (kh >> 1) * 32 + (kh & 1) * 16 + 4 * g;
      uint2 kv = *(const uint2*)(KN + i * 136 + cc);
      uint2 qv = *(const uint2*)(QN + i * 136 + cc);
      ek[kh * 4] = bflo(kv.x); ek[kh * 4 + 1] = bfhi(kv.x); ek[kh * 4 + 2] = bflo(kv.y); ek[kh * 4 + 3] = bfhi(kv.y);
      eq[kh * 4] = bflo(qv.x); eq[kh * 4 + 1] = bfhi(qv.x); eq[kh * 4 + 2] = bflo(qv.y); eq[kh * 4 + 3] = bfhi(qv.y);
    }
    float sq = 0.f, sk = 0.f;
#pragma unroll
    for (int e = 0; e < 32; ++e) { sq += eq[e] * eq[e]; sk += ek[e] * ek[e]; }
    sq += __shfl_xor(sq, 16); sq += __shfl_xor(sq, 32);
    sk += __shfl_xor(sk, 16); sk += __shfl_xor(sk, 32);
    const float rq = valid ? rsqrtf(sq + EPS) * 0.08838834764831845f : 0.f;
    const float rk = valid ? rsqrtf(sk + EPS) : 0.f;
#pragma unroll
    for (int e = 0; e < 32; ++e) { eq[e] *= rq; ek[e] *= rk; }
#pragma unroll
    for (int kh = 0; kh < 8; ++kh) {
      const int cc = (kh >> 1) * 32 + (kh & 1) * 16 + 4 * g;
      *(uint2*)(KN + i * 136 + cc) = make_uint2(pack2(ek[kh * 4], ek[kh * 4 + 1]), pack2(ek[kh * 4 + 2], ek[kh * 4 + 3]));
      *(uint2*)(QN + i * 136 + cc) = make_uint2(pack2(eq[kh * 4], eq[kh * 4 + 1]), pack2(eq[kh * 4 + 2], eq[kh * 4 + 3]));
    }
    if (wave < MT) {
      const float ei = __expf(gcs[i]);
#pragma unroll
      for (int ks = 0; ks < 4; ++ks) {
        const int e0 = ks * 8;
        fa[fidx_q<SAMPLE>(wave, ks) * 64 + lane] =
            make_uint4(pack2(eq[e0] * ei, eq[e0 + 1] * ei), pack2(eq[e0 + 2] * ei, eq[e0 + 3] * ei),
                       pack2(eq[e0 + 4] * ei, eq[e0 + 5] * ei), pack2(eq[e0 + 6] * ei, eq[e0 + 7] * ei));
      }
    }
  }
  __syncthreads();
  if (wave < MT) {
    const int it = wave;
    bf16x8 knI[4], qnI[4];
#pragma unroll
    for (int ks = 0; ks < 4; ++ks) {
      knI[ks] = *(const bf16x8*)(KN + (16 * it + m) * 136 + 32 * ks + 8 * g);
      qnI[ks] = *(const bf16x8*)(QN + (16 * it + m) * 136 + 32 * ks + 8 * g);
    }
    f32x4 qkv_[4];
#pragma unroll
    for (int jt = 0; jt < 4; ++jt) qkv_[jt] = f32x4{0, 0, 0, 0};
    const float gi_n = gcs[16 * it + m];
#pragma unroll
    for (int jt = 0; jt < 4; ++jt) {
      if (jt <= it && (SAMPLE || (jt >> 1) == (it >> 1))) {
        bf16x8 knJ[4];
#pragma unroll
        for (int ks = 0; ks < 4; ++ks) knJ[ks] = *(const bf16x8*)(KN + (16 * jt + m) * 136 + 32 * ks + 8 * g);
        f32x4 aa = f32x4{0, 0, 0, 0}, qq = f32x4{0, 0, 0, 0};
#pragma unroll
        for (int ks = 0; ks < 4; ++ks) { aa = MFMA(knI[ks], knJ[ks], aa); qq = MFMA(knJ[ks], qnI[ks], qq); }
        const int jA = 16 * jt + m;
        const float gj = gcs[jA];
#pragma unroll
        for (int r = 0; r < 4; ++r) {
          const int iA = 16 * it + 4 * g + r;
          float val = (jA < iA) ? bts[iA] * __expf(gcs[iA] - gj) * aa[r] : 0.f;
          AM[iA * 64 + jA] = val;
        }
        const int iQ = 16 * it + m;
#pragma unroll
        for (int r = 0; r < 4; ++r) {
          const int jQ = 16 * jt + 4 * g + r;
          qkv_[jt][r] = (jQ <= iQ) ? __expf(gi_n - gcs[jQ]) * qq[r] : 0.f;
        }
      }
    }
    {
      const bool up = !SAMPLE && (it >> 1);
      f32x4 lo = up ? qkv_[2] : qkv_[0], hi = up ? qkv_[3] : qkv_[1];
      fa[fidx_qk<SAMPLE>(it) * 64 + lane] =
          make_uint4(pack2(lo[0], lo[1]), pack2(lo[2], lo[3]), pack2(hi[0], hi[1]), pack2(hi[2], hi[3]));
    }
  }
  {
#pragma unroll
    for (int dd = 0; dd < 2; ++dd) {
      const int dt = 2 * wave + dd;
#pragma unroll
      for (int hf = 0; hf < KS2; ++hf) {
        const float gl = gcs[SAMPLE ? 63 : 32 * hf + 31];
        float vv[8];
#pragma unroll
        for (int e = 0; e < 8; ++e) {
          const int i = 32 * hf + (e >> 2) * 16 + 4 * g + (e & 3);
          vv[e] = bf2f(KN[i * 136 + 16 * dt + m]) * __expf(gl - gcs[i]);
        }
        fa[fidx_kd<SAMPLE>(dt, hf) * 64 + lane] =
            make_uint4(pack2(vv[0], vv[1]), pack2(vv[2], vv[3]), pack2(vv[4], vv[5]), pack2(vv[6], vv[7]));
      }
    }
    if (tid == 0) {
      float* gla = (float*)(p.ws + WS_GLAST);
      if (SAMPLE) gla[2048 + item] = __expf(gcs[63]);
      else { gla[2 * item] = __expf(gcs[31]); gla[2 * item + 1] = __expf(gcs[63]); }
    }
  }
  __syncthreads();
  float x[NI];
  {
  if (tid < 128) {
    const int dv = tid;
    const int col = 1024 + h * 128 + dv;
    const float w0 = p.dn_conv_w[col], w1 = p.dn_conv_w[1536 + col], w2 = p.dn_conv_w[2 * 1536 + col], w3 = p.dn_conv_w[3 * 1536 + col];
    float rr[3];
#pragma unroll
    for (int jj = 0; jj < 3; ++jj) {
      if (SAMPLE) rr[jj] = p.state_dn_conv[((size_t)b * 3 + jj) * 1536 + col];
      else rr[jj] = (pos0 > 0) ? bf2f(proj[(size_t)(row0 - 3 + jj) * DPJ + C_QKV + col]) : 0.f;
    }
    float ra = rr[0], rb = rr[1], rc = rr[2];
    const u16* pcol = proj + (size_t)row0 * DPJ + C_QKV + col;
#pragma unroll
    for (int i = 0; i < NI; ++i) x[i] = bf2f(pcol[(size_t)i * DPJ]);
    __builtin_amdgcn_sched_barrier(0);
#pragma unroll
    for (int i = 0; i < NI; ++i) {
      float rd = x[i];
      float v = siluf_(w0 * ra + w1 * rb + w2 * rc + w3 * rd);
      x[i] = bts[i] * v;
      ra = rb; rb = rc; rc = rd;
    }
  } else {
    const int dk = tid - 128;
#pragma unroll
    for (int i = 0; i < NI; ++i) x[i] = bts[i] * __expf(gcs[i]) * bf2f(KN[i * 136 + dk]);
  }
  {
    constexpr int NSUB = SAMPLE ? 1 : 2, NLI = SAMPLE ? 8 : 32;
#pragma unroll
    for (int hf = 0; hf < NSUB; ++hf) {
      float4 ac[8], an[8];
#pragma unroll
      for (int j4 = 0; j4 < 8; ++j4) { ac[j4] = make_float4(0, 0, 0, 0); an[j4] = make_float4(0, 0, 0, 0); }
      ac[0] = *(const float4*)(AM + (32 * hf + 1) * 64 + 32 * hf);
#pragma unroll
      for (int li = 1; li < NLI; ++li) {
        if (li + 1 < NLI) {
#pragma unroll
          for (int j4 = 0; j4 < 8; ++j4)
            if (j4 < (li + 4) / 4) an[j4] = *(const float4*)(AM + (32 * hf + li + 1) * 64 + 32 * hf + j4 * 4);
        }
        float acc0 = x[32 * hf + li], acc1 = 0.f;
#pragma unroll
        for (int j4 = 0; j4 < 8; ++j4) {
          if (j4 < (li + 3) / 4) {
            float4 a = ac[j4];
            if (j4 * 4 + 0 < li) acc0 -= a.x * x[32 * hf + j4 * 4 + 0];
            if (j4 * 4 + 1 < li) acc1 -= a.y * x[32 * hf + j4 * 4 + 1];
            if (j4 * 4 + 2 < li) acc0 -= a.z * x[32 * hf + j4 * 4 + 2];
            if (j4 * 4 + 3 < li) acc1 -= a.w * x[32 * hf + j4 * 4 + 3];
          }
        }
        x[32 * hf + li] = acc0 + acc1;
#pragma unroll
        for (int j4 = 0; j4 < 8; ++j4) ac[j4] = an[j4];
        __builtin_amdgcn_sched_barrier(0);
      }
    }
  }
  }
  __syncthreads();
  u16* WM = KN;
  if (tid < 128) {
    const int dv = tid, s = dv >> 4, n = dv & 15;
#pragma unroll
    for (int mt = 0; mt < MT; ++mt)
#pragma unroll
      for (int g4 = 0; g4 < 4; ++g4) {
        const int i0 = 16 * mt + 4 * g4;
        float4 o;
        o.x = (i0 + 0 < NI) ? x[(i0 + 0 < NI) ? i0 + 0 : 0] : 0.f;
        o.y = (i0 + 1 < NI) ? x[(i0 + 1 < NI) ? i0 + 1 : 0] : 0.f;
        o.z = (i0 + 2 < NI) ? x[(i0 + 2 < NI) ? i0 + 2 : 0] : 0.f;
        o.w = (i0 + 3 < NI) ? x[(i0 + 3 < NI) ? i0 + 3 : 0] : 0.f;
        uf[(s * MT + mt) * 64 + g4 * 16 + n] = o;
      }
  } else {
    const int dk = tid - 128;
#pragma unroll
    for (int i = 0; i < 16 * MT; ++i) WM[i * 136 + dk] = (i < NI) ? f2bf(-x[(i < NI) ? i : 0]) : (u16)0;
  }
  __syncthreads();
  {
    const int mt = SAMPLE ? 0 : wave;
#pragma unroll
    for (int q = 0; q < (SAMPLE ? 1 : 4); ++q) {
      const int ks = SAMPLE ? wave : q;
      uint2 lo = *(const uint2*)(WM + (16 * mt + m) * 136 + 32 * ks + 4 * g);
      uint2 hi = *(const uint2*)(WM + (16 * mt + m) * 136 + 32 * ks + 16 + 4 * g);
      fa[fidx_w<SAMPLE>(mt, ks) * 64 + lane] = make_uint4(lo.x, lo.y, hi.x, hi.y);
    }
  }
  if (SAMPLE || (item & 31) == 31) {
    float* dst = p.out + (SAMPLE ? O_NDS : O_NDP);
    for (int idx = tid; idx < 3 * 384; idx += 256) {
      int j = idx / 384, cc = idx % 384, sec = cc >> 7, c = cc & 127;
      int col = sec * 512 + h * 128 + c;
      dst[((size_t)b * 3 + j) * 1536 + col] = bf2f(proj[(size_t)(row0 + NI - 3 + j) * DPJ + C_QKV + col]);
    }
  }
}

template <bool SAMPLE>
__device__ __forceinline__ void delta_seq(const Params& p, int item, char* smem) {
  constexpr int MT = SAMPLE ? 1 : 4, KS2 = SAMPLE ? 1 : 2, NI = SAMPLE ? 8 : 64, NC = SAMPLE ? 1 : 32;
  constexpr int NF = MT * 8 + MT * KS2 + 8 * KS2;
  static_assert(SAMPLE, "prompt chains use delta_seq_p");
  constexpr int W_OFF = 0, Q_OFF = MT * 4, QK_OFF = MT * 8, KD_OFF = MT * 8 + MT * KS2;
  constexpr int NPRE = (NF * 64 + 255) / 256;
  const int tid = threadIdx.x, lane = tid & 63, wave = tid >> 6, n = lane & 15, g = lane >> 4;
  const int bh = item >> 1, half = item & 1, b = bh >> 2, h = bh & 3;
  const int s = half * 4 + wave;
  const float* glast = (const float*)(p.ws + WS_GLAST);
  u16* ofp = (u16*)(p.ws + WS_X);
  const uint4* fa0; const float4* uf0; int chunk0, row00;
  if (SAMPLE) {
    fa0 = (const uint4*)(p.ws + WS_FRAG + 1024 * FRAG_P_BYTES + (size_t)bh * FRAG_S_BYTES);
    uf0 = (const float4*)((char*)p.out + YS_UF + 1024 * UF_P_BYTES + (size_t)bh * UF_S_BYTES);
    chunk0 = 2048 + bh; row00 = NP + b * 8;
  } else {
    fa0 = (const uint4*)(p.ws + WS_FRAG + (size_t)bh * 32 * FRAG_P_BYTES);
    uf0 = (const float4*)((char*)p.out + YS_UF + (size_t)bh * 32 * UF_P_BYTES);
    chunk0 = bh * 32; row00 = b * SEQ;
  }
  constexpr size_t FSTR = (SAMPLE ? FRAG_S_BYTES : FRAG_P_BYTES) / 16, USTR = (SAMPLE ? UF_S_BYTES : UF_P_BYTES) / 16;
  uint4* L = (uint4*)smem;
  f32x4 S[8];
  if (SAMPLE) {
    const float* s0 = p.state_dn_S + (size_t)bh * 16384;
#pragma unroll
    for (int dt = 0; dt < 8; ++dt)
#pragma unroll
      for (int r = 0; r < 4; ++r) S[dt][r] = s0[(16 * dt + 4 * g + r) * 128 + 16 * s + n];
  } else {
#pragma unroll
    for (int dt = 0; dt < 8; ++dt) S[dt] = f32x4{0, 0, 0, 0};
  }
  uint4 pre[NPRE];
  f32x4 upre[MT];
  float glpre;
#define SEQ_PREFETCH(c_)                                                                     \
  {                                                                                          \
    const uint4* fa_ = fa0 + (size_t)(c_) * FSTR;                                            \
    _Pragma("unroll") for (int q = 0; q < NPRE; ++q) {                                       \
      int idx = tid + q * 256;                                                               \
      pre[q] = (NF * 64 % 256 == 0 || idx < NF * 64) ? fa_[idx] : make_uint4(0, 0, 0, 0);   \
    }                                                                                        \
    const float4* uf_ = uf0 + (size_t)(c_) * USTR;                                           \
    _Pragma("unroll") for (int mt = 0; mt < MT; ++mt) {                                      \
      float4 t = uf_[(s * MT + mt) * 64 + lane];                                             \
      upre[mt] = f32x4{t.x, t.y, t.z, t.w};                                                  \
    }                                                                                        \
    glpre = glast[chunk0 + (c_)];                                                            \
  }
  SEQ_PREFETCH(0)
#pragma unroll 1
  for (int c = 0; c < NC; ++c) {
    __syncthreads();
#pragma unroll
    for (int q = 0; q < NPRE; ++q) {
      int idx = tid + q * 256;
      if (NF * 64 % 256 == 0 || idx < NF * 64) L[idx] = pre[q];
    }
    f32x4 accV[MT], accO[MT];
#pragma unroll
    for (int mt = 0; mt < MT; ++mt) { accV[mt] = upre[mt]; accO[mt] = f32x4{0, 0, 0, 0}; }
    const float gl = glpre;
    __syncthreads();
    if (c + 1 < NC) SEQ_PREFETCH(c + 1)
    bf16x8 Sb[4];
#pragma unroll
    for (int ks = 0; ks < 4; ++ks)
      Sb[ks] = mk8(pack2(S[2 * ks][0], S[2 * ks][1]), pack2(S[2 * ks][2], S[2 * ks][3]),
                   pack2(S[2 * ks + 1][0], S[2 * ks + 1][1]), pack2(S[2 * ks + 1][2], S[2 * ks + 1][3]));
#pragma unroll
    for (int mt = 0; mt < MT; ++mt)
#pragma unroll
      for (int ks = 0; ks < 4; ++ks) {
        accV[mt] = MFMA(u4_to_b8(L[(W_OFF + mt * 4 + ks) * 64 + lane]), Sb[ks], accV[mt]);
        accO[mt] = MFMA(u4_to_b8(L[(Q_OFF + mt * 4 + ks) * 64 + lane]), Sb[ks], accO[mt]);
        if (ks == 3) __builtin_amdgcn_sched_barrier(0);
      }
    bf16x8 Vb[KS2];
#pragma unroll
    for (int ks2 = 0; ks2 < KS2; ++ks2) {
      f32x4 lo = accV[(2 * ks2 < MT) ? 2 * ks2 : 0];
      f32x4 hi = (2 * ks2 + 1 < MT) ? accV[(2 * ks2 + 1 < MT) ? 2 * ks2 + 1 : 0] : f32x4{0, 0, 0, 0};
      Vb[ks2] = mk8(pack2(lo[0], lo[1]), pack2(lo[2], lo[3]), pack2(hi[0], hi[1]), pack2(hi[2], hi[3]));
    }
#pragma unroll
    for (int mt = 0; mt < MT; ++mt)
#pragma unroll
      for (int ks2 = 0; ks2 < KS2; ++ks2)
        accO[mt] = MFMA(u4_to_b8(L[(QK_OFF + mt * KS2 + ks2) * 64 + lane]), Vb[ks2], accO[mt]);
#pragma unroll
    for (int dt = 0; dt < 8; ++dt) {
      S[dt] = S[dt] * gl;
#pragma unroll
      for (int ks2 = 0; ks2 < KS2; ++ks2)
        S[dt] = MFMA(u4_to_b8(L[(KD_OFF + dt * KS2 + ks2) * 64 + lane]), Vb[ks2], S[dt]);
      if (dt & 1) __builtin_amdgcn_sched_barrier(0);
    }
    const int rowc = row00 + c * 64;
#pragma unroll
    for (int mt = 0; mt < MT; ++mt)
#pragma unroll
      for (int r = 0; r < 4; ++r) {
        const int i = 16 * mt + 4 * g + r;
        if (i < NI) ofp[(size_t)(rowc + i) * 512 + h * 128 + 16 * s + n] = f2bf(accO[mt][r]);
      }
  }
  float* so = p.out + (SAMPLE ? O_NSS : O_NSP) + (size_t)bh * 16384;
#pragma unroll
  for (int dt = 0; dt < 8; ++dt)
#pragma unroll
    for (int r = 0; r < 4; ++r) so[(16 * dt + 4 * g + r) * 128 + 16 * s + n] = S[dt][r];
  __syncthreads();
}


__device__ __forceinline__ void delta_seq_p(const Params& p, int item, char* smem) {
  constexpr int NFH = 26, NH = 64;
  constexpr int W_OFF = 0, Q_OFF = 8, QK_OFF = 16, KD_OFF = 18;
  constexpr int NV = NFH * 64;
  constexpr int NPRE = (NV + 255) / 256;
  const int tid = threadIdx.x, lane = tid & 63, wave = tid >> 6, n = lane & 15, g = lane >> 4;
  const int bh = item >> 1, half = item & 1, b = bh >> 2, h = bh & 3;
  const int s = half * 4 + wave;
  const float* glast = (const float*)(p.ws + WS_GLAST) + (size_t)bh * 64;
  u16* ofp = (u16*)(p.ws + WS_X);
  const uint4* fa0 = (const uint4*)(p.ws + WS_FRAG + (size_t)bh * 32 * FRAG_P_BYTES);
  const float4* uf0 = (const float4*)((char*)p.out + YS_UF + (size_t)bh * 32 * UF_P_BYTES);
  const int row00 = b * SEQ;
  uint4* L = (uint4*)smem;
  f32x4 S[8];
#pragma unroll
  for (int dt = 0; dt < 8; ++dt) S[dt] = f32x4{0, 0, 0, 0};
  uint4 PA[NPRE], PB[NPRE];
  f32x4 UA[2], UB[2];
  float GA = 0.f, GB = 0.f; (void)GA; (void)GB;
  constexpr int TOUCH_AHEAD = 8;
  uint32_t TA = 0, TB = 0, tsink = 0;
#define SEQP_TOUCH(T_, hs_)                                                                     \
  {                                                                                             \
    tsink ^= T_;                                                                                \
    const int ht_ = (hs_) + TOUCH_AHEAD;                                                        \
    if (ht_ < NH) {                                                                             \
      const int c64_ = ht_ >> 1, hf_ = ht_ & 1;                                                 \
      const uint32_t* fl_ = (const uint32_t*)(fa0 + (size_t)c64_ * (FRAG_P_BYTES / 16) + hf_ * NV);  \
      const uint32_t* ul_ = (const uint32_t*)(uf0 + (size_t)c64_ * (UF_P_BYTES / 16));            \
      uint32_t t0_ = (tid < 208) ? fl_[tid * 32] : 0u;                                          \
      uint32_t t1_ = (tid < 64) ? ul_[(((half * 4 + (tid >> 4)) * 4 + 2 * hf_ + ((tid >> 3) & 1)) * 64) * 4 + (tid & 7) * 32] : 0u; \
      T_ = t0_ ^ t1_;                                                                           \
    }                                                                                           \
  }
#define SEQP_LOAD(P_, U_, G_, hs_)                                                              \
  {                                                                                             \
    const int c64_ = (hs_) >> 1, hf_ = (hs_) & 1;                                               \
    const uint4* fa_ = fa0 + (size_t)c64_ * (FRAG_P_BYTES / 16) + hf_ * NV;                     \
    _Pragma("unroll") for (int q = 0; q < NPRE; ++q) {                                          \
      int idx = tid + q * 256;                                                                  \
      P_[q] = (idx < NV) ? fa_[idx] : make_uint4(0, 0, 0, 0);                                   \
    }                                                                                           \
    const float4* uf_ = uf0 + (size_t)c64_ * (UF_P_BYTES / 16);                                 \
    _Pragma("unroll") for (int mt = 0; mt < 2; ++mt) {                                          \
      float4 t = uf_[(s * 4 + 2 * hf_ + mt) * 64 + lane];                                       \
      U_[mt] = f32x4{t.x, t.y, t.z, t.w};                                                       \
    }                                                                                           \
  }
#define SEQP_STEP(P_, U_, G_, T_, hs_, buf_)                                                        \
  {                                                                                             \
    uint4* Lb = L + (buf_) * NV;                                                                \
    _Pragma("unroll") for (int q = 0; q < NPRE; ++q) {                                          \
      int idx = tid + q * 256;                                                                  \
      if (idx < NV) Lb[idx] = P_[q];                                                            \
    }                                                                                           \
    f32x4 accV[2], accO[2];                                                                     \
    accV[0] = U_[0]; accV[1] = U_[1];                                                           \
    accO[0] = f32x4{0, 0, 0, 0}; accO[1] = f32x4{0, 0, 0, 0};                                   \
    __syncthreads();                                                                            \
    const float gl = gls[(hs_)];                                                                \
    if ((hs_) + 2 < NH) SEQP_LOAD(P_, U_, G_, (hs_) + 2)                                        \
    bf16x8 Sb[4];                                                                               \
    _Pragma("unroll") for (int ks = 0; ks < 4; ++ks)                                            \
      Sb[ks] = mk8(pack2(S[2 * ks][0], S[2 * ks][1]), pack2(S[2 * ks][2], S[2 * ks][3]),        \
                   pack2(S[2 * ks + 1][0], S[2 * ks + 1][1]), pack2(S[2 * ks + 1][2], S[2 * ks + 1][3])); \
    _Pragma("unroll") for (int mt = 0; mt < 2; ++mt)                                            \
      _Pragma("unroll") for (int ks = 0; ks < 4; ++ks) {                                        \
        accV[mt] = MFMA(u4_to_b8(Lb[(W_OFF + mt * 4 + ks) * 64 + lane]), Sb[ks], accV[mt]);     \
        accO[mt] = MFMA(u4_to_b8(Lb[(Q_OFF + mt * 4 + ks) * 64 + lane]), Sb[ks], accO[mt]);     \
      }                                                                                         \
    __builtin_amdgcn_sched_barrier(0);                                                          \
    bf16x8 Vb = mk8(pack2(accV[0][0], accV[0][1]), pack2(accV[0][2], accV[0][3]),               \
                    pack2(accV[1][0], accV[1][1]), pack2(accV[1][2], accV[1][3]));              \
    _Pragma("unroll") for (int mt = 0; mt < 2; ++mt)                                            \
      accO[mt] = MFMA(u4_to_b8(Lb[(QK_OFF + mt) * 64 + lane]), Vb, accO[mt]);                   \
    _Pragma("unroll") for (int dt = 0; dt < 8; ++dt) {                                          \
      S[dt] = S[dt] * gl;                                                                       \
      S[dt] = MFMA(u4_to_b8(Lb[(KD_OFF + dt) * 64 + lane]), Vb, S[dt]);                         \
    }                                                                                           \
    const int rowc = row00 + (hs_) * 32;                                                        \
    _Pragma("unroll") for (int mt = 0; mt < 2; ++mt)                                            \
      _Pragma("unroll") for (int r = 0; r < 4; ++r)                                             \
        ofp[(size_t)(rowc + 16 * mt + 4 * g + r) * 512 + h * 128 + 16 * s + n] = f2bf(accO[mt][r]);   \
  }
  __syncthreads();
  float* gls = (float*)(smem + 2 * NV * 16);
  if (tid < 64) gls[tid] = glast[tid];
  SEQP_LOAD(PA, UA, GA, 0)
  SEQP_LOAD(PB, UB, GB, 1)
#pragma unroll 1
  for (int hs = 0; hs < NH; hs += 2) {
    SEQP_STEP(PA, UA, GA, TA, hs, 0)
    SEQP_STEP(PB, UB, GB, TB, hs + 1, 1)
  }
  float* so = p.out + O_NSP + (size_t)bh * 16384;
#pragma unroll
  for (int dt = 0; dt < 8; ++dt)
#pragma unroll
    for (int r = 0; r < 4; ++r) so[(16 * dt + 4 * g + r) * 128 + 16 * s + n] = S[dt][r];
  __syncthreads();
}

template <int MH>
__device__ __forceinline__ void g2_tile(const Params& p, int m0, int n0, char* smem) {
  const u16* cact = (const u16*)((const char*)p.out + YS_CACT);
  const u16* pw = (const u16*)(p.ws + WS_PW);
  const u16* proj = (const u16*)(p.ws + WS_PROJ);
  u16* cmix = (u16*)(p.ws + WS_CMIX);
  f32x4 acc[4][4];
#pragma unroll
  for (int i = 0; i < 4; ++i)
#pragma unroll
    for (int j = 0; j < 4; ++j) acc[i][j] = f32x4{0, 0, 0, 0};
  gemm128<false, MH>(cact + (size_t)m0 * 512, 512, pw + (size_t)n0 * 512, 512, 512, smem, acc);
  uint2 gpre[4][4];
  GEMM_EPILOGUE_M(acc, m0, n0, MH, { (void)v; gpre[mt][nt] = *(const uint2*)(proj + (size_t)row * DPJ + C_GATE + col); })
  GEMM_EPILOGUE_M(acc, m0, n0, MH, {
    uint2 gv = gpre[mt][nt];
    float o0 = v[0] * siluf_(bflo(gv.x)), o1 = v[1] * siluf_(bfhi(gv.x));
    float o2 = v[2] * siluf_(bflo(gv.y)), o3 = v[3] * siluf_(bfhi(gv.y));
    *(uint2*)(cmix + (size_t)row * 512 + col) = make_uint2(pack2(o0, o1), pack2(o2, o3));
  })
}


__device__ __forceinline__ void phase4(const Params& p, int bid, int nb, char* smem) {
  const int nfull4 = (544 / nb) * nb, rem4 = 544 - nfull4;
  const int nhalf4 = (2 * rem4 <= nb) ? 2 * rem4 : 0;
#pragma unroll 1
  for (int it = bid; it < (nhalf4 > 0 ? nfull4 : 544); it += nb) g2_tile<4>(p, (it >> 2) * 128, (it & 3) * 128, smem);
  if (bid < nhalf4) {
    const int it = nfull4 + (bid >> 1);
    g2_tile<2>(p, (it >> 2) * 128 + (bid & 1) * 64, (it & 3) * 128, smem);
  }
  const int tid = threadIdx.x, lane = tid & 63, wave = tid >> 6;
  const u16* ofp = (const u16*)(p.ws + WS_X);
  const u16* proj = (const u16*)(p.ws + WS_PROJ);
  u16* omix = (u16*)(p.ws + WS_OMIX);
  const int nheavy4 = nhalf4 > 0 ? nhalf4 : ((544 > nb && 544 < 2 * nb) ? 544 - nb : 0);
  if (bid < nheavy4) return;
  const int ob = bid - nheavy4, onb = nb - nheavy4;
  for (int row = ob * 4 + wave; row < NT; row += onb * 4) {
    const uint4 ov = *(const uint4*)(ofp + (size_t)row * 512 + lane * 8);
    float o[8] = {bflo(ov.x), bfhi(ov.x), bflo(ov.y), bfhi(ov.y), bflo(ov.z), bfhi(ov.z), bflo(ov.w), bfhi(ov.w)};
    float ss = 0.f;
#pragma unroll
    for (int e = 0; e < 8; ++e) ss += o[e] * o[e];
    ss += __shfl_xor(ss, 1); ss += __shfl_xor(ss, 2); ss += __shfl_xor(ss, 4); ss += __shfl_xor(ss, 8);
    float r = rsqrtf(ss * (1.f / 128.f) + EPS);
    uint4 zv = *(const uint4*)(proj + (size_t)row * DPJ + C_Z + lane * 8);
    float z[8] = {bflo(zv.x), bfhi(zv.x), bflo(zv.y), bfhi(zv.y), bflo(zv.z), bfhi(zv.z), bflo(zv.w), bfhi(zv.w)};
    float4 g0 = *(const float4*)(p.dn_norm_g + (lane & 15) * 8), g1 = *(const float4*)(p.dn_norm_g + (lane & 15) * 8 + 4);
    float gg[8] = {g0.x, g0.y, g0.z, g0.w, g1.x, g1.y, g1.z, g1.w};
    float y[8];
#pragma unroll
    for (int e = 0; e < 8; ++e) y[e] = o[e] * r * gg[e] * siluf_(z[e]);
    *(uint4*)(omix + (size_t)row * 512 + lane * 8) = make_uint4(pack2(y[0], y[1]), pack2(y[2], y[3]), pack2(y[4], y[5]), pack2(y[6], y[7]));
  }
}

__device__ __forceinline__ void ple_tile(const Params& p, int t, char* smem) {
  const u16* pb = (const u16*)(p.ws + WS_PB2);
  const u16* pp = (const u16*)(p.ws + WS_PPROJ);
  u16* pl = (u16*)(p.ws + WS_PL);
  int m0 = (t >> 3) * 128, n0 = (t & 7) * 128;
  f32x4 acc[4][4];
#pragma unroll
  for (int i = 0; i < 4; ++i)
#pragma unroll
    for (int j = 0; j < 4; ++j) acc[i][j] = f32x4{0, 0, 0, 0};
  gemm128<false>(pb + (size_t)m0 * 256, 256, pp + (size_t)n0 * 256, 256, 256, smem, acc);
  GEMM_EPILOGUE(acc, m0, n0, {
    *(uint2*)(pl + (size_t)row * 1024 + col) = make_uint2(pack2(v[0], v[1]), pack2(v[2], v[3]));
  })
}

template <int MH>
__device__ __forceinline__ void g3_unit(const Params& p, int m0, int n0, char* smem, bool do_atomic) {
  const u16* cmix = (const u16*)(p.ws + WS_CMIX);
  const u16* omix = (const u16*)(p.ws + WS_OMIX);
  const u16* wo = (const u16*)(p.ws + WS_WOUT);
  u16* x1b = (u16*)(p.ws + WS_X);
  float* ss2 = (float*)(p.ws + WS_SS2);
  float* y = p.out + O_Y;
  f32x4 acc[4][4];
#pragma unroll
  for (int i = 0; i < 4; ++i)
#pragma unroll
    for (int j = 0; j < 4; ++j) acc[i][j] = f32x4{0, 0, 0, 0};
  gemm128<false, MH>(cmix + (size_t)m0 * 512, 512, wo + (size_t)n0 * 1024, 1024, 512, smem, acc);
  gemm128<false, MH>(omix + (size_t)m0 * 512, 512, wo + (size_t)n0 * 1024 + 512, 1024, 512, smem, acc);
  float rs[4] = {0, 0, 0, 0};
  float4 xpre[4][4];
  GEMM_EPILOGUE_M(acc, m0, n0, MH, { (void)v; xpre[mt][nt] = *(const float4*)(xrow(p, row) + col); })
  GEMM_EPILOGUE_M(acc, m0, n0, MH, {
    float4 xv = xpre[mt][nt];
    float o0 = xv.x + v[0], o1 = xv.y + v[1], o2 = xv.z + v[2], o3 = xv.w + v[3];
    *(uint2*)(x1b + (size_t)row * 1024 + col) = make_uint2(pack2(o0, o1), pack2(o2, o3));
    rs[mt] += o0 * o0 + o1 * o1 + o2 * o2 + o3 * o3;
  })
  {
    const int lane = threadIdx.x & 63, wave = threadIdx.x >> 6;
#pragma unroll
    for (int mt = 0; mt < MH; ++mt) {
      float sq = rs[mt];
      sq += __shfl_xor(sq, 16); sq += __shfl_xor(sq, 32);
      if (lane < 16 && do_atomic) atomicAdd(&ss2[m0 + (wave >> 1) * (16 * MH) + mt * 16 + lane], sq);
    }
  }
}

template <int MH>
__device__ __forceinline__ void g4_unit(const Params& p, int m0, int n0, char* smem, bool do_atomic) {
  const u16* x1b = (const u16*)(p.ws + WS_X);
  const u16* pl = (const u16*)(p.ws + WS_PL);
  const u16* gt = (const u16*)(p.ws + WS_GATE);
  const float* ss2 = (const float*)(p.ws + WS_SS2);
  float* ss3 = (float*)(p.ws + WS_SS3);
  const float* y = p.out + O_Y;
  u16* x2b = (u16*)(p.ws + WS_X2B);
  f32x4 acc[4][4];
#pragma unroll
  for (int i = 0; i < 4; ++i)
#pragma unroll
    for (int j = 0; j < 4; ++j) acc[i][j] = f32x4{0, 0, 0, 0};
  gemm128<false, MH>(x1b + (size_t)m0 * 1024, 1024, gt + (size_t)n0 * 1024, 1024, 1024, smem, acc);
  float rs[4] = {0, 0, 0, 0};
  uint2 ypre[4][4];
  uint2 ppre[4][4];
  float r2pre[4];
  GEMM_EPILOGUE_M(acc, m0, n0, MH, {
    (void)v;
    ypre[mt][nt] = *(const uint2*)(x1b + (size_t)row * 1024 + col);
    ppre[mt][nt] = *(const uint2*)(pl + (size_t)row * 1024 + col);
    if (nt == 0) r2pre[mt] = ss2[row];
  })
  GEMM_EPILOGUE_M(acc, m0, n0, MH, {
    float r2 = rsqrtf(r2pre[mt] * (1.f / 1024.f) + EPS);
    uint2 xv = ypre[mt][nt];
    uint2 pv = ppre[mt][nt];
    float o0 = bflo(xv.x) + sigmoidf_(v[0] * r2) * bflo(pv.x), o1 = bfhi(xv.x) + sigmoidf_(v[1] * r2) * bfhi(pv.x);
    float o2 = bflo(xv.y) + sigmoidf_(v[2] * r2) * bflo(pv.y), o3 = bfhi(xv.y) + sigmoidf_(v[3] * r2) * bfhi(pv.y);
    *(uint2*)(x2b + (size_t)row * 1024 + col) = make_uint2(pack2(o0, o1), pack2(o2, o3));
    rs[mt] += o0 * o0 + o1 * o1 + o2 * o2 + o3 * o3;
  })
  {
    const int lane = threadIdx.x & 63, wave = threadIdx.x >> 6;
#pragma unroll
    for (int mt = 0; mt < MH; ++mt) {
      float sq = rs[mt];
      sq += __shfl_xor(sq, 16); sq += __shfl_xor(sq, 32);
      if (lane < 16 && do_atomic) atomicAdd(&ss3[m0 + (wave >> 1) * (16 * MH) + mt * 16 + lane], sq);
    }
  }
}

template <int G>
__device__ __forceinline__ void g34_tiles(const Params& p, int bid, int nb, char* smem, bool do_atomic, bool& heavy, int& nlight, int& lidx) {
  const TileWalk tw = tile_walk(8, bid, nb);
  heavy = false; nlight = nb; lidx = bid;
  if (tw.banded && tw.total > tw.step) {
    const int nfull = (tw.total / tw.step) * tw.step, rem = tw.total - nfull;
#pragma unroll 1
    for (int t = tw.q; t < nfull; t += tw.step) {
      int mt_, nt_;
      tile_get(tw, t, mt_, nt_);
      if (G == 0) g3_unit<4>(p, mt_ * 128, nt_ * 128, smem, do_atomic); else g4_unit<4>(p, mt_ * 128, nt_ * 128, smem, do_atomic);
    }
    const int nhalf = 2 * rem <= tw.step ? 2 * rem : 0;
    if (nhalf > 0) {
      if (tw.q < nhalf) {
        int mt_, nt_;
        tile_get(tw, nfull + (tw.q >> 1), mt_, nt_);
        const int m0 = mt_ * 128 + (tw.q & 1) * 64;
        if (G == 0) g3_unit<2>(p, m0, nt_ * 128, smem, do_atomic); else g4_unit<2>(p, m0, nt_ * 128, smem, do_atomic);
        heavy = true;
      }
      nlight = (tw.step - nhalf) * 8; lidx = (tw.q - nhalf) * 8 + (bid & 7);
    } else {
#pragma unroll 1
      for (int t = nfull + tw.q; t < tw.total; t += tw.step) {
        int mt_, nt_;
        tile_get(tw, t, mt_, nt_);
        if (G == 0) g3_unit<4>(p, mt_ * 128, nt_ * 128, smem, do_atomic); else g4_unit<4>(p, mt_ * 128, nt_ * 128, smem, do_atomic);
      }
    }
  } else {
#pragma unroll 1
    for (int t = tw.q; t < tw.total; t += tw.step) {
      int mt_, nt_;
      tile_get(tw, t, mt_, nt_);
      if (G == 0) g3_unit<4>(p, mt_ * 128, nt_ * 128, smem, do_atomic); else g4_unit<4>(p, mt_ * 128, nt_ * 128, smem, do_atomic);
    }
  }
}
__device__ __forceinline__ void phase5(const Params& p, int bid, int nb, char* smem, bool do_atomic = true) {
  bool heavy; int nlight, lidx;
  g34_tiles<0>(p, bid, nb, smem, do_atomic, heavy, nlight, lidx);
  if (do_atomic && !heavy) {
#pragma unroll 1
    for (int it = lidx; it < 1088; it += nlight) ple_tile(p, it, smem);
  }
}
__device__ __forceinline__ void phase6(const Params& p, int bid, int nb, char* smem, bool do_atomic = true) {
  bool heavy; int nlight, lidx;
  g34_tiles<1>(p, bid, nb, smem, do_atomic, heavy, nlight, lidx);
}

__device__ __forceinline__ void phase7(const Params& p, int bid, int nb) {
  const int tid = threadIdx.x;
  const float* ss3 = (const float*)(p.ws + WS_SS3);
  const u16* x2b = (const u16*)(p.ws + WS_X2B);
  float* y = p.out + O_Y;
  for (size_t i = (size_t)bid * 256 + tid; i < (size_t)NT * 128; i += (size_t)nb * 256) {
    const int row = (int)(i >> 7), c = (int)(i & 127) * 8;
    const float r = rsqrtf(ss3[row] * (1.f / 1024.f) + EPS);
    const uint4 v = *(const uint4*)(x2b + (size_t)row * 1024 + c);
    const float4 g0 = *(const float4*)(p.final_norm_g + c), g1 = *(const float4*)(p.final_norm_g + c + 4);
    *(float4*)(y + (size_t)row * 1024 + c) = make_float4(bflo(v.x) * r * g0.x, bfhi(v.x) * r * g0.y, bflo(v.y) * r * g0.z, bfhi(v.y) * r * g0.w);
    *(float4*)(y + (size_t)row * 1024 + c + 4) = make_float4(bflo(v.z) * r * g1.x, bfhi(v.z) * r * g1.y, bflo(v.w) * r * g1.z, bfhi(v.w) * r * g1.w);
  }
}

__device__ __forceinline__ void phase2(const Params& p, int bid, int nb, char* smem) {
#pragma unroll 1
  for (int it = bid; it < 1024; it += nb) delta_prep<false>(p, it, smem);
}
__device__ __forceinline__ void phase3(const Params& p, int bid, int nb, char* smem) {
  if (nb >= 128) {
    if (bid < 64) { delta_seq_p(p, bid, smem); return; }
    bid -= 64; nb -= 64;
  } else {
    for (int it = bid; it < 64; it += nb) delta_seq_p(p, it, smem);
  }
#pragma unroll 1
  for (int it = bid; it < 512; it += nb) conv_tile<false>(p, it, smem);
#pragma unroll 1
  for (int it = nb - 1 - bid; it < 128; it += nb) conv_tile<true>(p, it, smem);
#pragma unroll 1
  for (int it = bid; it < 512; it += nb) {
    delta_prep<true>(p, it, smem);
    __threadfence_block();
    __syncthreads();
#pragma unroll 1
    for (int hf = 0; hf < 2; ++hf) delta_seq<true>(p, 2 * it + hf, smem);
  }
}

#define XB_TMO      128
#define XB_XCNT(j)  (256  + 64 * (j))
#define XB_XSUB(j)  (1280 + 64 * (j))
#define XB_XGEN(j)  (2304 + 64 * (j))
#define XB_TOP      3328
#define XB_TOPGEN   3392
#define XCD_BAR_WORDS 3456
#define XB_SPIN_CAP (1u << 22)
__device__ __forceinline__ unsigned xb_ld(unsigned* p) { return __hip_atomic_load(p, __ATOMIC_RELAXED, __HIP_MEMORY_SCOPE_AGENT); }
__device__ __forceinline__ unsigned xb_add(unsigned* p, unsigned v) { return __hip_atomic_fetch_add(p, v, __ATOMIC_RELAXED, __HIP_MEMORY_SCOPE_AGENT); }
__device__ __forceinline__ unsigned xb_xcc_id() { return (unsigned)__builtin_amdgcn_s_getreg((3 << 11) | 20) & 0xFu; }
#define XB_SPIN(cond, bar) do { unsigned _sp = 0; while (cond) { __builtin_amdgcn_s_sleep(1); \
    if ((++_sp & 255u) == 0u) { if (xb_ld(&(bar)[XB_TMO])) break; if (_sp > XB_SPIN_CAP) { atomicAdd(&(bar)[XB_TMO], 1u); break; } } } } while (0)
struct XcdBarrier { unsigned* bar; unsigned x; unsigned nloc; unsigned nx; };
__device__ __forceinline__ void xcd_barrier_complete(unsigned* bar, unsigned x, unsigned& nloc, unsigned& nx) {
  const unsigned G = gridDim.x;
  unsigned sum, cnt, mine, sp = 0u;
  for (;;) {
    sum = 0u; cnt = 0u; mine = 0u;
#pragma unroll
    for (unsigned j = 0; j < 16; ++j) { const unsigned c = xb_ld(&bar[XB_XCNT(j)]); sum += c; cnt += (c > 0u) ? 1u : 0u; mine = (j == x) ? c : mine; }
    if (sum == G) break;
    __builtin_amdgcn_s_sleep(1);
    if ((++sp & 255u) == 0u) { if (xb_ld(&bar[XB_TMO])) break; if (sp > XB_SPIN_CAP) { atomicAdd(&bar[XB_TMO], 1u); break; } }
  }
  nloc = mine > 0u ? mine : 1u; nx = cnt > 0u ? cnt : 1u;
}
__device__ __forceinline__ void xcd_barrier(XcdBarrier& b) {
  asm volatile("s_waitcnt vmcnt(0)" ::: "memory");
  __syncthreads();
  if (threadIdx.x == 0) {
    unsigned* bar = b.bar;
    __builtin_amdgcn_s_waitcnt(0);
    if (b.nloc == 0u) xcd_barrier_complete(bar, b.x, b.nloc, b.nx);
    const unsigned nloc = b.nloc, nx = b.nx;
    const unsigned old = xb_add(&bar[XB_XSUB(b.x)], 1u);
    const unsigned gen = old / nloc;
    if (old + 1u == (gen + 1u) * nloc) {
      __builtin_amdgcn_fence(__ATOMIC_RELEASE, "agent");
      asm volatile("s_waitcnt vmcnt(0)" ::: "memory");
      const unsigned og = xb_add(&bar[XB_TOP], 1u);
      const unsigned tg = og / nx;
      if (og + 1u == (tg + 1u) * nx) xb_add(&bar[XB_TOPGEN], 1u);
      else XB_SPIN(xb_ld(&bar[XB_TOPGEN]) == tg, bar);
      __builtin_amdgcn_fence(__ATOMIC_ACQUIRE, "agent");
      xb_add(&bar[XB_XGEN(b.x)], 1u);
      asm volatile("s_waitcnt vmcnt(0)" ::: "memory");
    } else {
      XB_SPIN(xb_ld(&bar[XB_XGEN(b.x)]) == gen, bar);
      __builtin_amdgcn_fence(__ATOMIC_ACQUIRE, "agent");
      asm volatile("s_waitcnt vmcnt(0)" ::: "memory");
    }
  }
  __syncthreads();
}

template <int MODE>
__global__ void __launch_bounds__(256, 2) mega(Params p) {
  __shared__ __attribute__((aligned(16))) char smem[65536];
  const int bid = blockIdx.x, nb = gridDim.x;
  if (MODE < 0) {
    XcdBarrier gb;
    gb.bar = (unsigned*)(p.ws + WS_BAR); gb.x = xb_xcc_id(); gb.nloc = 0u; gb.nx = 0u;
    if (threadIdx.x == 0) (void)xb_add(&gb.bar[XB_XCNT(gb.x)], 1u);
    phase0(p, bid, nb, smem); xcd_barrier(gb);
    if (PROBE_DUP == 0) { phase0(p, bid, nb, smem); xcd_barrier(gb); }
    phase1(p, bid, nb, smem); xcd_barrier(gb);
    if (PROBE_DUP == 1) { phase1(p, bid, nb, smem); xcd_barrier(gb); }
    phase2(p, bid, nb, smem); xcd_barrier(gb);
    if (PROBE_DUP == 2) { phase2(p, bid, nb, smem); xcd_barrier(gb); }
    phase3(p, bid, nb, smem); xcd_barrier(gb);
    if (PROBE_DUP == 3) { phase3(p, bid, nb, smem); xcd_barrier(gb); }
    phase4(p, bid, nb, smem); xcd_barrier(gb);
    if (PROBE_DUP == 4) { phase4(p, bid, nb, smem); xcd_barrier(gb); }
    if (PROBE_DUP == 11) { phase5(p, bid, nb, smem, false); xcd_barrier(gb); }
    phase5(p, bid, nb, smem); xcd_barrier(gb);
    phase6(p, bid, nb, smem); xcd_barrier(gb);
    phase7(p, bid, nb);
  } else {
    if (MODE == 0) phase0(p, bid, nb, smem);
    if (MODE == 1) phase1(p, bid, nb, smem);
    if (MODE == 2) phase2(p, bid, nb, smem);
    if (MODE == 3) phase3(p, bid, nb, smem);
    if (MODE == 4) phase4(p, bid, nb, smem);
    if (MODE == 5) phase5(p, bid, nb, smem);
    if (MODE == 6) phase6(p, bid, nb, smem);
    if (MODE == 7) phase7(p, bid, nb);
  }
}

extern "C" void kernel_launch(void* const* d_in, const int* in_sizes, int n_in, void* d_out, int out_size, void* d_ws,
                              size_t ws_size, hipStream_t stream) {
  if (ws_size < WS_END) { fprintf(stderr, "workspace too small: %zu < %zu\n", ws_size, (size_t)WS_END); return; }
  static int grid = 0;
  if (grid == 0) {
    int dev = 0, cus = 0, per_cu = 0;
    hipGetDevice(&dev);
    hipDeviceGetAttribute(&cus, hipDeviceAttributeMultiprocessorCount, dev);
    hipOccupancyMaxActiveBlocksPerMultiprocessor(&per_cu, (const void*)mega<-1>, 256, 0);
    if (per_cu > 2) per_cu = 2;
    if (per_cu < 1 || cus < 1) { fprintf(stderr, "occupancy query failed (%d, %d)\n", cus, per_cu); grid = -1; return; }
    grid = cus * per_cu;
  }
  if (grid < 0) return;
  Params p{};
  const float** f = (const float**)&p;
  for (int i = 0; i < 23; ++i) f[i] = (const float*)d_in[i];
  p.out = (float*)d_out;
  p.ws = (char*)d_ws;
  hipMemsetAsync((char*)d_ws + WS_BAR, 0, XCD_BAR_WORDS * 4, stream);
  void* args[] = {&p};
  hipError_t e = hipLaunchCooperativeKernel((const void*)mega<-1>, dim3(grid), dim3(256), args, 0, stream);
  if (e != hipSuccess) fprintf(stderr, "cooperative launch failed: %s (grid %d)\n", hipGetErrorString(e), grid);
}
```

```cpp
#include <hip/hip_runtime.h>
#include <hip/hip_bf16.h>
#include <cstdio>
#include <cstdint>

typedef __attribute__((ext_vector_type(8))) short bf16x8;
typedef __attribute__((ext_vector_type(4))) float f32x4;
typedef unsigned short u16;
#ifndef PROBE_DUP
#define PROBE_DUP -1
#endif

constexpr int DM = 1024, NP = 16384, NS = 1024, NT = 17408, SEQ = 2048;
constexpr int DIN = 3592, DPJ = 3584;
constexpr int C_GLUA = 0, C_GLUB = 512, C_GATE = 1024, C_QKV = 1536, C_Z = 3072;
constexpr float EPS = 1e-6f;

constexpr int NF_P = 52, NF_S = 17;
constexpr size_t FRAG_P_BYTES = (size_t)NF_P * 1024, FRAG_S_BYTES = (size_t)NF_S * 1024;
constexpr size_t UF_P_BYTES = 32 * 1024, UF_S_BYTES = 8 * 1024;

constexpr size_t al256(size_t x) { return (x + 255) & ~(size_t)255; }
constexpr size_t WS_X = 0;
constexpr size_t WS_PROJ = WS_X + (size_t)NT * 1024 * 2;
constexpr size_t WS_FRAG = WS_PROJ + (size_t)NT * DPJ * 2;
constexpr size_t FRAG_TOTAL = 1024 * FRAG_P_BYTES + 512 * FRAG_S_BYTES;
constexpr size_t WS_OMIX = WS_FRAG;
constexpr size_t WS_X2B = WS_PROJ;
constexpr size_t WS_PL = WS_FRAG + (size_t)NT * 512 * 2;
constexpr size_t WS_CMIX = WS_FRAG + al256(FRAG_TOTAL);
constexpr size_t WS_WIN = WS_CMIX + (size_t)NT * 512 * 2;
constexpr size_t WS_PW = WS_WIN + (size_t)DPJ * 1024 * 2;
constexpr size_t WS_WOUT = WS_PW + 512 * 512 * 2;
constexpr size_t WS_GATE = WS_WOUT + 1024 * 1024 * 2;
constexpr size_t WS_PPROJ = WS_GATE + 1024 * 1024 * 2;
constexpr size_t WS_R1 = WS_PPROJ + 1024 * 256 * 2;
constexpr size_t WS_AB = WS_R1 + al256((size_t)NT * 4);
constexpr size_t WS_SS2 = WS_AB + (size_t)NT * 8 * 4;
constexpr size_t WS_SS3 = WS_SS2 + al256((size_t)NT * 4);
constexpr size_t WS_GLAST = WS_SS3 + al256((size_t)NT * 4);
constexpr size_t WS_BAR = WS_GLAST + al256(2560 * 4);
constexpr size_t WS_PB2 = WS_BAR + al256(3456 * 4);
constexpr size_t WS_END = WS_PB2 + (size_t)NT * 256 * 2;
constexpr size_t YS_UF = 0;
constexpr size_t YS_CACT = 1024 * UF_P_BYTES + 512 * UF_S_BYTES;
static_assert(YS_CACT + (size_t)NT * 512 * 2 <= (size_t)NT * 1024 * 4, "y scratch overflow");
static_assert(WS_PL + (size_t)NT * 1024 * 2 <= WS_CMIX, "frag alias overflow");

constexpr size_t O_Y = 0;
constexpr size_t O_NCP = (size_t)NT * 1024;
constexpr size_t O_NDP = O_NCP + 8 * 30 * 512;
constexpr size_t O_NSP = O_NDP + 8 * 3 * 1536;
constexpr size_t O_NCS = O_NSP + (size_t)8 * 4 * 128 * 128;
constexpr size_t O_NDS = O_NCS + (size_t)128 * 30 * 512;
constexpr size_t O_NSS = O_NDS + (size_t)128 * 3 * 1536;

struct Params {
  const float *x_prompt, *x_sample, *state_conv, *state_dn_conv, *state_dn_S, *p_prompt, *p_sample;
  const float *norm_mix_g, *w_in, *conv_dw_w, *conv_dw_b, *conv_ln_g, *conv_ln_b, *conv_pw_w;
  const float *dn_conv_w, *dn_a_log, *dn_dt_bias, *dn_norm_g, *w_out, *ple_norm_g, *ple_gate_w, *ple_proj_w, *final_norm_g;
  float* out;
  char* ws;
};

typedef float f32x2_t __attribute__((ext_vector_type(2)));
typedef __bf16 bf16x2_t __attribute__((ext_vector_type(2)));
__device__ __forceinline__ uint32_t pack2(float a, float b) {
  f32x2_t v = {a, b};
  bf16x2_t r = __builtin_convertvector(v, bf16x2_t);
  return __builtin_bit_cast(uint32_t, r);
}
__device__ __forceinline__ u16 f2bf(float f) { return (u16)(pack2(f, f) & 0xffffu); }
__device__ __forceinline__ float bf2f(u16 h) { return __uint_as_float(((uint32_t)h) << 16); }
__device__ __forceinline__ float bflo(uint32_t u) { return __uint_as_float(u << 16); }
__device__ __forceinline__ float bfhi(uint32_t u) { return __uint_as_float(u & 0xffff0000u); }
__device__ __forceinline__ float sigmoidf_(float x) { return __builtin_amdgcn_rcpf(1.f + __expf(-x)); }
__device__ __forceinline__ float siluf_(float x) { return x * __builtin_amdgcn_rcpf(1.f + __expf(-x)); }
__device__ __forceinline__ const float* xrow(const Params& p, int row) {
  return row < NP ? p.x_prompt + (size_t)row * DM : p.x_sample + (size_t)(row - NP) * DM;
}
__device__ __forceinline__ float wave_sum(float v) {
#pragma unroll
  for (int o = 32; o >= 1; o >>= 1) v += __shfl_xor(v, o);
  return v;
}
__device__ __forceinline__ bf16x8 mk8(uint32_t a, uint32_t b, uint32_t c, uint32_t d) {
  union { uint32_t u[4]; bf16x8 v; } t;
  t.u[0] = a; t.u[1] = b; t.u[2] = c; t.u[3] = d;
  return t.v;
}
__device__ __forceinline__ bf16x8 u4_to_b8(uint4 q) { return mk8(q.x, q.y, q.z, q.w); }
#define MFMA(a, b, c) __builtin_amdgcn_mfma_f32_16x16x32_bf16((a), (b), (c), 0, 0, 0)

template <bool DEEP = false, int MH = 4>
__device__ __forceinline__ void gemm128(const u16* __restrict__ A, int lda, const u16* __restrict__ B, int ldb,
                                        int K, char* smem, f32x4 (&acc)[4][4]) {
  const int tid = threadIdx.x, lane = tid & 63, wave = tid >> 6;
  const int wm = wave >> 1, wn = wave & 1, m = lane & 15, g = lane >> 4;
  const int nkt = K >> 6;
  uint4 ra0, ra1, ra2, ra3, rb0, rb1, rb2, rb3;
  uint4 rc0, rc1, rc2, rc3, rd0, rd1, rd2, rd3;
  const int lrow = tid >> 3, lch = tid & 7;
  const u16* gA = A + (size_t)lrow * lda + lch * 8;
  const u16* gB = B + (size_t)lrow * ldb + lch * 8;
  const int soff = lrow * 128 + ((lch ^ (lrow & 7)) << 4);
#define GLOAD(...) GLOAD_I(__VA_ARGS__)
#define SSTORE(...) SSTORE_I(__VA_ARGS__)
#define GLOAD_I(a0_, a1_, a2_, a3_, b0_, b1_, b2_, b3_, kt_)             \
  {                                                                     \
    a0_ = *(const uint4*)(gA + (kt_) * 64);                             \
    a1_ = *(const uint4*)(gA + (size_t)32 * lda + (kt_) * 64);          \
    if (MH == 4) {                                                      \
      a2_ = *(const uint4*)(gA + (size_t)64 * lda + (kt_) * 64);        \
      a3_ = *(const uint4*)(gA + (size_t)96 * lda + (kt_) * 64);        \
    }                                                                   \
    b0_ = *(const uint4*)(gB + (kt_) * 64);                             \
    b1_ = *(const uint4*)(gB + (size_t)32 * ldb + (kt_) * 64);          \
    b2_ = *(const uint4*)(gB + (size_t)64 * ldb + (kt_) * 64);          \
    b3_ = *(const uint4*)(gB + (size_t)96 * ldb + (kt_) * 64);          \
  }
#define SSTORE_I(a0_, a1_, a2_, a3_, b0_, b1_, b2_, b3_, buf_)           \
  {                                                                     \
    char* sa_ = smem + (buf_) * 32768 + soff;                           \
    *(uint4*)(sa_) = a0_;                                               \
    *(uint4*)(sa_ + 4096) = a1_;                                        \
    if (MH == 4) {                                                      \
      *(uint4*)(sa_ + 8192) = a2_;                                      \
      *(uint4*)(sa_ + 12288) = a3_;                                     \
    }                                                                   \
    *(uint4*)(sa_ + 16384) = b0_;                                       \
    *(uint4*)(sa_ + 16384 + 4096) = b1_;                                \
    *(uint4*)(sa_ + 16384 + 8192) = b2_;                                \
    *(uint4*)(sa_ + 16384 + 12288) = b3_;                               \
  }
#define GEMM_COMPUTE(buf_)                                                                   \
  {                                                                                          \
    const char* sa = smem + (buf_) * 32768;                                                  \
    const char* sb = sa + 16384;                                                             \
    _Pragma("unroll") for (int ks = 0; ks < 2; ++ks) {                                       \
      bf16x8 af[4], bfr[4];                                                                  \
      _Pragma("unroll") for (int t = 0; t < 4; ++t) {                                        \
        if (t < MH) {                                                                        \
          int ra_ = wm * (16 * MH) + t * 16 + m;                                             \
          af[t] = *(const bf16x8*)(sa + ra_ * 128 + (((ks * 4 + g) ^ (ra_ & 7)) << 4));      \
        }                                                                                    \
        int rb_ = wn * 64 + t * 16 + m;                                                      \
        bfr[t] = *(const bf16x8*)(sb + rb_ * 128 + (((ks * 4 + g) ^ (rb_ & 7)) << 4));       \
      }                                                                                      \
      _Pragma("unroll") for (int mt = 0; mt < MH; ++mt)                                      \
        _Pragma("unroll") for (int nt = 0; nt < 4; ++nt) acc[mt][nt] = MFMA(bfr[nt], af[mt], acc[mt][nt]); \
    }                                                                                        \
  }
#define SETX ra0, ra1, ra2, ra3, rb0, rb1, rb2, rb3
#define SETY rc0, rc1, rc2, rc3, rd0, rd1, rd2, rd3
  __syncthreads();
  if (DEEP) {
    GLOAD(SETX, 0)
    GLOAD(SETY, 1)
    SSTORE(SETX, 0)
    __syncthreads();
#pragma unroll 1
    for (int kt = 0; kt < nkt; kt += 2) {
      if (kt + 2 < nkt) GLOAD(SETX, kt + 2)
      GEMM_COMPUTE(0)
      SSTORE(SETY, 1)
      __syncthreads();
      if (kt + 3 < nkt) GLOAD(SETY, kt + 3)
      GEMM_COMPUTE(1)
      if (kt + 2 < nkt) SSTORE(SETX, 0)
      __syncthreads();
    }
  } else {
    GLOAD(SETX, 0)
    SSTORE(SETX, 0)
    __syncthreads();
#pragma unroll 1
    for (int kt = 0; kt < nkt; ++kt) {
      if (kt + 1 < nkt) GLOAD(SETX, kt + 1)
      GEMM_COMPUTE(kt & 1)
      if (kt + 1 < nkt) SSTORE(SETX, (kt + 1) & 1)
      __syncthreads();
    }
  }
}
#define GEMM_EPILOGUE_M(acc, m0, n0, MH_, ...)                                             \
  {                                                                                        \
    const int lane_ = threadIdx.x & 63, wave_ = threadIdx.x >> 6;                          \
    const int wm_ = wave_ >> 1, wn_ = wave_ & 1, m_ = lane_ & 15, g_ = lane_ >> 4;         \
    _Pragma("unroll") for (int mt = 0; mt < (MH_); ++mt) {                                 \
      const int row = (m0) + wm_ * (16 * (MH_)) + mt * 16 + m_;                            \
      _Pragma("unroll") for (int nt = 0; nt < 4; ++nt) {                                   \
        const int col = (n0) + wn_ * 64 + nt * 16 + g_ * 4;                                \
        f32x4 v = acc[mt][nt];                                                             \
        __VA_ARGS__                                                                        \
      }                                                                                    \
    }                                                                                      \
  }
#define GEMM_EPILOGUE(acc, m0, n0, ...) GEMM_EPILOGUE_M(acc, m0, n0, 4, __VA_ARGS__)

__device__ __forceinline__ void transpose_tile(const float* __restrict__ src, int lds_, const float* __restrict__ gv, u16* __restrict__ dst,
                               int ldd, int k0, int n0, char* smem, bool perm = false) {
  float* t = (float*)smem;
  const int tid = threadIdx.x;
  __syncthreads();
#pragma unroll
  for (int it = 0; it < 4; ++it) {
    int k = (tid >> 4) + it * 16, n = (tid & 15) * 4;
    float4 v = *(const float4*)(src + (size_t)(k0 + k) * lds_ + n0 + n);
    float gg = gv ? gv[k0 + k] : 1.f;
    t[k * 65 + n + 0] = v.x * gg; t[k * 65 + n + 1] = v.y * gg; t[k * 65 + n + 2] = v.z * gg; t[k * 65 + n + 3] = v.w * gg;
  }
  __syncthreads();
#pragma unroll
  for (int it = 0; it < 2; ++it) {
    int n = (tid >> 3) + it * 32, kc = (tid & 7) * 8;
    uint32_t w[4];
#pragma unroll
    for (int e = 0; e < 4; ++e) w[e] = pack2(t[(kc + 2 * e) * 65 + n], t[(kc + 2 * e + 1) * 65 + n]);
    const int j = n & 31;
    const int nd = perm ? ((n & ~31) + 16 * ((j >> 2) & 1) + 4 * (j >> 3) + (j & 3)) : n;
    *(uint4*)(dst + (size_t)(n0 + nd) * ldd + k0 + kc) = make_uint4(w[0], w[1], w[2], w[3]);
  }
}

__device__ __forceinline__ void phase0(const Params& p, int bid, int nb, char* smem) {
  const int tid = threadIdx.x, lane = tid & 63, wave = tid >> 6;
  u16* xb = (u16*)(p.ws + WS_X);
  float* r1 = (float*)(p.ws + WS_R1);
  float* ab = (float*)(p.ws + WS_AB);
  float* ss2 = (float*)(p.ws + WS_SS2);
  float* ss3 = (float*)(p.ws + WS_SS3);
  for (int i = bid * 256 + tid; i < NT; i += nb * 256) { ss2[i] = 0.f; ss3[i] = 0.f; }
  {
    u16* pb = (u16*)(p.ws + WS_PB2);
  for (int i = bid * 256 + tid; i < NT * 32; i += nb * 256) {
    int row = i >> 5, c = (i & 31) * 8;
    const float* pr = row < NP ? p.p_prompt + (size_t)row * 256 : p.p_sample + (size_t)(row - NP) * 256;
    float4 a = *(const float4*)(pr + c), bq = *(const float4*)(pr + c + 4);
    *(uint4*)(pb + (size_t)row * 256 + c) = make_uint4(pack2(a.x, a.y), pack2(a.z, a.w), pack2(bq.x, bq.y), pack2(bq.z, bq.w));
  }
  }
  for (int it = bid; it < 1536; it += nb) {
    if (it < 896) { int kt = it / 56, nt = it % 56; transpose_tile(p.w_in, DIN, p.norm_mix_g, (u16*)(p.ws + WS_WIN), 1024, kt * 64, nt * 64, smem, true); }
    else if (it < 960) { int j = it - 896; transpose_tile(p.conv_pw_w, 512, nullptr, (u16*)(p.ws + WS_PW), 512, (j >> 3) * 64, (j & 7) * 64, smem); }
    else if (it < 1216) { int j = it - 960; transpose_tile(p.w_out, 1024, nullptr, (u16*)(p.ws + WS_WOUT), 1024, (j >> 4) * 64, (j & 15) * 64, smem); }
    else if (it < 1472) { int j = it - 1216; transpose_tile(p.ple_gate_w, 1024, p.ple_norm_g, (u16*)(p.ws + WS_GATE), 1024, (j >> 4) * 64, (j & 15) * 64, smem); }
    else { int j = it - 1472; transpose_tile(p.ple_proj_w, 1024, nullptr, (u16*)(p.ws + WS_PPROJ), 256, (j >> 4) * 64, (j & 15) * 64, smem); }
  }
  float* tl = (float*)smem;
  __syncthreads();
#pragma unroll
  for (int it = 0; it < 4; ++it) {
    int k = tid + it * 256;
    const float4* wt = (const float4*)(p.w_in + (size_t)k * DIN + DPJ);
    float4 w0 = wt[0], w1 = wt[1];
    float gg = p.norm_mix_g[k];
    tl[0 * 1024 + k] = w0.x * gg; tl[1 * 1024 + k] = w0.y * gg; tl[2 * 1024 + k] = w0.z * gg; tl[3 * 1024 + k] = w0.w * gg;
    tl[4 * 1024 + k] = w1.x * gg; tl[5 * 1024 + k] = w1.y * gg; tl[6 * 1024 + k] = w1.z * gg; tl[7 * 1024 + k] = w1.w * gg;
  }
  __syncthreads();
  for (int row = bid * 4 + wave; row < NT; row += nb * 4) {
    const float* xr = xrow(p, row);
    float ss = 0.f;
    float d[8] = {0, 0, 0, 0, 0, 0, 0, 0};
#pragma unroll
    for (int it = 0; it < 4; ++it) {
      int k = it * 256 + lane * 4;
      float4 v = *(const float4*)(xr + k);
      ss += v.x * v.x + v.y * v.y + v.z * v.z + v.w * v.w;
      *(uint2*)(xb + (size_t)row * 1024 + k) = make_uint2(pack2(v.x, v.y), pack2(v.z, v.w));
#pragma unroll
      for (int j = 0; j < 8; ++j) {
        float4 w = *(const float4*)(tl + j * 1024 + k);
        d[j] += v.x * w.x + v.y * w.y + v.z * w.z + v.w * w.w;
      }
    }
    ss = wave_sum(ss);
#pragma unroll
    for (int j = 0; j < 8; ++j) d[j] = wave_sum(d[j]);
    float r = rsqrtf(ss * (1.f / 1024.f) + EPS);
    if (lane == 0) {
      r1[row] = r;
      *(float4*)(ab + (size_t)row * 8) = make_float4(d[0] * r, d[1] * r, d[2] * r, d[3] * r);
      *(float4*)(ab + (size_t)row * 8 + 4) = make_float4(d[4] * r, d[5] * r, d[6] * r, d[7] * r);
    }
  }
}

struct TileWalk { int q, step, total, mbase, nN; bool banded; };
__device__ __forceinline__ TileWalk tile_walk(int nN, int bid, int nb) {
  TileWalk w; w.nN = nN;
  if ((nb & 7) == 0) { w.banded = true; w.q = bid >> 3; w.step = nb >> 3; w.total = 17 * nN; w.mbase = 17 * (bid & 7); }
  else { w.banded = false; w.q = bid; w.step = nb; w.total = 136 * nN; w.mbase = 0; }
  return w;
}
__device__ __forceinline__ void tile_get(const TileWalk& w, int q, int& mt, int& nt) {
  if (w.banded) {
    if (q < 9 * w.nN) { mt = w.mbase + q % 9; nt = q / 9; }
    else { int q2 = q - 9 * w.nN; mt = w.mbase + 9 + (q2 & 7); nt = q2 >> 3; }
  } else { mt = q / w.nN; nt = q % w.nN; }
}
__device__ __forceinline__ void phase1(const Params& p, int bid, int nb, char* smem) {
  const u16* xb = (const u16*)(p.ws + WS_X);
  const u16* wt = (const u16*)(p.ws + WS_WIN);
  const float* r1 = (const float*)(p.ws + WS_R1);
  u16* proj = (u16*)(p.ws + WS_PROJ);
  const TileWalk tw = tile_walk(28, bid, nb);
  for (int t = tw.q; t < tw.total; t += tw.step) {
    int mt_, nt_;
    tile_get(tw, t, mt_, nt_);
    int m0 = mt_ * 128, n0 = nt_ * 128;
    f32x4 acc[4][4];
#pragma unroll
    for (int i = 0; i < 4; ++i)
#pragma unroll
      for (int j = 0; j < 4; ++j) acc[i][j] = f32x4{0, 0, 0, 0};
    gemm128(xb + (size_t)m0 * 1024, 1024, wt + (size_t)n0 * 1024, 1024, 1024, smem, acc);
    {
      const int lane_ = threadIdx.x & 63, wave_ = threadIdx.x >> 6;
      const int wm_ = wave_ >> 1, wn_ = wave_ & 1, m_ = lane_ & 15, g_ = lane_ >> 4;
#pragma unroll
      for (int mt = 0; mt < 4; ++mt) {
        const int row = m0 + wm_ * 64 + mt * 16 + m_;
        const float r = r1[row];
#pragma unroll
        for (int k2 = 0; k2 < 2; ++k2) {
          const int col = n0 + wn_ * 64 + 32 * k2 + 8 * g_;
          const f32x4 lo = acc[mt][2 * k2], hi = acc[mt][2 * k2 + 1];
          *(uint4*)(proj + (size_t)row * DPJ + col) =
              make_uint4(pack2(lo[0] * r, lo[1] * r), pack2(lo[2] * r, lo[3] * r), pack2(hi[0] * r, hi[1] * r), pack2(hi[2] * r, hi[3] * r));
        }
      }
    }
  }
}

template <bool SAMPLE>
__device__ __forceinline__ void conv_tile(const Params& p, int item, char* smem) {
  constexpr int NTK = SAMPLE ? 8 : 32;
  const int tid = threadIdx.x, lane = tid & 63, wave = tid >> 6;
  const u16* proj = (const u16*)(p.ws + WS_PROJ);
  u16* cact = (u16*)((char*)p.out + YS_CACT);
  int b, pos0, row0;
  if (SAMPLE) { b = item; pos0 = 0; row0 = NP + b * 8; }
  else { b = item >> 6; pos0 = (item & 63) * 32; row0 = b * SEQ + pos0; }
  float* Y = (float*)smem;
  const float* cw_ = p.conv_dw_w;
  const float* lng_ = p.conv_ln_g;
  const float* lnb_ = p.conv_ln_b;
  const float* cb_ = p.conv_dw_b;
  asm volatile("" : "+s"(cw_), "+s"(lng_), "+s"(lnb_), "+s"(cb_));
  const bool write_tail = SAMPLE || ((item & 63) == 63);
  constexpr int NR = NTK + 30, GR = 16, NG = (NR + GR - 1) / GR;
  __syncthreads();
#pragma unroll 1
  for (int cp = 0; cp < 2; ++cp) {
    const int c0 = tid + cp * 256;
    float w0[31];
#pragma unroll
    for (int j = 0; j < 31; ++j) w0[j] = cw_[j * 512 + c0];
    float a0[NTK];
#pragma unroll
    for (int t = 0; t < NTK; ++t) a0[t] = 0.f;
    uint32_t ca[GR], cb[GR], na[GR], nb2[GR];
#define CONV_LOAD(r_, A_, B_)                                                                   \
  {                                                                                             \
    A_ = 0; B_ = 0;                                                                             \
    if ((r_) < NR) {                                                                            \
      if (SAMPLE && (r_) < 30) {                                                                \
        A_ = __float_as_uint(p.state_conv[((size_t)b * 30 + (r_)) * 512 + c0]);                 \
      } else {                                                                                  \
        int pos_ = pos0 - 30 + (r_);                                                            \
        int pc_ = pos_ < 0 ? 0 : pos_;                                                          \
        size_t prow_ = SAMPLE ? (size_t)(row0 + (r_) - 30) : (size_t)(b * SEQ + pc_);           \
        uint32_t la_ = proj[prow_ * DPJ + C_GLUA + c0];                                         \
        uint32_t lb_ = proj[prow_ * DPJ + C_GLUB + c0];                                         \
        A_ = (!SAMPLE && pos_ < 0) ? 0u : la_;                                                  \
        B_ = (!SAMPLE && pos_ < 0) ? 0u : lb_;                                                  \
      }                                                                                         \
    }                                                                                           \
  }
#pragma unroll
    for (int rr = 0; rr < GR; ++rr) CONV_LOAD(rr, ca[rr], cb[rr])
#pragma unroll
    for (int gq = 0; gq < NG; ++gq) {
      if (gq + 1 < NG) {
#pragma unroll
        for (int rr = 0; rr < GR; ++rr) CONV_LOAD((gq + 1) * GR + rr, na[rr], nb2[rr])
      }
#pragma unroll
      for (int rr = 0; rr < GR; ++rr) {
        const int r = gq * GR + rr;
        if (r < NR) {
          float u0;
          if (SAMPLE && r < 30) u0 = __uint_as_float(ca[rr]);
          else u0 = bf2f((u16)ca[rr]) * sigmoidf_(bf2f((u16)cb[rr]));
          if (SAMPLE) {
            if (r >= 8) p.out[O_NCS + ((size_t)b * 30 + (r - 8)) * 512 + c0] = u0;
          } else {
            if (write_tail && r >= 32) p.out[O_NCP + ((size_t)b * 30 + (r - 32)) * 512 + c0] = u0;
          }
#pragma unroll
          for (int t = 0; t < NTK; ++t) {
            if (r - t >= 0 && r - t <= 30) a0[t] += w0[r - t] * u0;
          }
        }
      }
#pragma unroll
      for (int rr = 0; rr < GR; ++rr) { ca[rr] = na[rr]; cb[rr] = nb2[rr]; }
      __builtin_amdgcn_sched_barrier(0);
    }
    const float bias = cb_[c0];
#pragma unroll
    for (int t = 0; t < NTK; ++t) Y[t * 512 + c0] = a0[t] + bias;
  }
  __syncthreads();
  for (int t = wave; t < NTK; t += 4) {
    float4 v0 = *(const float4*)(Y + t * 512 + lane * 8);
    float4 v1 = *(const float4*)(Y + t * 512 + lane * 8 + 4);
    float xv[8] = {v0.x, v0.y, v0.z, v0.w, v1.x, v1.y, v1.z, v1.w};
    float s = 0.f;
#pragma unroll
    for (int e = 0; e < 8; ++e) s += xv[e];
    float mean = wave_sum(s) * (1.f / 512.f);
    float q = 0.f;
#pragma unroll
    for (int e = 0; e < 8; ++e) { xv[e] -= mean; q += xv[e] * xv[e]; }
    float rstd = rsqrtf(wave_sum(q) * (1.f / 512.f) + EPS);
    float4 g0 = *(const float4*)(lng_ + lane * 8), g1 = *(const float4*)(lng_ + lane * 8 + 4);
    float4 b0 = *(const float4*)(lnb_ + lane * 8), b1 = *(const float4*)(lnb_ + lane * 8 + 4);
    float gg[8] = {g0.x, g0.y, g0.z, g0.w, g1.x, g1.y, g1.z, g1.w};
    float bb[8] = {b0.x, b0.y, b0.z, b0.w, b1.x, b1.y, b1.z, b1.w};
    float o[8];
#pragma unroll
    for (int e = 0; e < 8; ++e) o[e] = siluf_(xv[e] * rstd * gg[e] + bb[e]);
    *(uint4*)(cact + (size_t)(row0 + t) * 512 + lane * 8) =
        make_uint4(pack2(o[0], o[1]), pack2(o[2], o[3]), pack2(o[4], o[5]), pack2(o[6], o[7]));
  }
}

template <bool SAMPLE> __device__ __forceinline__ constexpr int fidx_w(int mt, int ks) { return SAMPLE ? ks : (mt >> 1) * 26 + (mt & 1) * 4 + ks; }
template <bool SAMPLE> __device__ __forceinline__ constexpr int fidx_q(int mt, int ks) { return SAMPLE ? 4 + ks : (mt >> 1) * 26 + 8 + (mt & 1) * 4 + ks; }
template <bool SAMPLE> __device__ __forceinline__ constexpr int fidx_qk(int mt) { return SAMPLE ? 8 : (mt >> 1) * 26 + 16 + (mt & 1); }
template <bool SAMPLE> __device__ __forceinline__ constexpr int fidx_kd(int dt, int hf) { return SAMPLE ? 9 + dt : hf * 26 + 18 + dt; }

template <bool SAMPLE>
__device__ __forceinline__ void delta_prep(const Params& p, int item, char* smem) {
  constexpr int MT = SAMPLE ? 1 : 4, KS2 = SAMPLE ? 1 : 2, NI = SAMPLE ? 8 : 64;
  const int tid = threadIdx.x, lane = tid & 63, wave = tid >> 6, m = lane & 15, g = lane >> 4;
  const u16* proj = (const u16*)(p.ws + WS_PROJ);
  const float* ab = (const float*)(p.ws + WS_AB);
  int b, h, row0, pos0, chunk;
  uint4* fa; float4* uf;
  if (SAMPLE) {
    b = item >> 2; h = item & 3; row0 = NP + b * 8; pos0 = 0; chunk = 1024 + item;
    fa = (uint4*)(p.ws + WS_FRAG + 1024 * FRAG_P_BYTES + (size_t)item * FRAG_S_BYTES);
    uf = (float4*)((char*)p.out + YS_UF + 1024 * UF_P_BYTES + (size_t)item * UF_S_BYTES);
  } else {
    int bh = item >> 5, n = item & 31; b = bh >> 2; h = bh & 3; pos0 = n * 64; row0 = b * SEQ + pos0; chunk = item;
    fa = (uint4*)(p.ws + WS_FRAG + (size_t)item * FRAG_P_BYTES);
    uf = (float4*)((char*)p.out + YS_UF + (size_t)item * UF_P_BYTES);
  }
  u16* KN = (u16*)smem;
  u16* QN = KN + 64 * 136;
  float* AM = (float*)(QN + 64 * 136);
  float* gcs = AM + 64 * 64;
  float* bts = gcs + 64;
  __syncthreads();
  if (wave == 0) {
    int i = lane; float gi = 0.f, bi = 0.f;
    if (i < NI) {
      const float* abr = ab + (size_t)(row0 + i) * 8;
      bi = sigmoidf_(abr[h]);
      float a = abr[4 + h] + p.dn_dt_bias[h];
      float sp = a > 20.f ? a : log1pf(expf(a));
      gi = -expf(p.dn_a_log[h]) * sp;
    }
    float c = gi;
#pragma unroll
    for (int off = 1; off < 64; off <<= 1) { float t = __shfl_up(c, off); if (lane >= off) c += t; }
    if (!SAMPLE) { float c31 = __shfl(c, 31); if (lane >= 32) c -= c31; }
    gcs[i] = c; bts[i] = bi;
  }
  __syncthreads();
  {
    const int sec = tid >> 7, c = tid & 127;
    const int col = sec * 512 + h * 128 + c;
    u16* dstm = sec ? KN : QN;
    const float w0 = p.dn_conv_w[col], w1 = p.dn_conv_w[1536 + col], w2 = p.dn_conv_w[2 * 1536 + col], w3 = p.dn_conv_w[3 * 1536 + col];
    float rr[3];
#pragma unroll
    for (int jj = 0; jj < 3; ++jj) {
      if (SAMPLE) rr[jj] = p.state_dn_conv[((size_t)b * 3 + jj) * 1536 + col];
      else rr[jj] = (pos0 > 0) ? bf2f(proj[(size_t)(row0 - 3 + jj) * DPJ + C_QKV + col]) : 0.f;
    }
    float ra = rr[0], rb = rr[1], rc = rr[2];
    const u16* pcol = proj + (size_t)row0 * DPJ + C_QKV + col;
    u16 raw[NI];
#pragma unroll
    for (int i = 0; i < NI; ++i) raw[i] = pcol[(size_t)i * DPJ];
#pragma unroll
    for (int i = 0; i < NI; ++i) {
      float rd = bf2f(raw[i]);
      float v = siluf_(w0 * ra + w1 * rb + w2 * rc + w3 * rd);
      dstm[i * 136 + c] = f2bf(v);
      ra = rb; rb = rc; rc = rd;
    }
#pragma unroll
    for (int i = NI; i < 64; ++i) dstm[i * 136 + c] = 0;
  }
  __syncthreads();
  {
    const int i = wave * 16 + m;
    const bool valid = i < NI;
    float eq[32], ek[32];
#pragma unroll
    for (int kh = 0; kh < 8; ++kh) {
      const int cc = (kh >> 1) * 32 + (kh & 1) * 16 + 4 * g;
      uint2 kv = *(const uint2*)(KN + i * 136 + cc);
      uint2 qv = *(const uint2*)(QN + i * 136 + cc);
      ek[kh * 4] = bflo(kv.x); ek[kh * 4 + 1] = bfhi(kv.x); ek[kh * 4 + 2] = bflo(kv.y); ek[kh * 4 + 3] = bfhi(kv.y);
      eq[kh * 4] = bflo(qv.x); eq[kh * 4 + 1] = bfhi(qv.x); eq[kh * 4 + 2] = bflo(qv.y); eq[kh * 4 + 3] = bfhi(qv.y);
    }
    float sq = 0.f, sk = 0.f;
#pragma unroll
    for (int e = 0; e < 32; ++e) { sq += eq[e] * eq[e]; sk += ek[e] * ek[e]; }
    sq += __shfl_xor(sq, 16); sq += __shfl_xor(sq, 32);
    sk += __shfl_xor(sk, 16); sk += __shfl_xor(sk, 32);
    const float rq = valid ? rsqrtf(sq + EPS) * 0.08838834764831845f : 0.f;
    const float rk = valid ? rsqrtf(sk + EPS) : 0.f;
#pragma unroll
    for (int e = 0; e < 32; ++e) { eq[e] *= rq; ek[e] *= rk; }
#pragma unroll
    for (int kh = 0; kh < 8; ++kh) {
      const int cc = (kh >> 1) * 32 + (kh & 1) * 16 + 4 * g;
      *(uint2*)(KN + i * 136 + cc) = make_uint2(pack2(ek[kh * 4], ek[kh * 4 + 1]), pack2(ek[kh * 4 + 2], ek[kh * 4 + 3]));
      *(uint2*)(QN + i * 136 + cc) = make_uint2(pack2(eq[kh * 4], eq[kh * 4 + 1]), pack2(eq[kh * 4 + 2], eq[kh * 4 + 3]));
    }
    if (wave < MT) {
      const float ei = __expf(gcs[i]);
#pragma unroll
      for (int ks = 0; ks < 4; ++ks) {
        const int e0 = ks * 8;
        fa[fidx_q<SAMPLE>(wave, ks) * 64 + lane] =
            make_uint4(pack2(eq[e0] * ei, eq[e0 + 1] * ei), pack2(eq[e0 + 2] * ei, eq[e0 + 3] * ei),
                       pack2(eq[e0 + 4] * ei, eq[e0 + 5] * ei), pack2(eq[e0 + 6] * ei, eq[e0 + 7] * ei));
      }
    }
  }
  __syncthreads();
  if (wave < MT) {
    const int it = wave;
    bf16x8 knI[4], qnI[4];
#pragma unroll
    for (int ks = 0; ks < 4; ++ks) {
      knI[ks] = *(const bf16x8*)(KN + (16 * it + m) * 136 + 32 * ks + 8 * g);
      qnI[ks] = *(const bf16x8*)(QN + (16 * it + m) * 136 + 32 * ks + 8 * g);
    }
    f32x4 qkv_[4];
#pragma unroll
    for (int jt = 0; jt < 4; ++jt) qkv_[jt] = f32x4{0, 0, 0, 0};
    const float gi_n = gcs[16 * it + m];
#pragma unroll
    for (int jt = 0; jt < 4; ++jt) {
      if (jt <= it && (SAMPLE || (jt >> 1) == (it >> 1))) {
        bf16x8 knJ[4];
#pragma unroll
        for (int ks = 0; ks < 4; ++ks) knJ[ks] = *(const bf16x8*)(KN + (16 * jt + m) * 136 + 32 * ks + 8 * g);
        f32x4 aa = f32x4{0, 0, 0, 0}, qq = f32x4{0, 0, 0, 0};
#pragma unroll
        for (int ks = 0; ks < 4; ++ks) { aa = MFMA(knI[ks], knJ[ks], aa); qq = MFMA(knJ[ks], qnI[ks], qq); }
        const int jA = 16 * jt + m;
        const float gj = gcs[jA];
#pragma unroll
        for (int r = 0; r < 4; ++r) {
          const int iA = 16 * it + 4 * g + r;
          float val = (jA < iA) ? bts[iA] * __expf(gcs[iA] - gj) * aa[r] : 0.f;
          AM[iA * 64 + jA] = val;
        }
        const int iQ = 16 * it + m;
#pragma unroll
        for (int r = 0; r < 4; ++r) {
          const int jQ = 16 * jt + 4 * g + r;
          qkv_[jt][r] = (jQ <= iQ) ? __expf(gi_n - gcs[jQ]) * qq[r] : 0.f;
        }
      }
    }
    {
      const bool up = !SAMPLE && (it >> 1);
      f32x4 lo = up ? qkv_[2] : qkv_[0], hi = up ? qkv_[3] : qkv_[1];
      fa[fidx_qk<SAMPLE>(it) * 64 + lane] =
          make_uint4(pack2(lo[0], lo[1]), pack2(lo[2], lo[3]), pack2(hi[0], hi[1]), pack2(hi[2], hi[3]));
    }
  }
  {
#pragma unroll
    for (int dd = 0; dd < 2; ++dd) {
      const int dt = 2 * wave + dd;
#pragma unroll
      for (int hf = 0; hf < KS2; ++hf) {
        const float gl = gcs[SAMPLE ? 63 : 32 * hf + 31];
        float vv[8];
#pragma unroll
        for (int e = 0; e < 8; ++e) {
          const int i = 32 * hf + (e >> 2) * 16 + 4 * g + (e & 3);
          vv[e] = bf2f(KN[i * 136 + 16 * dt + m]) * __expf(gl - gcs[i]);
        }
        fa[fidx_kd<SAMPLE>(dt, hf) * 64 + lane] =
            make_uint4(pack2(vv[0], vv[1]), pack2(vv[2], vv[3]), pack2(vv[4], vv[5]), pack2(vv[6], vv[7]));
      }
    }
    if (tid == 0) {
      float* gla = (float*)(p.ws + WS_GLAST);
      if (SAMPLE) gla[2048 + item] = __expf(gcs[63]);
      else { gla[2 * item] = __expf(gcs[31]); gla[2 * item + 1] = __expf(gcs[63]); }
    }
  }
  __syncthreads();
  float x[NI];
  {
  if (tid < 128) {
    const int dv = tid;
    const int col = 1024 + h * 128 + dv;
    const float w0 = p.dn_conv_w[col], w1 = p.dn_conv_w[1536 + col], w2 = p.dn_conv_w[2 * 1536 + col], w3 = p.dn_conv_w[3 * 1536 + col];
    float rr[3];
#pragma unroll
    for (int jj = 0; jj < 3; ++jj) {
      if (SAMPLE) rr[jj] = p.state_dn_conv[((size_t)b * 3 + jj) * 1536 + col];
      else rr[jj] = (pos0 > 0) ? bf2f(proj[(size_t)(row0 - 3 + jj) * DPJ + C_QKV + col]) : 0.f;
    }
    float ra = rr[0], rb = rr[1], rc = rr[2];
    const u16* pcol = proj + (size_t)row0 * DPJ + C_QKV + col;
#pragma unroll
    for (int i = 0; i < NI; ++i) x[i] = bf2f(pcol[(size_t)i * DPJ]);
    __builtin_amdgcn_sched_barrier(0);
#pragma unroll
    for (int i = 0; i < NI; ++i) {
      float rd = x[i];
      float v = siluf_(w0 * ra + w1 * rb + w2 * rc + w3 * rd);
      x[i] = bts[i] * v;
      ra = rb; rb = rc; rc = rd;
    }
  } else {
    const int dk = tid - 128;
#pragma unroll
    for (int i = 0; i < NI; ++i) x[i] = bts[i] * __expf(gcs[i]) * bf2f(KN[i * 136 + dk]);
  }
  {
    constexpr int NSUB = SAMPLE ? 1 : 2, NLI = SAMPLE ? 8 : 32;
#pragma unroll
    for (int hf = 0; hf < NSUB; ++hf) {
      float4 ac[8], an[8];
#pragma unroll
      for (int j4 = 0; j4 < 8; ++j4) { ac[j4] = make_float4(0, 0, 0, 0); an[j4] = make_float4(0, 0, 0, 0); }
      ac[0] = *(const float4*)(AM + (32 * hf + 1) * 64 + 32 * hf);
#pragma unroll
      for (int li = 1; li < NLI; ++li) {
        if (li + 1 < NLI) {
#pragma unroll
          for (int j4 = 0; j4 < 8; ++j4)
            if (j4 < (li + 4) / 4) an[j4] = *(const float4*)(AM + (32 * hf + li + 1) * 64 + 32 * hf + j4 * 4);
        }
        float acc0 = x[32 * hf + li], acc1 = 0.f;
#pragma unroll
        for (int j4 = 0; j4 < 8; ++j4) {
          if (j4 < (li + 3) / 4) {
            float4 a = ac[j4];
            if (j4 * 4 + 0 < li) acc0 -= a.x * x[32 * hf + j4 * 4 + 0];
            if (j4 * 4 + 1 < li) acc1 -= a.y * x[32 * hf + j4 * 4 + 1];
            if (j4 * 4 + 2 < li) acc0 -= a.z * x[32 * hf + j4 * 4 + 2];
            if (j4 * 4 + 3 < li) acc1 -= a.w * x[32 * hf + j4 * 4 + 3];
          }
        }
        x[32 * hf + li] = acc0 + acc1;
#pragma unroll
        for (int j4 = 0; j4 < 8; ++j4) ac[j4] = an[j4];
        __builtin_amdgcn_sched_barrier(0);
      }
    }
  }
  }
  __syncthreads();
  u16* WM = KN;
  if (tid < 128) {
    const int dv = tid, s = dv >> 4, n = dv & 15;
#pragma unroll
    for (int mt = 0; mt < MT; ++mt)
#pragma unroll
      for (int g4 = 0; g4 < 4; ++g4) {
        const int i0 = 16 * mt + 4 * g4;
        float4 o;
        o.x = (i0 + 0 < NI) ? x[(i0 + 0 < NI) ? i0 + 0 : 0] : 0.f;
        o.y = (i0 + 1 < NI) ? x[(i0 + 1 < NI) ? i0 + 1 : 0] : 0.f;
        o.z = (i0 + 2 < NI) ? x[(i0 + 2 < NI) ? i0 + 2 : 0] : 0.f;
        o.w = (i0 + 3 < NI) ? x[(i0 + 3 < NI) ? i0 + 3 : 0] : 0.f;
        uf[(s * MT + mt) * 64 + g4 * 16 + n] = o;
      }
  } else {
    const int dk = tid - 128;
#pragma unroll
    for (int i = 0; i < 16 * MT; ++i) WM[i * 136 + dk] = (i < NI) ? f2bf(-x[(i < NI) ? i : 0]) : (u16)0;
  }
  __syncthreads();
  {
    const int mt = SAMPLE ? 0 : wave;
#pragma unroll
    for (int q = 0; q < (SAMPLE ? 1 : 4); ++q) {
      const int ks = SAMPLE ? wave : q;
      uint2 lo = *(const uint2*)(WM + (16 * mt + m) * 136 + 32 * ks + 4 * g);
      uint2 hi = *(const uint2*)(WM + (16 * mt + m) * 136 + 32 * ks + 16 + 4 * g);
      fa[fidx_w<SAMPLE>(mt, ks) * 64 + lane] = make_uint4(lo.x, lo.y, hi.x, hi.y);
    }
  }
  if (SAMPLE || (item & 31) == 31) {
    float* dst = p.out + (SAMPLE ? O_NDS : O_NDP);
    for (int idx = tid; idx < 3 * 384; idx += 256) {
      int j = idx / 384, cc = idx % 384, sec = cc >> 7, c = cc & 127;
      int col = sec * 512 + h * 128 + c;
      dst[((size_t)b * 3 + j) * 1536 + col] = bf2f(proj[(size_t)(row0 + NI - 3 + j) * DPJ + C_QKV + col]);
    }
  }
}

template <bool SAMPLE>
__device__ __forceinline__ void delta_seq(const Params& p, int item, char* smem) {
  constexpr int MT = SAMPLE ? 1 : 4, KS2 = SAMPLE ? 1 : 2, NI = SAMPLE ? 8 : 64, NC = SAMPLE ? 1 : 32;
  constexpr int NF = MT * 8 + MT * KS2 + 8 * KS2;
  static_assert(SAMPLE, "prompt chains use delta_seq_p");
  constexpr int W_OFF = 0, Q_OFF = MT * 4, QK_OFF = MT * 8, KD_OFF = MT * 8 + MT * KS2;
  constexpr int NPRE = (NF * 64 + 255) / 256;
  const int tid = threadIdx.x, lane = tid & 63, wave = tid >> 6, n = lane & 15, g = lane >> 4;
  const int bh = item >> 1, half = item & 1, b = bh >> 2, h = bh & 3;
  const int s = half * 4 + wave;
  const float* glast = (const float*)(p.ws + WS_GLAST);
  u16* ofp = (u16*)(p.ws + WS_X);
  const uint4* fa0; const float4* uf0; int chunk0, row00;
  if (SAMPLE) {
    fa0 = (const uint4*)(p.ws + WS_FRAG + 1024 * FRAG_P_BYTES + (size_t)bh * FRAG_S_BYTES);
    uf0 = (const float4*)((char*)p.out + YS_UF + 1024 * UF_P_BYTES + (size_t)bh * UF_S_BYTES);
    chunk0 = 2048 + bh; row00 = NP + b * 8;
  } else {
    fa0 = (const uint4*)(p.ws + WS_FRAG + (size_t)bh * 32 * FRAG_P_BYTES);
    uf0 = (const float4*)((char*)p.out + YS_UF + (size_t)bh * 32 * UF_P_BYTES);
    chunk0 = bh * 32; row00 = b * SEQ;
  }
  constexpr size_t FSTR = (SAMPLE ? FRAG_S_BYTES : FRAG_P_BYTES) / 16, USTR = (SAMPLE ? UF_S_BYTES : UF_P_BYTES) / 16;
  uint4* L = (uint4*)smem;
  f32x4 S[8];
  if (SAMPLE) {
    const float* s0 = p.state_dn_S + (size_t)bh * 16384;
#pragma unroll
    for (int dt = 0; dt < 8; ++dt)
#pragma unroll
      for (int r = 0; r < 4; ++r) S[dt][r] = s0[(16 * dt + 4 * g + r) * 128 + 16 * s + n];
  } else {
#pragma unroll
    for (int dt = 0; dt < 8; ++dt) S[dt] = f32x4{0, 0, 0, 0};
  }
  uint4 pre[NPRE];
  f32x4 upre[MT];
  float glpre;
#define SEQ_PREFETCH(c_)                                                                     \
  {                                                                                          \
    const uint4* fa_ = fa0 + (size_t)(c_) * FSTR;                                            \
    _Pragma("unroll") for (int q = 0; q < NPRE; ++q) {                                       \
      int idx = tid + q * 256;                                                               \
      pre[q] = (NF * 64 % 256 == 0 || idx < NF * 64) ? fa_[idx] : make_uint4(0, 0, 0, 0);   \
    }                                                                                        \
    const float4* uf_ = uf0 + (size_t)(c_) * USTR;                                           \
    _Pragma("unroll") for (int mt = 0; mt < MT; ++mt) {                                      \
      float4 t = uf_[(s * MT + mt) * 64 + lane];                                             \
      upre[mt] = f32x4{t.x, t.y, t.z, t.w};                                                  \
    }                                                                                        \
    glpre = glast[chunk0 + (c_)];                                                            \
  }
  SEQ_PREFETCH(0)
#pragma unroll 1
  for (int c = 0; c < NC; ++c) {
    __syncthreads();
#pragma unroll
    for (int q = 0; q < NPRE; ++q) {
      int idx = tid + q * 256;
      if (NF * 64 % 256 == 0 || idx < NF * 64) L[idx] = pre[q];
    }
    f32x4 accV[MT], accO[MT];
#pragma unroll
    for (int mt = 0; mt < MT; ++mt) { accV[mt] = upre[mt]; accO[mt] = f32x4{0, 0, 0, 0}; }
    const float gl = glpre;
    __syncthreads();
    if (c + 1 < NC) SEQ_PREFETCH(c + 1)
    bf16x8 Sb[4];
#pragma unroll
    for (int ks = 0; ks < 4; ++ks)
      Sb[ks] = mk8(pack2(S[2 * ks][0], S[2 * ks][1]), pack2(S[2 * ks][2], S[2 * ks][3]),
                   pack2(S[2 * ks + 1][0], S[2 * ks + 1][1]), pack2(S[2 * ks + 1][2], S[2 * ks + 1][3]));
#pragma unroll
    for (int mt = 0; mt < MT; ++mt)
#pragma unroll
      for (int ks = 0; ks < 4; ++ks) {
        accV[mt] = MFMA(u4_to_b8(L[(W_OFF + mt * 4 + ks) * 64 + lane]), Sb[ks], accV[mt]);
        accO[mt] = MFMA(u4_to_b8(L[(Q_OFF + mt * 4 + ks) * 64 + lane]), Sb[ks], accO[mt]);
        if (ks == 3) __builtin_amdgcn_sched_barrier(0);
      }
    bf16x8 Vb[KS2];
#pragma unroll
    for (int ks2 = 0; ks2 < KS2; ++ks2) {
      f32x4 lo = accV[(2 * ks2 < MT) ? 2 * ks2 : 0];
      f32x4 hi = (2 * ks2 + 1 < MT) ? accV[(2 * ks2 + 1 < MT) ? 2 * ks2 + 1 : 0] : f32x4{0, 0, 0, 0};
      Vb[ks2] = mk8(pack2(lo[0], lo[1]), pack2(lo[2], lo[3]), pack2(hi[0], hi[1]), pack2(hi[2], hi[3]));
    }
#pragma unroll
    for (int mt = 0; mt < MT; ++mt)
#pragma unroll
      for (int ks2 = 0; ks2 < KS2; ++ks2)
        accO[mt] = MFMA(u4_to_b8(L[(QK_OFF + mt * KS2 + ks2) * 64 + lane]), Vb[ks2], accO[mt]);
#pragma unroll
    for (int dt = 0; dt < 8; ++dt) {
      S[dt] = S[dt] * gl;
#pragma unroll
      for (int ks2 = 0; ks2 < KS2; ++ks2)
        S[dt] = MFMA(u4_to_b8(L[(KD_OFF + dt * KS2 + ks2) * 64 + lane]), Vb[ks2], S[dt]);
      if (dt & 1) __builtin_amdgcn_sched_barrier(0);
    }
    const int rowc = row00 + c * 64;
#pragma unroll
    for (int mt = 0; mt < MT; ++mt)
#pragma unroll
      for (int r = 0; r < 4; ++r) {
        const int i = 16 * mt + 4 * g + r;
        if (i < NI) ofp[(size_t)(rowc + i) * 512 + h * 128 + 16 * s + n] = f2bf(accO[mt][r]);
      }
  }
  float* so = p.out + (SAMPLE ? O_NSS : O_NSP) + (size_t)bh * 16384;
#pragma unroll
  for (int dt = 0; dt < 8; ++dt)
#pragma unroll
    for (int r = 0; r < 4; ++r) so[(16 * dt + 4 * g + r) * 128 + 16 * s + n] = S[dt][r];
  __syncthreads();
}


__device__ __forceinline__ void delta_seq_p(const Params& p, int item, char* smem) {
  constexpr int NFH = 26, NH = 64;
  constexpr int W_OFF = 0, Q_OFF = 8, QK_OFF = 16, KD_OFF = 18;
  constexpr int NV = NFH * 64;
  constexpr int NPRE = (NV + 255) / 256;
  const int tid = threadIdx.x, lane = tid & 63, wave = tid >> 6, n = lane & 15, g = lane >> 4;
  const int bh = item >> 1, half = item & 1, b = bh >> 2, h = bh & 3;
  const int s = half * 4 + wave;
  const float* glast = (const float*)(p.ws + WS_GLAST) + (size_t)bh * 64;
  u16* ofp = (u16*)(p.ws + WS_X);
  const uint4* fa0 = (const uint4*)(p.ws + WS_FRAG + (size_t)bh * 32 * FRAG_P_BYTES);
  const float4* uf0 = (const float4*)((char*)p.out + YS_UF + (size_t)bh * 32 * UF_P_BYTES);
  const int row00 = b * SEQ;
  uint4* L = (uint4*)smem;
  f32x4 S[8];
#pragma unroll
  for (int dt = 0; dt < 8; ++dt) S[dt] = f32x4{0, 0, 0, 0};
  uint4 PA[NPRE], PB[NPRE];
  f32x4 UA[2], UB[2];
  float GA = 0.f, GB = 0.f; (void)GA; (void)GB;
  constexpr int TOUCH_AHEAD = 8;
  uint32_t TA = 0, TB = 0, tsink = 0;
#define SEQP_TOUCH(T_, hs_)                                                                     \
  {                                                                                             \
    tsink ^= T_;                                                                                \
    const int ht_ = (hs_) + TOUCH_AHEAD;                                                        \
    if (ht_ < NH) {                                                                             \
      const int c64_ = ht_ >> 1, hf_ = ht_ & 1;                                                 \
      const uint32_t* fl_ = (const uint32_t*)(fa0 + (size_t)c64_ * (FRAG_P_BYTES / 16) + hf_ * NV);  \
      const uint32_t* ul_ = (const uint32_t*)(uf0 + (size_t)c64_ * (UF_P_BYTES / 16));            \
      uint32_t t0_ = (tid < 208) ? fl_[tid * 32] : 0u;                                          \
      uint32_t t1_ = (tid < 64) ? ul_[(((half * 4 + (tid >> 4)) * 4 + 2 * hf_ + ((tid >> 3) & 1)) * 64) * 4 + (tid & 7) * 32] : 0u; \
      T_ = t0_ ^ t1_;                                                                           \
    }                                                                                           \
  }
#define SEQP_LOAD(P_, U_, G_, hs_)                                                              \
  {                                                                                             \
    const int c64_ = (hs_) >> 1, hf_ = (hs_) & 1;                                               \
    const uint4* fa_ = fa0 + (size_t)c64_ * (FRAG_P_BYTES / 16) + hf_ * NV;                     \
    _Pragma("unroll") for (int q = 0; q < NPRE; ++q) {                                          \
      int idx = tid + q * 256;                                                                  \
      P_[q] = (idx < NV) ? fa_[idx] : make_uint4(0, 0, 0, 0);                                   \
    }                                                                                           \
    const float4* uf_ = uf0 + (size_t)c64_ * (UF_P_BYTES / 16);                                 \
    _Pragma("unroll") for (int mt = 0; mt < 2; ++mt) {                                          \
      float4 t = uf_[(s * 4 + 2 * hf_ + mt) * 64 + lane];                                       \
      U_[mt] = f32x4{t.x, t.y, t.z, t.w};                                                       \
    }                                                                                           \
  }
#define SEQP_STEP(P_, U_, G_, T_, hs_, buf_)                                                        \
  {                                                                                             \
    uint4* Lb = L + (buf_) * NV;                                                                \
    _Pragma("unroll") for (int q = 0; q < NPRE; ++q) {                                          \
      int idx = tid + q * 256;                                                                  \
      if (idx < NV) Lb[idx] = P_[q];                                                            \
    }                                                                                           \
    f32x4 accV[2], accO[2];                                                                     \
    accV[0] = U_[0]; accV[1] = U_[1];                                                           \
    accO[0] = f32x4{0, 0, 0, 0}; accO[1] = f32x4{0, 0, 0, 0};                                   \
    __syncthreads();                                                                            \
    const float gl = gls[(hs_)];                                                                \
    if ((hs_) + 2 < NH) SEQP_LOAD(P_, U_, G_, (hs_) + 2)                                        \
    bf16x8 Sb[4];                                                                               \
    _Pragma("unroll") for (int ks = 0; ks < 4; ++ks)                                            \
      Sb[ks] = mk8(pack2(S[2 * ks][0], S[2 * ks][1]), pack2(S[2 * ks][2], S[2 * ks][3]),        \
                   pack2(S[2 * ks + 1][0], S[2 * ks + 1][1]), pack2(S[2 * ks + 1][2], S[2 * ks + 1][3])); \
    _Pragma("unroll") for (int mt = 0; mt < 2; ++mt)                                            \
      _Pragma("unroll") for (int ks = 0; ks < 4; ++ks) {                                        \
        accV[mt] = MFMA(u4_to_b8(Lb[(W_OFF + mt * 4 + ks) * 64 + lane]), Sb[ks], accV[mt]);     \
        accO[mt] = MFMA(u4_to_b8(Lb[(Q_OFF + mt * 4 + ks) * 64 + lane]), Sb[ks], accO[mt]);     \
      }                                                                                         \
    __builtin_amdgcn_sched_barrier(0);                                                          \
    bf16x8 Vb = mk8(pack2(accV[0][0], accV[0][1]), pack2(accV[0][2], accV[0][3]),               \
                    pack2(accV[1][0], accV[1][1]), pack2(accV[1][2], accV[1][3]));              \
    _Pragma("unroll") for (int mt = 0; mt < 2; ++mt)                                            \
      accO[mt] = MFMA(u4_to_b8(Lb[(QK_OFF + mt) * 64 + lane]), Vb, accO[mt]);                   \
    _Pragma("unroll") for (int dt = 0; dt < 8; ++dt) {                                          \
      S[dt] = S[dt] * gl;                                                                       \
      S[dt] = MFMA(u4_to_b8(Lb[(KD_OFF + dt) * 64 + lane]), Vb, S[dt]);                         \
    }                                                                                           \
    const int rowc = row00 + (hs_) * 32;                                                        \
    _Pragma("unroll") for (int mt = 0; mt < 2; ++mt)                                            \
      _Pragma("unroll") for (int r = 0; r < 4; ++r)                                             \
        ofp[(size_t)(rowc + 16 * mt + 4 * g + r) * 512 + h * 128 + 16 * s + n] = f2bf(accO[mt][r]);   \
  }
  __syncthreads();
  float* gls = (float*)(smem + 2 * NV * 16);
  if (tid < 64) gls[tid] = glast[tid];
  SEQP_LOAD(PA, UA, GA, 0)
  SEQP_LOAD(PB, UB, GB, 1)
#pragma unroll 1
  for (int hs = 0; hs < NH; hs += 2) {
    SEQP_STEP(PA, UA, GA, TA, hs, 0)
    SEQP_STEP(PB, UB, GB, TB, hs + 1, 1)
  }
  float* so = p.out + O_NSP + (size_t)bh * 16384;
#pragma unroll
  for (int dt = 0; dt < 8; ++dt)
#pragma unroll
    for (int r = 0; r < 4; ++r) so[(16 * dt + 4 * g + r) * 128 + 16 * s + n] = S[dt][r];
  __syncthreads();
}

template <int MH>
__device__ __forceinline__ void g2_tile(const Params& p, int m0, int n0, char* smem) {
  const u16* cact = (const u16*)((const char*)p.out + YS_CACT);
  const u16* pw = (const u16*)(p.ws + WS_PW);
  const u16* proj = (const u16*)(p.ws + WS_PROJ);
  u16* cmix = (u16*)(p.ws + WS_CMIX);
  f32x4 acc[4][4];
#pragma unroll
  for (int i = 0; i < 4; ++i)
#pragma unroll
    for (int j = 0; j < 4; ++j) acc[i][j] = f32x4{0, 0, 0, 0};
  gemm128<false, MH>(cact + (size_t)m0 * 512, 512, pw + (size_t)n0 * 512, 512, 512, smem, acc);
  uint2 gpre[4][4];
  GEMM_EPILOGUE_M(acc, m0, n0, MH, { (void)v; gpre[mt][nt] = *(const uint2*)(proj + (size_t)row * DPJ + C_GATE + col); })
  GEMM_EPILOGUE_M(acc, m0, n0, MH, {
    uint2 gv = gpre[mt][nt];
    float o0 = v[0] * siluf_(bflo(gv.x)), o1 = v[1] * siluf_(bfhi(gv.x));
    float o2 = v[2] * siluf_(bflo(gv.y)), o3 = v[3] * siluf_(bfhi(gv.y));
    *(uint2*)(cmix + (size_t)row * 512 + col) = make_uint2(pack2(o0, o1), pack2(o2, o3));
  })
}


__device__ __forceinline__ void phase4(const Params& p, int bid, int nb, char* smem) {
  const int nfull4 = (544 / nb) * nb, rem4 = 544 - nfull4;
  const int nhalf4 = (2 * rem4 <= nb) ? 2 * rem4 : 0;
#pragma unroll 1
  for (int it = bid; it < (nhalf4 > 0 ? nfull4 : 544); it += nb) g2_tile<4>(p, (it >> 2) * 128, (it & 3) * 128, smem);
  if (bid < nhalf4) {
    const int it = nfull4 + (bid >> 1);
    g2_tile<2>(p, (it >> 2) * 128 + (bid & 1) * 64, (it & 3) * 128, smem);
  }
  const int tid = threadIdx.x, lane = tid & 63, wave = tid >> 6;
  const u16* ofp = (const u16*)(p.ws + WS_X);
  const u16* proj = (const u16*)(p.ws + WS_PROJ);
  u16* omix = (u16*)(p.ws + WS_OMIX);
  const int nheavy4 = nhalf4 > 0 ? nhalf4 : ((544 > nb && 544 < 2 * nb) ? 544 - nb : 0);
  if (bid < nheavy4) return;
  const int ob = bid - nheavy4, onb = nb - nheavy4;
  for (int row = ob * 4 + wave; row < NT; row += onb * 4) {
    const uint4 ov = *(const uint4*)(ofp + (size_t)row * 512 + lane * 8);
    float o[8] = {bflo(ov.x), bfhi(ov.x), bflo(ov.y), bfhi(ov.y), bflo(ov.z), bfhi(ov.z), bflo(ov.w), bfhi(ov.w)};
    float ss = 0.f;
#pragma unroll
    for (int e = 0; e < 8; ++e) ss += o[e] * o[e];
    ss += __shfl_xor(ss, 1); ss += __shfl_xor(ss, 2); ss += __shfl_xor(ss, 4); ss += __shfl_xor(ss, 8);
    float r = rsqrtf(ss * (1.f / 128.f) + EPS);
    uint4 zv = *(const uint4*)(proj + (size_t)row * DPJ + C_Z + lane * 8);
    float z[8] = {bflo(zv.x), bfhi(zv.x), bflo(zv.y), bfhi(zv.y), bflo(zv.z), bfhi(zv.z), bflo(zv.w), bfhi(zv.w)};
    float4 g0 = *(const float4*)(p.dn_norm_g + (lane & 15) * 8), g1 = *(const float4*)(p.dn_norm_g + (lane & 15) * 8 + 4);
    float gg[8] = {g0.x, g0.y, g0.z, g0.w, g1.x, g1.y, g1.z, g1.w};
    float y[8];
#pragma unroll
    for (int e = 0; e < 8; ++e) y[e] = o[e] * r * gg[e] * siluf_(z[e]);
    *(uint4*)(omix + (size_t)row * 512 + lane * 8) = make_uint4(pack2(y[0], y[1]), pack2(y[2], y[3]), pack2(y[4], y[5]), pack2(y[6], y[7]));
  }
}

__device__ __forceinline__ void ple_tile(const Params& p, int t, char* smem) {
  const u16* pb = (const u16*)(p.ws + WS_PB2);
  const u16* pp = (const u16*)(p.ws + WS_PPROJ);
  u16* pl = (u16*)(p.ws + WS_PL);
  int m0 = (t >> 3) * 128, n0 = (t & 7) * 128;
  f32x4 acc[4][4];
#pragma unroll
  for (int i = 0; i < 4; ++i)
#pragma unroll
    for (int j = 0; j < 4; ++j) acc[i][j] = f32x4{0, 0, 0, 0};
  gemm128<false>(pb + (size_t)m0 * 256, 256, pp + (size_t)n0 * 256, 256, 256, smem, acc);
  GEMM_EPILOGUE(acc, m0, n0, {
    *(uint2*)(pl + (size_t)row * 1024 + col) = make_uint2(pack2(v[0], v[1]), pack2(v[2], v[3]));
  })
}

template <int MH>
__device__ __forceinline__ void g3_unit(const Params& p, int m0, int n0, char* smem, bool do_atomic) {
  const u16* cmix = (const u16*)(p.ws + WS_CMIX);
  const u16* omix = (const u16*)(p.ws + WS_OMIX);
  const u16* wo = (const u16*)(p.ws + WS_WOUT);
  u16* x1b = (u16*)(p.ws + WS_X);
  float* ss2 = (float*)(p.ws + WS_SS2);
  float* y = p.out + O_Y;
  f32x4 acc[4][4];
#pragma unroll
  for (int i = 0; i < 4; ++i)
#pragma unroll
    for (int j = 0; j < 4; ++j) acc[i][j] = f32x4{0, 0, 0, 0};
  gemm128<false, MH>(cmix + (size_t)m0 * 512, 512, wo + (size_t)n0 * 1024, 1024, 512, smem, acc);
  gemm128<false, MH>(omix + (size_t)m0 * 512, 512, wo + (size_t)n0 * 1024 + 512, 1024, 512, smem, acc);
  float rs[4] = {0, 0, 0, 0};
  float4 xpre[4][4];
  GEMM_EPILOGUE_M(acc, m0, n0, MH, { (void)v; xpre[mt][nt] = *(const float4*)(xrow(p, row) + col); })
  GEMM_EPILOGUE_M(acc, m0, n0, MH, {
    float4 xv = xpre[mt][nt];
    float o0 = xv.x + v[0], o1 = xv.y + v[1], o2 = xv.z + v[2], o3 = xv.w + v[3];
    *(uint2*)(x1b + (size_t)row * 1024 + col) = make_uint2(pack2(o0, o1), pack2(o2, o3));
    rs[mt] += o0 * o0 + o1 * o1 + o2 * o2 + o3 * o3;
  })
  {
    const int lane = threadIdx.x & 63, wave = threadIdx.x >> 6;
#pragma unroll
    for (int mt = 0; mt < MH; ++mt) {
      float sq = rs[mt];
      sq += __shfl_xor(sq, 16); sq += __shfl_xor(sq, 32);
      if (lane < 16 && do_atomic) atomicAdd(&ss2[m0 + (wave >> 1) * (16 * MH) + mt * 16 + lane], sq);
    }
  }
}

template <int MH>
__device__ __forceinline__ void g4_unit(const Params& p, int m0, int n0, char* smem, bool do_atomic) {
  const u16* x1b = (const u16*)(p.ws + WS_X);
  const u16* pl = (const u16*)(p.ws + WS_PL);
  const u16* gt = (const u16*)(p.ws + WS_GATE);
  const float* ss2 = (const float*)(p.ws + WS_SS2);
  float* ss3 = (float*)(p.ws + WS_SS3);
  const float* y = p.out + O_Y;
  u16* x2b = (u16*)(p.ws + WS_X2B);
  f32x4 acc[4][4];
#pragma unroll
  for (int i = 0; i < 4; ++i)
#pragma unroll
    for (int j = 0; j < 4; ++j) acc[i][j] = f32x4{0, 0, 0, 0};
  gemm128<false, MH>(x1b + (size_t)m0 * 1024, 1024, gt + (size_t)n0 * 1024, 1024, 1024, smem, acc);
  float rs[4] = {0, 0, 0, 0};
  uint2 ypre[4][4];
  uint2 ppre[4][4];
  float r2pre[4];
  GEMM_EPILOGUE_M(acc, m0, n0, MH, {
    (void)v;
    ypre[mt][nt] = *(const uint2*)(x1b + (size_t)row * 1024 + col);
    ppre[mt][nt] = *(const uint2*)(pl + (size_t)row * 1024 + col);
    if (nt == 0) r2pre[mt] = ss2[row];
  })
  GEMM_EPILOGUE_M(acc, m0, n0, MH, {
    float r2 = rsqrtf(r2pre[mt] * (1.f / 1024.f) + EPS);
    uint2 xv = ypre[mt][nt];
    uint2 pv = ppre[mt][nt];
    float o0 = bflo(xv.x) + sigmoidf_(v[0] * r2) * bflo(pv.x), o1 = bfhi(xv.x) + sigmoidf_(v[1] * r2) * bfhi(pv.x);
    float o2 = bflo(xv.y) + sigmoidf_(v[2] * r2) * bflo(pv.y), o3 = bfhi(xv.y) + sigmoidf_(v[3] * r2) * bfhi(pv.y);
    *(uint2*)(x2b + (size_t)row * 1024 + col) = make_uint2(pack2(o0, o1), pack2(o2, o3));
    rs[mt] += o0 * o0 + o1 * o1 + o2 * o2 + o3 * o3;
  })
  {
    const int lane = threadIdx.x & 63, wave = threadIdx.x >> 6;
#pragma unroll
    for (int mt = 0; mt < MH; ++mt) {
      float sq = rs[mt];
      sq += __shfl_xor(sq, 16); sq += __shfl_xor(sq, 32);
      if (lane < 16 && do_atomic) atomicAdd(&ss3[m0 + (wave >> 1) * (16 * MH) + mt * 16 + lane], sq);
    }
  }
}

template <int G>
__device__ __forceinline__ void g34_tiles(const Params& p, int bid, int nb, char* smem, bool do_atomic, bool& heavy, int& nlight, int& lidx) {
  const TileWalk tw = tile_walk(8, bid, nb);
  heavy = false; nlight = nb; lidx = bid;
  if (tw.banded && tw.total > tw.step) {
    const int nfull = (tw.total / tw.step) * tw.step, rem = tw.total - nfull;
#pragma unroll 1
    for (int t = tw.q; t < nfull; t += tw.step) {
      int mt_, nt_;
      tile_get(tw, t, mt_, nt_);
      if (G == 0) g3_unit<4>(p, mt_ * 128, nt_ * 128, smem, do_atomic); else g4_unit<4>(p, mt_ * 128, nt_ * 128, smem, do_atomic);
    }
    const int nhalf = 2 * rem <= tw.step ? 2 * rem : 0;
    if (nhalf > 0) {
      if (tw.q < nhalf) {
        int mt_, nt_;
        tile_get(tw, nfull + (tw.q >> 1), mt_, nt_);
        const int m0 = mt_ * 128 + (tw.q & 1) * 64;
        if (G == 0) g3_unit<2>(p, m0, nt_ * 128, smem, do_atomic); else g4_unit<2>(p, m0, nt_ * 128, smem, do_atomic);
        heavy = true;
      }
      nlight = (tw.step - nhalf) * 8; lidx = (tw.q - nhalf) * 8 + (bid & 7);
    } else {
#pragma unroll 1
      for (int t = nfull + tw.q; t < tw.total; t += tw.step) {
        int mt_, nt_;
        tile_get(tw, t, mt_, nt_);
        if (G == 0) g3_unit<4>(p, mt_ * 128, nt_ * 128, smem, do_atomic); else g4_unit<4>(p, mt_ * 128, nt_ * 128, smem, do_atomic);
      }
    }
  } else {
#pragma unroll 1
    for (int t = tw.q; t < tw.total; t += tw.step) {
      int mt_, nt_;
      tile_get(tw, t, mt_, nt_);
      if (G == 0) g3_unit<4>(p, mt_ * 128, nt_ * 128, smem, do_atomic); else g4_unit<4>(p, mt_ * 128, nt_ * 128, smem, do_atomic);
    }
  }
}
__device__ __forceinline__ void phase5(const Params& p, int bid, int nb, char* smem, bool do_atomic = true) {
  bool heavy; int nlight, lidx;
  g34_tiles<0>(p, bid, nb, smem, do_atomic, heavy, nlight, lidx);
  if (do_atomic && !heavy) {
#pragma unroll 1
    for (int it = lidx; it < 1088; it += nlight) ple_tile(p, it, smem);
  }
}
__device__ __forceinline__ void phase6(const Params& p, int bid, int nb, char* smem, bool do_atomic = true) {
  bool heavy; int nlight, lidx;
  g34_tiles<1>(p, bid, nb, smem, do_atomic, heavy, nlight, lidx);
}

__device__ __forceinline__ void phase7(const Params& p, int bid, int nb) {
  const int tid = threadIdx.x;
  const float* ss3 = (const float*)(p.ws + WS_SS3);
  const u16* x2b = (const u16*)(p.ws + WS_X2B);
  float* y = p.out + O_Y;
  for (size_t i = (size_t)bid * 256 + tid; i < (size_t)NT * 128; i += (size_t)nb * 256) {
    const int row = (int)(i >> 7), c = (int)(i & 127) * 8;
    const float r = rsqrtf(ss3[row] * (1.f / 1024.f) + EPS);
    const uint4 v = *(const uint4*)(x2b + (size_t)row * 1024 + c);
    const float4 g0 = *(const float4*)(p.final_norm_g + c), g1 = *(const float4*)(p.final_norm_g + c + 4);
    *(float4*)(y + (size_t)row * 1024 + c) = make_float4(bflo(v.x) * r * g0.x, bfhi(v.x) * r * g0.y, bflo(v.y) * r * g0.z, bfhi(v.y) * r * g0.w);
    *(float4*)(y + (size_t)row * 1024 + c + 4) = make_float4(bflo(v.z) * r * g1.x, bfhi(v.z) * r * g1.y, bflo(v.w) * r * g1.z, bfhi(v.w) * r * g1.w);
  }
}

__device__ __forceinline__ void phase2(const Params& p, int bid, int nb, char* smem) {
#pragma unroll 1
  for (int it = bid; it < 1024; it += nb) delta_prep<false>(p, it, smem);
}
__device__ __forceinline__ void phase3(const Params& p, int bid, int nb, char* smem) {
  if (nb >= 128) {
    if (bid < 64) { delta_seq_p(p, bid, smem); return; }
    bid -= 64; nb -= 64;
  } else {
    for (int it = bid; it < 64; it += nb) delta_seq_p(p, it, smem);
  }
#pragma unroll 1
  for (int it = bid; it < 512; it += nb) conv_tile<false>(p, it, smem);
#pragma unroll 1
  for (int it = nb - 1 - bid; it < 128; it += nb) conv_tile<true>(p, it, smem);
#pragma unroll 1
  for (int it = bid; it < 512; it += nb) {
    delta_prep<true>(p, it, smem);
    __threadfence_block();
    __syncthreads();
#pragma unroll 1
    for (int hf = 0; hf < 2; ++hf) delta_seq<true>(p, 2 * it + hf, smem);
  }
}

#define XB_TMO      128
#define XB_XCNT(j)  (256  + 64 * (j))
#define XB_XSUB(j)  (1280 + 64 * (j))
#define XB_XGEN(j)  (2304 + 64 * (j))
#define XB_TOP      3328
#define XB_TOPGEN   3392
#define XCD_BAR_WORDS 3456
#define XB_SPIN_CAP (1u << 22)
__device__ __forceinline__ unsigned xb_ld(unsigned* p) { return __hip_atomic_load(p, __ATOMIC_RELAXED, __HIP_MEMORY_SCOPE_AGENT); }
__device__ __forceinline__ unsigned xb_add(unsigned* p, unsigned v) { return __hip_atomic_fetch_add(p, v, __ATOMIC_RELAXED, __HIP_MEMORY_SCOPE_AGENT); }
__device__ __forceinline__ unsigned xb_xcc_id() { return (unsigned)__builtin_amdgcn_s_getreg((3 << 11) | 20) & 0xFu; }
#define XB_SPIN(cond, bar) do { unsigned _sp = 0; while (cond) { __builtin_amdgcn_s_sleep(1); \
    if ((++_sp & 255u) == 0u) { if (xb_ld(&(bar)[XB_TMO])) break; if (_sp > XB_SPIN_CAP) { atomicAdd(&(bar)[XB_TMO], 1u); break; } } } } while (0)
struct XcdBarrier { unsigned* bar; unsigned x; unsigned nloc; unsigned nx; };
__device__ __forceinline__ void xcd_barrier_complete(unsigned* bar, unsigned x, unsigned& nloc, unsigned& nx) {
  const unsigned G = gridDim.x;
  unsigned sum, cnt, mine, sp = 0u;
  for (;;) {
    sum = 0u; cnt = 0u; mine = 0u;
#pragma unroll
    for (unsigned j = 0; j < 16; ++j) { const unsigned c = xb_ld(&bar[XB_XCNT(j)]); sum += c; cnt += (c > 0u) ? 1u : 0u; mine = (j == x) ? c : mine; }
    if (sum == G) break;
    __builtin_amdgcn_s_sleep(1);
    if ((++sp & 255u) == 0u) { if (xb_ld(&bar[XB_TMO])) break; if (sp > XB_SPIN_CAP) { atomicAdd(&bar[XB_TMO], 1u); break; } }
  }
  nloc = mine > 0u ? mine : 1u; nx = cnt > 0u ? cnt : 1u;
}
__device__ __forceinline__ void xcd_barrier(XcdBarrier& b) {
  asm volatile("s_waitcnt vmcnt(0)" ::: "memory");
  __syncthreads();
  if (threadIdx.x == 0) {
    unsigned* bar = b.bar;
    __builtin_amdgcn_s_waitcnt(0);
    if (b.nloc == 0u) xcd_barrier_complete(bar, b.x, b.nloc, b.nx);
    const unsigned nloc = b.nloc, nx = b.nx;
    const unsigned old = xb_add(&bar[XB_XSUB(b.x)], 1u);
    const unsigned gen = old / nloc;
    if (old + 1u == (gen + 1u) * nloc) {
      __builtin_amdgcn_fence(__ATOMIC_RELEASE, "agent");
      asm volatile("s_waitcnt vmcnt(0)" ::: "memory");
      const unsigned og = xb_add(&bar[XB_TOP], 1u);
      const unsigned tg = og / nx;
      if (og + 1u == (tg + 1u) * nx) xb_add(&bar[XB_TOPGEN], 1u);
      else XB_SPIN(xb_ld(&bar[XB_TOPGEN]) == tg, bar);
      __builtin_amdgcn_fence(__ATOMIC_ACQUIRE, "agent");
      xb_add(&bar[XB_XGEN(b.x)], 1u);
      asm volatile("s_waitcnt vmcnt(0)" ::: "memory");
    } else {
      XB_SPIN(xb_ld(&bar[XB_XGEN(b.x)]) == gen, bar);
      __builtin_amdgcn_fence(__ATOMIC_ACQUIRE, "agent");
      asm volatile("s_waitcnt vmcnt(0)" ::: "memory");
    }
  }
  __syncthreads();
}

template <int MODE>
__global__ void __launch_bounds__(256, 2) mega(Params p) {
  __shared__ __attribute__((aligned(16))) char smem[65536];
  const int bid = blockIdx.x, nb = gridDim.x;
  if (MODE < 0) {
    XcdBarrier gb;
    gb.bar = (unsigned*)(p.ws + WS_BAR); gb.x = xb_xcc_id(); gb.nloc = 0u; gb.nx = 0u;
    if (threadIdx.x == 0) (void)xb_add(&gb.bar[XB_XCNT(gb.x)], 1u);
    phase0(p, bid, nb, smem); xcd_barrier(gb);
    if (PROBE_DUP == 0) { phase0(p, bid, nb, smem); xcd_barrier(gb); }
    phase1(p, bid, nb, smem); xcd_barrier(gb);
    if (PROBE_DUP == 1) { phase1(p, bid, nb, smem); xcd_barrier(gb); }
    phase2(p, bid, nb, smem); xcd_barrier(gb);
    if (PROBE_DUP == 2) { phase2(p, bid, nb, smem); xcd_barrier(gb); }
    phase3(p, bid, nb, smem); xcd_barrier(gb);
    if (PROBE_DUP == 3) { phase3(p, bid, nb, smem); xcd_barrier(gb); }
    phase4(p, bid, nb, smem); xcd_barrier(gb);
    if (PROBE_DUP == 4) { phase4(p, bid, nb, smem); xcd_barrier(gb); }
    if (PROBE_DUP == 11) { phase5(p, bid, nb, smem, false); xcd_barrier(gb); }
    phase5(p, bid, nb, smem); xcd_barrier(gb);
    phase6(p, bid, nb, smem); xcd_barrier(gb);
    phase7(p, bid, nb);
  } else {
    if (MODE == 0) phase0(p, bid, nb, smem);
    if (MODE == 1) phase1(p, bid, nb, smem);
    if (MODE == 2) phase2(p, bid, nb, smem);
    if (MODE == 3) phase3(p, bid, nb, smem);
    if (MODE == 4) phase4(p, bid, nb, smem);
    if (MODE == 5) phase5(p, bid, nb, smem);
    if (MODE == 6) phase6(p, bid, nb, smem);
    if (MODE == 7) phase7(p, bid, nb);
  }
}

extern "C" void kernel_launch(void* const* d_in, const int* in_sizes, int n_in, void* d_out, int out_size, void* d_ws,
                              size_t ws_size, hipStream_t stream) {
  if (ws_size < WS_END) { fprintf(stderr, "workspace too small: %zu < %zu\n", ws_size, (size_t)WS_END); return; }
  static int grid = 0;
  if (grid == 0) {
    int dev = 0, cus = 0, per_cu = 0;
    hipGetDevice(&dev);
    hipDeviceGetAttribute(&cus, hipDeviceAttributeMultiprocessorCount, dev);
    hipOccupancyMaxActiveBlocksPerMultiprocessor(&per_cu, (const void*)mega<-1>, 256, 0);
    if (per_cu > 2) per_cu = 2;
    if (per_cu < 1 || cus < 1) { fprintf(stderr, "occupancy query failed (%d, %d)\n", cus, per_cu); grid = -1; return; }
    grid = cus * per_cu;
  }
  if (grid < 0) return;
  Params p{};
  const float** f = (const float**)&p;
  for (int i = 0; i < 23; ++i) f[i] = (const float*)d_in[i];
  p.out = (float*)d_out;
  p.ws = (char*)d_ws;
  hipMemsetAsync((char*)d_ws + WS_BAR, 0, XCD_BAR_WORDS * 4, stream);
  void* args[] = {&p};
  hipError_t e = hipLaunchCooperativeKernel((const void*)mega<-1>, dim3(grid), dim3(256), args, 0, stream);
  if (e != hipSuccess) fprintf(stderr, "cooperative launch failed: %s (grid %d)\n", hipGetErrorString(e), grid);
}
```

```cpp
#include <hip/hip_runtime.h>
#include <hip/hip_bf16.h>
#include <cstdio>
#include <cstdint>

typedef __attribute__((ext_vector_type(8))) short bf16x8;
typedef __attribute__((ext_vector_type(4))) float f32x4;
typedef unsigned short u16;
#ifndef PROBE_DUP
#define PROBE_DUP -1
#endif

constexpr int DM = 1024, NP = 16384, NS = 1024, NT = 17408, SEQ = 2048;
constexpr int DIN = 3592, DPJ = 3584;
constexpr int C_GLUA = 0, C_GLUB = 512, C_GATE = 1024, C_QKV = 1536, C_Z = 3072;
constexpr float EPS = 1e-6f;

constexpr int NF_P = 52, NF_S = 17;
constexpr size_t FRAG_P_BYTES = (size_t)NF_P * 1024, FRAG_S_BYTES = (size_t)NF_S * 1024;
constexpr size_t UF_P_BYTES = 32 * 1024, UF_S_BYTES = 8 * 1024;

constexpr size_t al256(size_t x) { return (x + 255) & ~(size_t)255; }
constexpr size_t WS_X = 0;
constexpr size_t WS_PROJ = WS_X + (size_t)NT * 1024 * 2;
constexpr size_t WS_FRAG = WS_PROJ + (size_t)NT * DPJ * 2;
constexpr size_t FRAG_TOTAL = 1024 * FRAG_P_BYTES + 512 * FRAG_S_BYTES;
constexpr size_t WS_OMIX = WS_FRAG;
constexpr size_t WS_X2B = WS_PROJ;
constexpr size_t WS_PL = WS_FRAG + (size_t)NT * 512 * 2;
constexpr size_t WS_CMIX = WS_FRAG + al256(FRAG_TOTAL);
constexpr size_t WS_WIN = WS_CMIX + (size_t)NT * 512 * 2;
constexpr size_t WS_PW = WS_WIN + (size_t)DPJ * 1024 * 2;
constexpr size_t WS_WOUT = WS_PW + 512 * 512 * 2;
constexpr size_t WS_GATE = WS_WOUT + 1024 * 1024 * 2;
constexpr size_t WS_PPROJ = WS_GATE + 1024 * 1024 * 2;
constexpr size_t WS_R1 = WS_PPROJ + 1024 * 256 * 2;
constexpr size_t WS_AB = WS_R1 + al256((size_t)NT * 4);
constexpr size_t WS_SS2 = WS_AB + (size_t)NT * 8 * 4;
constexpr size_t WS_SS3 = WS_SS2 + al256((size_t)NT * 4);
constexpr size_t WS_GLAST = WS_SS3 + al256((size_t)NT * 4);
constexpr size_t WS_BAR = WS_GLAST + al256(2560 * 4);
constexpr size_t WS_PB2 = WS_BAR + al256(3456 * 4);
constexpr size_t WS_END = WS_PB2 + (size_t)NT * 256 * 2;
constexpr size_t YS_UF = 0;
constexpr size_t YS_CACT = 1024 * UF_P_BYTES + 512 * UF_S_BYTES;
static_assert(YS_CACT + (size_t)NT * 512 * 2 <= (size_t)NT * 1024 * 4, "y scratch overflow");
static_assert(WS_PL + (size_t)NT * 1024 * 2 <= WS_CMIX, "frag alias overflow");

constexpr size_t O_Y = 0;
constexpr size_t O_NCP = (size_t)NT * 1024;
constexpr size_t O_NDP = O_NCP + 8 * 30 * 512;
constexpr size_t O_NSP = O_NDP + 8 * 3 * 1536;
constexpr size_t O_NCS = O_NSP + (size_t)8 * 4 * 128 * 128;
constexpr size_t O_NDS = O_NCS + (size_t)128 * 30 * 512;
constexpr size_t O_NSS = O_NDS + (size_t)128 * 3 * 1536;

struct Params {
  const float *x_prompt, *x_sample, *state_conv, *state_dn_conv, *state_dn_S, *p_prompt, *p_sample;
  const float *norm_mix_g, *w_in, *conv_dw_w, *conv_dw_b, *conv_ln_g, *conv_ln_b, *conv_pw_w;
  const float *dn_conv_w, *dn_a_log, *dn_dt_bias, *dn_norm_g, *w_out, *ple_norm_g, *ple_gate_w, *ple_proj_w, *final_norm_g;
  float* out;
  char* ws;
};

typedef float f32x2_t __attribute__((ext_vector_type(2)));
typedef __bf16 bf16x2_t __attribute__((ext_vector_type(2)));
__device__ __forceinline__ uint32_t pack2(float a, float b) {
  f32x2_t v = {a, b};
  bf16x2_t r = __builtin_convertvector(v, bf16x2_t);
  return __builtin_bit_cast(uint32_t, r);
}
__device__ __forceinline__ u16 f2bf(float f) { return (u16)(pack2(f, f) & 0xffffu); }
__device__ __forceinline__ float bf2f(u16 h) { return __uint_as_float(((uint32_t)h) << 16); }
__device__ __forceinline__ float bflo(uint32_t u) { return __uint_as_float(u << 16); }
__device__ __forceinline__ float bfhi(uint32_t u) { return __uint_as_float(u & 0xffff0000u); }
__device__ __forceinline__ float sigmoidf_(float x) { return __builtin_amdgcn_rcpf(1.f + __expf(-x)); }
__device__ __forceinline__ float siluf_(float x) { return x * __builtin_amdgcn_rcpf(1.f + __expf(-x)); }
__device__ __forceinline__ const float* xrow(const Params& p, int row) {
  return row < NP ? p.x_prompt + (size_t)row * DM : p.x_sample + (size_t)(row - NP) * DM;
}
__device__ __forceinline__ float wave_sum(float v) {
#pragma unroll
  for (int o = 32; o >= 1; o >>= 1) v += __shfl_xor(v, o);
  return v;
}
__device__ __forceinline__ bf16x8 mk8(uint32_t a, uint32_t b, uint32_t c, uint32_t d) {
  union { uint32_t u[4]; bf16x8 v; } t;
  t.u[0] = a; t.u[1] = b; t.u[2] = c; t.u[3] = d;
  return t.v;
}
__device__ __forceinline__ bf16x8 u4_to_b8(uint4 q) { return mk8(q.x, q.y, q.z, q.w); }
#define MFMA(a, b, c) __builtin_amdgcn_mfma_f32_16x16x32_bf16((a), (b), (c), 0, 0, 0)

template <bool DEEP = false, int MH = 4>
__device__ __forceinline__ void gemm128(const u16* __restrict__ A, int lda, const u16* __restrict__ B, int ldb,
                                        int K, char* smem, f32x4 (&acc)[4][4]) {
  const int tid = threadIdx.x, lane = tid & 63, wave = tid >> 6;
  const int wm = wave >> 1, wn = wave & 1, m = lane & 15, g = lane >> 4;
  const int nkt = K >> 6;
  uint4 ra0, ra1, ra2, ra3, rb0, rb1, rb2, rb3;
  uint4 rc0, rc1, rc2, rc3, rd0, rd1, rd2, rd3;
  const int lrow = tid >> 3, lch = tid & 7;
  const u16* gA = A + (size_t)lrow * lda + lch * 8;
  const u16* gB = B + (size_t)lrow * ldb + lch * 8;
  const int soff = lrow * 128 + ((lch ^ (lrow & 7)) << 4);
#define GLOAD(...) GLOAD_I(__VA_ARGS__)
#define SSTORE(...) SSTORE_I(__VA_ARGS__)
#define GLOAD_I(a0_, a1_, a2_, a3_, b0_, b1_, b2_, b3_, kt_)             \
  {                                                                     \
    a0_ = *(const uint4*)(gA + (kt_) * 64);                             \
    a1_ = *(const uint4*)(gA + (size_t)32 * lda + (kt_) * 64);          \
    if (MH == 4) {                                                      \
      a2_ = *(const uint4*)(gA + (size_t)64 * lda + (kt_) * 64);        \
      a3_ = *(const uint4*)(gA + (size_t)96 * lda + (kt_) * 64);        \
    }                                                                   \
    b0_ = *(const uint4*)(gB + (kt_) * 64);                             \
    b1_ = *(const uint4*)(gB + (size_t)32 * ldb + (kt_) * 64);          \
    b2_ = *(const uint4*)(gB + (size_t)64 * ldb + (kt_) * 64);          \
    b3_ = *(const uint4*)(gB + (size_t)96 * ldb + (kt_) * 64);          \
  }
#define SSTORE_I(a0_, a1_, a2_, a3_, b0_, b1_, b2_, b3_, buf_)           \
  {                                                                     \
    char* sa_ = smem + (buf_) * 32768 + soff;                           \
    *(uint4*)(sa_) = a0_;                                               \
    *(uint4*)(sa_ + 4096) = a1_;                                        \
    if (MH == 4) {                                                      \
      *(uint4*)(sa_ + 8192) = a2_;                                      \
      *(uint4*)(sa_ + 12288) = a3_;                                     \
    }                                                                   \
    *(uint4*)(sa_ + 16384) = b0_;                                       \
    *(uint4*)(sa_ + 16384 + 4096) = b1_;                                \
    *(uint4*)(sa_ + 16384 + 8192) = b2_;                                \
    *(uint4*)(sa_ + 16384 + 12288) = b3_;                               \
  }
#define GEMM_COMPUTE(buf_)                                                                   \
  {                                                                                          \
    const char* sa = smem + (buf_) * 32768;                                                  \
    const char* sb = sa + 16384;                                                             \
    _Pragma("unroll") for (int ks = 0; ks < 2; ++ks) {                                       \
      bf16x8 af[4], bfr[4];                                                                  \
      _Pragma("unroll") for (int t = 0; t < 4; ++t) {                                        \
        if (t < MH) {                                                                        \
          int ra_ = wm * (16 * MH) + t * 16 + m;                                             \
          af[t] = *(const bf16x8*)(sa + ra_ * 128 + (((ks * 4 + g) ^ (ra_ & 7)) << 4));      \
        }                                                                                    \
        int rb_ = wn * 64 + t * 16 + m;                                                      \
        bfr[t] = *(const bf16x8*)(sb + rb_ * 128 + (((ks * 4 + g) ^ (rb_ & 7)) << 4));       \
      }                                                                                      \
      _Pragma("unroll") for (int mt = 0; mt < MH; ++mt)                                      \
        _Pragma("unroll") for (int nt = 0; nt < 4; ++nt) acc[mt][nt] = MFMA(bfr[nt], af[mt], acc[mt][nt]); \
    }                                                                                        \
  }
#define SETX ra0, ra1, ra2, ra3, rb0, rb1, rb2, rb3
#define SETY rc0, rc1, rc2, rc3, rd0, rd1, rd2, rd3
  __syncthreads();
  if (DEEP) {
    GLOAD(SETX, 0)
    GLOAD(SETY, 1)
    SSTORE(SETX, 0)
    __syncthreads();
#pragma unroll 1
    for (int kt = 0; kt < nkt; kt += 2) {
      if (kt + 2 < nkt) GLOAD(SETX, kt + 2)
      GEMM_COMPUTE(0)
      SSTORE(SETY, 1)
      __syncthreads();
      if (kt + 3 < nkt) GLOAD(SETY, kt + 3)
      GEMM_COMPUTE(1)
      if (kt + 2 < nkt) SSTORE(SETX, 0)
      __syncthreads();
    }
  } else {
    GLOAD(SETX, 0)
    SSTORE(SETX, 0)
    __syncthreads();
#pragma unroll 1
    for (int kt = 0; kt < nkt; ++kt) {
      if (kt + 1 < nkt) GLOAD(SETX, kt + 1)
      GEMM_COMPUTE(kt & 1)
      if (kt + 1 < nkt) SSTORE(SETX, (kt + 1) & 1)
      __syncthreads();
    }
  }
}
#define GEMM_EPILOGUE_M(acc, m0, n0, MH_, ...)                                             \
  {                                                                                        \
    const int lane_ = threadIdx.x & 63, wave_ = threadIdx.x >> 6;                          \
    const int wm_ = wave_ >> 1, wn_ = wave_ & 1, m_ = lane_ & 15, g_ = lane_ >> 4;         \
    _Pragma("unroll") for (int mt = 0; mt < (MH_); ++mt) {                                 \
      const int row = (m0) + wm_ * (16 * (MH_)) + mt * 16 + m_;                            \
      _Pragma("unroll") for (int nt = 0; nt < 4; ++nt) {                                   \
        const int col = (n0) + wn_ * 64 + (nt >> 1) * 32 + g_ * 8 + (nt & 1) * 4;     \
        f32x4 v = acc[mt][nt];                                                             \
        __VA_ARGS__                                                                        \
      }                                                                                    \
    }                                                                                      \
  }
#define GEMM_EPILOGUE(acc, m0, n0, ...) GEMM_EPILOGUE_M(acc, m0, n0, 4, __VA_ARGS__)

__device__ __forceinline__ void transpose_tile(const float* __restrict__ src, int lds_, const float* __restrict__ gv, u16* __restrict__ dst,
                               int ldd, int k0, int n0, char* smem, bool perm = false) {
  float* t = (float*)smem;
  const int tid = threadIdx.x;
  __syncthreads();
#pragma unroll
  for (int it = 0; it < 4; ++it) {
    int k = (tid >> 4) + it * 16, n = (tid & 15) * 4;
    float4 v = *(const float4*)(src + (size_t)(k0 + k) * lds_ + n0 + n);
    float gg = gv ? gv[k0 + k] : 1.f;
    t[k * 65 + n + 0] = v.x * gg; t[k * 65 + n + 1] = v.y * gg; t[k * 65 + n + 2] = v.z * gg; t[k * 65 + n + 3] = v.w * gg;
  }
  __syncthreads();
#pragma unroll
  for (int it = 0; it < 2; ++it) {
    int n = (tid >> 3) + it * 32, kc = (tid & 7) * 8;
    uint32_t w[4];
#pragma unroll
    for (int e = 0; e < 4; ++e) w[e] = pack2(t[(kc + 2 * e) * 65 + n], t[(kc + 2 * e + 1) * 65 + n]);
    const int j = n & 31;
    const int nd = perm ? ((n & ~31) + 16 * ((j >> 2) & 1) + 4 * (j >> 3) + (j & 3)) : n;
    *(uint4*)(dst + (size_t)(n0 + nd) * ldd + k0 + kc) = make_uint4(w[0], w[1], w[2], w[3]);
  }
}

__device__ __forceinline__ void phase0(const Params& p, int bid, int nb, char* smem) {
  const int tid = threadIdx.x, lane = tid & 63, wave = tid >> 6;
  u16* xb = (u16*)(p.ws + WS_X);
  float* r1 = (float*)(p.ws + WS_R1);
  float* ab = (float*)(p.ws + WS_AB);
  float* ss2 = (float*)(p.ws + WS_SS2);
  float* ss3 = (float*)(p.ws + WS_SS3);
  for (int i = bid * 256 + tid; i < NT; i += nb * 256) { ss2[i] = 0.f; ss3[i] = 0.f; }
  {
    u16* pb = (u16*)(p.ws + WS_PB2);
  for (int i = bid * 256 + tid; i < NT * 32; i += nb * 256) {
    int row = i >> 5, c = (i & 31) * 8;
    const float* pr = row < NP ? p.p_prompt + (size_t)row * 256 : p.p_sample + (size_t)(row - NP) * 256;
    float4 a = *(const float4*)(pr + c), bq = *(const float4*)(pr + c + 4);
    *(uint4*)(pb + (size_t)row * 256 + c) = make_uint4(pack2(a.x, a.y), pack2(a.z, a.w), pack2(bq.x, bq.y), pack2(bq.z, bq.w));
  }
  }
  for (int it = bid; it < 1536; it += nb) {
    if (it < 896) { int kt = it / 56, nt = it % 56; transpose_tile(p.w_in, DIN, p.norm_mix_g, (u16*)(p.ws + WS_WIN), 1024, kt * 64, nt * 64, smem, true); }
    else if (it < 960) { int j = it - 896; transpose_tile(p.conv_pw_w, 512, nullptr, (u16*)(p.ws + WS_PW), 512, (j >> 3) * 64, (j & 7) * 64, smem, true); }
    else if (it < 1216) { int j = it - 960; transpose_tile(p.w_out, 1024, nullptr, (u16*)(p.ws + WS_WOUT), 1024, (j >> 4) * 64, (j & 15) * 64, smem, true); }
    else if (it < 1472) { int j = it - 1216; transpose_tile(p.ple_gate_w, 1024, p.ple_norm_g, (u16*)(p.ws + WS_GATE), 1024, (j >> 4) * 64, (j & 15) * 64, smem, true); }
    else { int j = it - 1472; transpose_tile(p.ple_proj_w, 1024, nullptr, (u16*)(p.ws + WS_PPROJ), 256, (j >> 4) * 64, (j & 15) * 64, smem, true); }
  }
  float* tl = (float*)smem;
  __syncthreads();
#pragma unroll
  for (int it = 0; it < 4; ++it) {
    int k = tid + it * 256;
    const float4* wt = (const float4*)(p.w_in + (size_t)k * DIN + DPJ);
    float4 w0 = wt[0], w1 = wt[1];
    float gg = p.norm_mix_g[k];
    tl[0 * 1024 + k] = w0.x * gg; tl[1 * 1024 + k] = w0.y * gg; tl[2 * 1024 + k] = w0.z * gg; tl[3 * 1024 + k] = w0.w * gg;
    tl[4 * 1024 + k] = w1.x * gg; tl[5 * 1024 + k] = w1.y * gg; tl[6 * 1024 + k] = w1.z * gg; tl[7 * 1024 + k] = w1.w * gg;
  }
  __syncthreads();
  for (int row = bid * 4 + wave; row < NT; row += nb * 4) {
    const float* xr = xrow(p, row);
    float ss = 0.f;
    float d[8] = {0, 0, 0, 0, 0, 0, 0, 0};
#pragma unroll
    for (int it = 0; it < 4; ++it) {
      int k = it * 256 + lane * 4;
      float4 v = *(const float4*)(xr + k);
      ss += v.x * v.x + v.y * v.y + v.z * v.z + v.w * v.w;
      *(uint2*)(xb + (size_t)row * 1024 + k) = make_uint2(pack2(v.x, v.y), pack2(v.z, v.w));
#pragma unroll
      for (int j = 0; j < 8; ++j) {
        float4 w = *(const float4*)(tl + j * 1024 + k);
        d[j] += v.x * w.x + v.y * w.y + v.z * w.z + v.w * w.w;
      }
    }
    ss = wave_sum(ss);
#pragma unroll
    for (int j = 0; j < 8; ++j) d[j] = wave_sum(d[j]);
    float r = rsqrtf(ss * (1.f / 1024.f) + EPS);
    if (lane == 0) {
      r1[row] = r;
      *(float4*)(ab + (size_t)row * 8) = make_float4(d[0] * r, d[1] * r, d[2] * r, d[3] * r);
      *(float4*)(ab + (size_t)row * 8 + 4) = make_float4(d[4] * r, d[5] * r, d[6] * r, d[7] * r);
    }
  }
}

struct TileWalk { int q, step, total, mbase, nN; bool banded; };
__device__ __forceinline__ TileWalk tile_walk(int nN, int bid, int nb) {
  TileWalk w; w.nN = nN;
  if ((nb & 7) == 0) { w.banded = true; w.q = bid >> 3; w.step = nb >> 3; w.total = 17 * nN; w.mbase = 17 * (bid & 7); }
  else { w.banded = false; w.q = bid; w.step = nb; w.total = 136 * nN; w.mbase = 0; }
  return w;
}
__device__ __forceinline__ void tile_get(const TileWalk& w, int q, int& mt, int& nt) {
  if (w.banded) {
    if (q < 9 * w.nN) { mt = w.mbase + q % 9; nt = q / 9; }
    else { int q2 = q - 9 * w.nN; mt = w.mbase + 9 + (q2 & 7); nt = q2 >> 3; }
  } else { mt = q / w.nN; nt = q % w.nN; }
}
__device__ __forceinline__ void phase1(const Params& p, int bid, int nb, char* smem) {
  const u16* xb = (const u16*)(p.ws + WS_X);
  const u16* wt = (const u16*)(p.ws + WS_WIN);
  const float* r1 = (const float*)(p.ws + WS_R1);
  u16* proj = (u16*)(p.ws + WS_PROJ);
  const TileWalk tw = tile_walk(28, bid, nb);
  for (int t = tw.q; t < tw.total; t += tw.step) {
    int mt_, nt_;
    tile_get(tw, t, mt_, nt_);
    int m0 = mt_ * 128, n0 = nt_ * 128;
    f32x4 acc[4][4];
#pragma unroll
    for (int i = 0; i < 4; ++i)
#pragma unroll
      for (int j = 0; j < 4; ++j) acc[i][j] = f32x4{0, 0, 0, 0};
    gemm128(xb + (size_t)m0 * 1024, 1024, wt + (size_t)n0 * 1024, 1024, 1024, smem, acc);
    {
      const int lane_ = threadIdx.x & 63, wave_ = threadIdx.x >> 6;
      const int wm_ = wave_ >> 1, wn_ = wave_ & 1, m_ = lane_ & 15, g_ = lane_ >> 4;
#pragma unroll
      for (int mt = 0; mt < 4; ++mt) {
        const int row = m0 + wm_ * 64 + mt * 16 + m_;
        const float r = r1[row];
#pragma unroll
        for (int k2 = 0; k2 < 2; ++k2) {
          const int col = n0 + wn_ * 64 + 32 * k2 + 8 * g_;
          const f32x4 lo = acc[mt][2 * k2], hi = acc[mt][2 * k2 + 1];
          *(uint4*)(proj + (size_t)row * DPJ + col) =
              make_uint4(pack2(lo[0] * r, lo[1] * r), pack2(lo[2] * r, lo[3] * r), pack2(hi[0] * r, hi[1] * r), pack2(hi[2] * r, hi[3] * r));
        }
      }
    }
  }
}

template <bool SAMPLE>
__device__ __forceinline__ void conv_tile(const Params& p, int item, char* smem) {
  constexpr int NTK = SAMPLE ? 8 : 32;
  const int tid = threadIdx.x, lane = tid & 63, wave = tid >> 6;
  const u16* proj = (const u16*)(p.ws + WS_PROJ);
  u16* cact = (u16*)((char*)p.out + YS_CACT);
  int b, pos0, row0;
  if (SAMPLE) { b = item; pos0 = 0; row0 = NP + b * 8; }
  else { b = item >> 6; pos0 = (item & 63) * 32; row0 = b * SEQ + pos0; }
  float* Y = (float*)smem;
  const float* cw_ = p.conv_dw_w;
  const float* lng_ = p.conv_ln_g;
  const float* lnb_ = p.conv_ln_b;
  const float* cb_ = p.conv_dw_b;
  asm volatile("" : "+s"(cw_), "+s"(lng_), "+s"(lnb_), "+s"(cb_));
  const bool write_tail = SAMPLE || ((item & 63) == 63);
  constexpr int NR = NTK + 30, GR = 16, NG = (NR + GR - 1) / GR;
  __syncthreads();
#pragma unroll 1
  for (int cp = 0; cp < 2; ++cp) {
    const int c0 = tid + cp * 256;
    float w0[31];
#pragma unroll
    for (int j = 0; j < 31; ++j) w0[j] = cw_[j * 512 + c0];
    float a0[NTK];
#pragma unroll
    for (int t = 0; t < NTK; ++t) a0[t] = 0.f;
    uint32_t ca[GR], cb[GR], na[GR], nb2[GR];
#define CONV_LOAD(r_, A_, B_)                                                                   \
  {                                                                                             \
    A_ = 0; B_ = 0;                                                                             \
    if ((r_) < NR) {                                                                            \
      if (SAMPLE && (r_) < 30) {                                                                \
        A_ = __float_as_uint(p.state_conv[((size_t)b * 30 + (r_)) * 512 + c0]);                 \
      } else {                                                                                  \
        int pos_ = pos0 - 30 + (r_);                                                            \
        int pc_ = pos_ < 0 ? 0 : pos_;                                                          \
        size_t prow_ = SAMPLE ? (size_t)(row0 + (r_) - 30) : (size_t)(b * SEQ + pc_);           \
        uint32_t la_ = proj[prow_ * DPJ + C_GLUA + c0];                                         \
        uint32_t lb_ = proj[prow_ * DPJ + C_GLUB + c0];                                         \
        A_ = (!SAMPLE && pos_ < 0) ? 0u : la_;                                                  \
        B_ = (!SAMPLE && pos_ < 0) ? 0u : lb_;                                                  \
      }                                                                                         \
    }                                                                                           \
  }
#pragma unroll
    for (int rr = 0; rr < GR; ++rr) CONV_LOAD(rr, ca[rr], cb[rr])
#pragma unroll
    for (int gq = 0; gq < NG; ++gq) {
      if (gq + 1 < NG) {
#pragma unroll
        for (int rr = 0; rr < GR; ++rr) CONV_LOAD((gq + 1) * GR + rr, na[rr], nb2[rr])
      }
#pragma unroll
      for (int rr = 0; rr < GR; ++rr) {
        const int r = gq * GR + rr;
        if (r < NR) {
          float u0;
          if (SAMPLE && r < 30) u0 = __uint_as_float(ca[rr]);
          else u0 = bf2f((u16)ca[rr]) * sigmoidf_(bf2f((u16)cb[rr]));
          if (SAMPLE) {
            if (r >= 8) p.out[O_NCS + ((size_t)b * 30 + (r - 8)) * 512 + c0] = u0;
          } else {
            if (write_tail && r >= 32) p.out[O_NCP + ((size_t)b * 30 + (r - 32)) * 512 + c0] = u0;
          }
#pragma unroll
          for (int t = 0; t < NTK; ++t) {
            if (r - t >= 0 && r - t <= 30) a0[t] += w0[r - t] * u0;
          }
        }
      }
#pragma unroll
      for (int rr = 0; rr < GR; ++rr) { ca[rr] = na[rr]; cb[rr] = nb2[rr]; }
      __builtin_amdgcn_sched_barrier(0);
    }
    const float bias = cb_[c0];
#pragma unroll
    for (int t = 0; t < NTK; ++t) Y[t * 512 + c0] = a0[t] + bias;
  }
  __syncthreads();
  for (int t = wave; t < NTK; t += 4) {
    float4 v0 = *(const float4*)(Y + t * 512 + lane * 8);
    float4 v1 = *(const float4*)(Y + t * 512 + lane * 8 + 4);
    float xv[8] = {v0.x, v0.y, v0.z, v0.w, v1.x, v1.y, v1.z, v1.w};
    float s = 0.f;
#pragma unroll
    for (int e = 0; e < 8; ++e) s += xv[e];
    float mean = wave_sum(s) * (1.f / 512.f);
    float q = 0.f;
#pragma unroll
    for (int e = 0; e < 8; ++e) { xv[e] -= mean; q += xv[e] * xv[e]; }
    float rstd = rsqrtf(wave_sum(q) * (1.f / 512.f) + EPS);
    float4 g0 = *(const float4*)(lng_ + lane * 8), g1 = *(const float4*)(lng_ + lane * 8 + 4);
    float4 b0 = *(const float4*)(lnb_ + lane * 8), b1 = *(const float4*)(lnb_ + lane * 8 + 4);
    float gg[8] = {g0.x, g0.y, g0.z, g0.w, g1.x, g1.y, g1.z, g1.w};
    float bb[8] = {b0.x, b0.y, b0.z, b0.w, b1.x, b1.y, b1.z, b1.w};
    float o[8];
#pragma unroll
    for (int e = 0; e < 8; ++e) o[e] = siluf_(xv[e] * rstd * gg[e] + bb[e]);
    *(uint4*)(cact + (size_t)(row0 + t) * 512 + lane * 8) =
        make_uint4(pack2(o[0], o[1]), pack2(o[2], o[3]), pack2(o[4], o[5]), pack2(o[6], o[7]));
  }
}

template <bool SAMPLE> __device__ __forceinline__ constexpr int fidx_w(int mt, int ks) { return SAMPLE ? ks : (mt >> 1) * 26 + (mt & 1) * 4 + ks; }
template <bool SAMPLE> __device__ __forceinline__ constexpr int fidx_q(int mt, int ks) { return SAMPLE ? 4 + ks : (mt >> 1) * 26 + 8 + (mt & 1) * 4 + ks; }
template <bool SAMPLE> __device__ __forceinline__ constexpr int fidx_qk(int mt) { return SAMPLE ? 8 : (mt >> 1) * 26 + 16 + (mt & 1); }
template <bool SAMPLE> __device__ __forceinline__ constexpr int fidx_kd(int dt, int hf) { return SAMPLE ? 9 + dt : hf * 26 + 18 + dt; }

template <bool SAMPLE>
__device__ __forceinline__ void delta_prep(const Params& p, int item, char* smem) {
  constexpr int MT = SAMPLE ? 1 : 4, KS2 = SAMPLE ? 1 : 2, NI = SAMPLE ? 8 : 64;
  const int tid = threadIdx.x, lane = tid & 63, wave = tid >> 6, m = lane & 15, g = lane >> 4;
  const u16* proj = (const u16*)(p.ws + WS_PROJ);
  const float* ab = (const float*)(p.ws + WS_AB);
  int b, h, row0, pos0, chunk;
  uint4* fa; float4* uf;
  if (SAMPLE) {
    b = item >> 2; h = item & 3; row0 = NP + b * 8; pos0 = 0; chunk = 1024 + item;
    fa = (uint4*)(p.ws + WS_FRAG + 1024 * FRAG_P_BYTES + (size_t)item * FRAG_S_BYTES);
    uf = (float4*)((char*)p.out + YS_UF + 1024 * UF_P_BYTES + (size_t)item * UF_S_BYTES);
  } else {
    int bh = item >> 5, n = item & 31; b = bh >> 2; h = bh & 3; pos0 = n * 64; row0 = b * SEQ + pos0; chunk = item;
    fa = (uint4*)(p.ws + WS_FRAG + (size_t)item * FRAG_P_BYTES);
    uf = (float4*)((char*)p.out + YS_UF + (size_t)item * UF_P_BYTES);
  }
  u16* KN = (u16*)smem;
  u16* QN = KN + 64 * 136;
  float* AM = (float*)(QN + 64 * 136);
  float* gcs = AM + 64 * 64;
  float* bts = gcs + 64;
  __syncthreads();
  if (wave == 0) {
    int i = lane; float gi = 0.f, bi = 0.f;
    if (i < NI) {
      const float* abr = ab + (size_t)(row0 + i) * 8;
      bi = sigmoidf_(abr[h]);
      float a = abr[4 + h] + p.dn_dt_bias[h];
      float sp = a > 20.f ? a : log1pf(expf(a));
      gi = -expf(p.dn_a_log[h]) * sp;
    }
    float c = gi;
#pragma unroll
    for (int off = 1; off < 64; off <<= 1) { float t = __shfl_up(c, off); if (lane >= off) c += t; }
    if (!SAMPLE) { float c31 = __shfl(c, 31); if (lane >= 32) c -= c31; }
    gcs[i] = c; bts[i] = bi;
  }
  __syncthreads();
  {
    const int sec = tid >> 7, c = tid & 127;
    const int col = sec * 512 + h * 128 + c;
    u16* dstm = sec ? KN : QN;
    const float w0 = p.dn_conv_w[col], w1 = p.dn_conv_w[1536 + col], w2 = p.dn_conv_w[2 * 1536 + col], w3 = p.dn_conv_w[3 * 1536 + col];
    float rr[3];
#pragma unroll
    for (int jj = 0; jj < 3; ++jj) {
      if (SAMPLE) rr[jj] = p.state_dn_conv[((size_t)b * 3 + jj) * 1536 + col];
      else rr[jj] = (pos0 > 0) ? bf2f(proj[(size_t)(row0 - 3 + jj) * DPJ + C_QKV + col]) : 0.f;
    }
    float ra = rr[0], rb = rr[1], rc = rr[2];
    const u16* pcol = proj + (size_t)row0 * DPJ + C_QKV + col;
    u16 raw[NI];
#pragma unroll
    for (int i = 0; i < NI; ++i) raw[i] = pcol[(size_t)i * DPJ];
#pragma unroll
    for (int i = 0; i < NI; ++i) {
      float rd = bf2f(raw[i]);
      float v = siluf_(w0 * ra + w1 * rb + w2 * rc + w3 * rd);
      dstm[i * 136 + c] = f2bf(v);
      ra = rb; rb = rc; rc = rd;
    }
#pragma unroll
    for (int i = NI; i < 64; ++i) dstm[i * 136 + c] = 0;
  }
  __syncthreads();
  {
    const int i = wave * 16 + m;
    const bool valid = i < NI;
    float eq[32], ek[32];
#pragma unroll
    for (int kh = 0; kh < 8; ++kh) {
      const int cc = (kh >> 1) * 32 + (kh & 1) * 16 + 4 * g;
      uint2 kv = *(const uint2*)(KN + i * 136 + cc);
      uint2 qv = *(const uint2*)(QN + i * 136 + cc);
      ek[kh * 4] = bflo(kv.x); ek[kh * 4 + 1] = bfhi(kv.x); ek[kh * 4 + 2] = bflo(kv.y); ek[kh * 4 + 3] = bfhi(kv.y);
      eq[kh * 4] = bflo(qv.x); eq[kh * 4 + 1] = bfhi(qv.x); eq[kh * 4 + 2] = bflo(qv.y); eq[kh * 4 + 3] = bfhi(qv.y);
    }
    float sq = 0.f, sk = 0.f;
#pragma unroll
    for (int e = 0; e < 32; ++e) { sq += eq[e] * eq[e]; sk += ek[e] * ek[e]; }
    sq += __shfl_xor(sq, 16); sq += __shfl_xor(sq, 32);
    sk += __shfl_xor(sk, 16); sk += __shfl_xor(sk, 32);
    const float rq = valid ? rsqrtf(sq + EPS) * 0.08838834764831845f : 0.f;
    const float rk = valid ? rsqrtf(sk + EPS) : 0.f;
#pragma unroll
    for (int e = 0; e < 32; ++e) { eq[e] *= rq; ek[e] *= rk; }
#pragma unroll
    for (int kh = 0; kh < 8; ++kh) {
      const int cc = (kh >> 1) * 32 + (kh & 1) * 16 + 4 * g;
      *(uint2*)(KN + i * 136 + cc) = make_uint2(pack2(ek[kh * 4], ek[kh * 4 + 1]), pack2(ek[kh * 4 + 2], ek[kh * 4 + 3]));
      *(uint2*)(QN + i * 136 + cc) = make_uint2(pack2(eq[kh * 4], eq[kh * 4 + 1]), pack2(eq[kh * 4 + 2], eq[kh * 4 + 3]));
    }
    if (wave < MT) {
      const float ei = __expf(gcs[i]);
#pragma unroll
      for (int ks = 0; ks < 4; ++ks) {
        const int e0 = ks * 8;
        fa[fidx_q<SAMPLE>(wave, ks) * 64 + lane] =
            make_uint4(pack2(eq[e0] * ei, eq[e0 + 1] * ei), pack2(eq[e0 + 2] * ei, eq[e0 + 3] * ei),
                       pack2(eq[e0 + 4] * ei, eq[e0 + 5] * ei), pack2(eq[e0 + 6] * ei, eq[e0 + 7] * ei));
      }
    }
  }
  __syncthreads();
  if (wave < MT) {
    const int it = wave;
    bf16x8 knI[4], qnI[4];
#pragma unroll
    for (int ks = 0; ks < 4; ++ks) {
      knI[ks] = *(const bf16x8*)(KN + (16 * it + m) * 136 + 32 * ks + 8 * g);
      qnI[ks] = *(const bf16x8*)(QN + (16 * it + m) * 136 + 32 * ks + 8 * g);
    }
    f32x4 qkv_[4];
#pragma unroll
    for (int jt = 0; jt < 4; ++jt) qkv_[jt] = f32x4{0, 0, 0, 0};
    const float gi_n = gcs[16 * it + m];
#pragma unroll
    for (int jt = 0; jt < 4; ++jt) {
      if (jt <= it && (SAMPLE || (jt >> 1) == (it >> 1))) {
        bf16x8 knJ[4];
#pragma unroll
        for (int ks = 0; ks < 4; ++ks) knJ[ks] = *(const bf16x8*)(KN + (16 * jt + m) * 136 + 32 * ks + 8 * g);
        f32x4 aa = f32x4{0, 0, 0, 0}, qq = f32x4{0, 0, 0, 0};
#pragma unroll
        for (int ks = 0; ks < 4; ++ks) { aa = MFMA(knI[ks], knJ[ks], aa); qq = MFMA(knJ[ks], qnI[ks], qq); }
        const int jA = 16 * jt + m;
        const float gj = gcs[jA];
#pragma unroll
        for (int r = 0; r < 4; ++r) {
          const int iA = 16 * it + 4 * g + r;
          float val = (jA < iA) ? bts[iA] * __expf(gcs[iA] - gj) * aa[r] : 0.f;
          AM[iA * 64 + jA] = val;
        }
        const int iQ = 16 * it + m;
#pragma unroll
        for (int r = 0; r < 4; ++r) {
          const int jQ = 16 * jt + 4 * g + r;
          qkv_[jt][r] = (jQ <= iQ) ? __expf(gi_n - gcs[jQ]) * qq[r] : 0.f;
        }
      }
    }
    {
      const bool up = !SAMPLE && (it >> 1);
      f32x4 lo = up ? qkv_[2] : qkv_[0], hi = up ? qkv_[3] : qkv_[1];
      fa[fidx_qk<SAMPLE>(it) * 64 + lane] =
          make_uint4(pack2(lo[0], lo[1]), pack2(lo[2], lo[3]), pack2(hi[0], hi[1]), pack2(hi[2], hi[3]));
    }
  }
  {
#pragma unroll
    for (int dd = 0; dd < 2; ++dd) {
      const int dt = 2 * wave + dd;
#pragma unroll
      for (int hf = 0; hf < KS2; ++hf) {
        const float gl = gcs[SAMPLE ? 63 : 32 * hf + 31];
        float vv[8];
#pragma unroll
        for (int e = 0; e < 8; ++e) {
          const int i = 32 * hf + (e >> 2) * 16 + 4 * g + (e & 3);
          vv[e] = bf2f(KN[i * 136 + 16 * dt + m]) * __expf(gl - gcs[i]);
        }
        fa[fidx_kd<SAMPLE>(dt, hf) * 64 + lane] =
            make_uint4(pack2(vv[0], vv[1]), pack2(vv[2], vv[3]), pack2(vv[4], vv[5]), pack2(vv[6], vv[7]));
      }
    }
    if (tid == 0) {
      float* gla = (float*)(p.ws + WS_GLAST);
      if (SAMPLE) gla[2048 + item] = __expf(gcs[63]);
      else { gla[2 * item] = __expf(gcs[31]); gla[2 * item + 1] = __expf(gcs[63]); }
    }
  }
  __syncthreads();
  float x[NI];
  {
  if (tid < 128) {
    const int dv = tid;
    const int col = 1024 + h * 128 + dv;
    const float w0 = p.dn_conv_w[col], w1 = p.dn_conv_w[1536 + col], w2 = p.dn_conv_w[2 * 1536 + col], w3 = p.dn_conv_w[3 * 1536 + col];
    float rr[3];
#pragma unroll
    for (int jj = 0; jj < 3; ++jj) {
      if (SAMPLE) rr[jj] = p.state_dn_conv[((size_t)b * 3 + jj) * 1536 + col];
      else rr[jj] = (pos0 > 0) ? bf2f(proj[(size_t)(row0 - 3 + jj) * DPJ + C_QKV + col]) : 0.f;
    }
    float ra = rr[0], rb = rr[1], rc = rr[2];
    const u16* pcol = proj + (size_t)row0 * DPJ + C_QKV + col;
#pragma unroll
    for (int i = 0; i < NI; ++i) x[i] = bf2f(pcol[(size_t)i * DPJ]);
    __builtin_amdgcn_sched_barrier(0);
#pragma unroll
    for (int i = 0; i < NI; ++i) {
      float rd = x[i];
      float v = siluf_(w0 * ra + w1 * rb + w2 * rc + w3 * rd);
      x[i] = bts[i] * v;
      ra = rb; rb = rc; rc = rd;
    }
  } else {
    const int dk = tid - 128;
#pragma unroll
    for (int i = 0; i < NI; ++i) x[i] = bts[i] * __expf(gcs[i]) * bf2f(KN[i * 136 + dk]);
  }
  {
    constexpr int NSUB = SAMPLE ? 1 : 2, NLI = SAMPLE ? 8 : 32;
#pragma unroll
    for (int hf = 0; hf < NSUB; ++hf) {
      float4 ac[8], an[8];
#pragma unroll
      for (int j4 = 0; j4 < 8; ++j4) { ac[j4] = make_float4(0, 0, 0, 0); an[j4] = make_float4(0, 0, 0, 0); }
      ac[0] = *(const float4*)(AM + (32 * hf + 1) * 64 + 32 * hf);
#pragma unroll
      for (int li = 1; li < NLI; ++li) {
        if (li + 1 < NLI) {
#pragma unroll
          for (int j4 = 0; j4 < 8; ++j4)
            if (j4 < (li + 4) / 4) an[j4] = *(const float4*)(AM + (32 * hf + li + 1) * 64 + 32 * hf + j4 * 4);
        }
        float acc0 = x[32 * hf + li], acc1 = 0.f;
#pragma unroll
        for (int j4 = 0; j4 < 8; ++j4) {
          if (j4 < (li + 3) / 4) {
            float4 a = ac[j4];
            if (j4 * 4 + 0 < li) acc0 -= a.x * x[32 * hf + j4 * 4 + 0];
            if (j4 * 4 + 1 < li) acc1 -= a.y * x[32 * hf + j4 * 4 + 1];
            if (j4 * 4 + 2 < li) acc0 -= a.z * x[32 * hf + j4 * 4 + 2];
            if (j4 * 4 + 3 < li) acc1 -= a.w * x[32 * hf + j4 * 4 + 3];
          }
        }
        x[32 * hf + li] = acc0 + acc1;
#pragma unroll
        for (int j4 = 0; j4 < 8; ++j4) ac[j4] = an[j4];
        __builtin_amdgcn_sched_barrier(0);
      }
    }
  }
  }
  __syncthreads();
  u16* WM = KN;
  if (tid < 128) {
    const int dv = tid, s = dv >> 4, n = dv & 15;
#pragma unroll
    for (int mt = 0; mt < MT; ++mt)
#pragma unroll
      for (int g4 = 0; g4 < 4; ++g4) {
        const int i0 = 16 * mt + 4 * g4;
        float4 o;
        o.x = (i0 + 0 < NI) ? x[(i0 + 0 < NI) ? i0 + 0 : 0] : 0.f;
        o.y = (i0 + 1 < NI) ? x[(i0 + 1 < NI) ? i0 + 1 : 0] : 0.f;
        o.z = (i0 + 2 < NI) ? x[(i0 + 2 < NI) ? i0 + 2 : 0] : 0.f;
        o.w = (i0 + 3 < NI) ? x[(i0 + 3 < NI) ? i0 + 3 : 0] : 0.f;
        uf[(s * MT + mt) * 64 + g4 * 16 + n] = o;
      }
  } else {
    const int dk = tid - 128;
#pragma unroll
    for (int i = 0; i < 16 * MT; ++i) WM[i * 136 + dk] = (i < NI) ? f2bf(-x[(i < NI) ? i : 0]) : (u16)0;
  }
  __syncthreads();
  {
    const int mt = SAMPLE ? 0 : wave;
#pragma unroll
    for (int q = 0; q < (SAMPLE ? 1 : 4); ++q) {
      const int ks = SAMPLE ? wave : q;
      uint2 lo = *(const uint2*)(WM + (16 * mt + m) * 136 + 32 * ks + 4 * g);
      uint2 hi = *(const uint2*)(WM + (16 * mt + m) * 136 + 32 * ks + 16 + 4 * g);
      fa[fidx_w<SAMPLE>(mt, ks) * 64 + lane] = make_uint4(lo.x, lo.y, hi.x, hi.y);
    }
  }
  if (SAMPLE || (item & 31) == 31) {
    float* dst = p.out + (SAMPLE ? O_NDS : O_NDP);
    for (int idx = tid; idx < 3 * 384; idx += 256) {
      int j = idx / 384, cc = idx % 384, sec = cc >> 7, c = cc & 127;
      int col = sec * 512 + h * 128 + c;
      dst[((size_t)b * 3 + j) * 1536 + col] = bf2f(proj[(size_t)(row0 + NI - 3 + j) * DPJ + C_QKV + col]);
    }
  }
}

template <bool SAMPLE>
__device__ __forceinline__ void delta_seq(const Params& p, int item, char* smem) {
  constexpr int MT = SAMPLE ? 1 : 4, KS2 = SAMPLE ? 1 : 2, NI = SAMPLE ? 8 : 64, NC = SAMPLE ? 1 : 32;
  constexpr int NF = MT * 8 + MT * KS2 + 8 * KS2;
  static_assert(SAMPLE, "prompt chains use delta_seq_p");
  constexpr int W_OFF = 0, Q_OFF = MT * 4, QK_OFF = MT * 8, KD_OFF = MT * 8 + MT * KS2;
  constexpr int NPRE = (NF * 64 + 255) / 256;
  const int tid = threadIdx.x, lane = tid & 63, wave = tid >> 6, n = lane & 15, g = lane >> 4;
  const int bh = item >> 1, half = item & 1, b = bh >> 2, h = bh & 3;
  const int s = half * 4 + wave;
  const float* glast = (const float*)(p.ws + WS_GLAST);
  u16* ofp = (u16*)(p.ws + WS_X);
  const uint4* fa0; const float4* uf0; int chunk0, row00;
  if (SAMPLE) {
    fa0 = (const uint4*)(p.ws + WS_FRAG + 1024 * FRAG_P_BYTES + (size_t)bh * FRAG_S_BYTES);
    uf0 = (const float4*)((char*)p.out + YS_UF + 1024 * UF_P_BYTES + (size_t)bh * UF_S_BYTES);
    chunk0 = 2048 + bh; row00 = NP + b * 8;
  } else {
    fa0 = (const uint4*)(p.ws + WS_FRAG + (size_t)bh * 32 * FRAG_P_BYTES);
    uf0 = (const float4*)((char*)p.out + YS_UF + (size_t)bh * 32 * UF_P_BYTES);
    chunk0 = bh * 32; row00 = b * SEQ;
  }
  constexpr size_t FSTR = (SAMPLE ? FRAG_S_BYTES : FRAG_P_BYTES) / 16, USTR = (SAMPLE ? UF_S_BYTES : UF_P_BYTES) / 16;
  uint4* L = (uint4*)smem;
  f32x4 S[8];
  if (SAMPLE) {
    const float* s0 = p.state_dn_S + (size_t)bh * 16384;
#pragma unroll
    for (int dt = 0; dt < 8; ++dt)
#pragma unroll
      for (int r = 0; r < 4; ++r) S[dt][r] = s0[(16 * dt + 4 * g + r) * 128 + 16 * s + n];
  } else {
#pragma unroll
    for (int dt = 0; dt < 8; ++dt) S[dt] = f32x4{0, 0, 0, 0};
  }
  uint4 pre[NPRE];
  f32x4 upre[MT];
  float glpre;
#define SEQ_PREFETCH(c_)                                                                     \
  {                                                                                          \
    const uint4* fa_ = fa0 + (size_t)(c_) * FSTR;                                            \
    _Pragma("unroll") for (int q = 0; q < NPRE; ++q) {                                       \
      int idx = tid + q * 256;                                                               \
      pre[q] = (NF * 64 % 256 == 0 || idx < NF * 64) ? fa_[idx] : make_uint4(0, 0, 0, 0);   \
    }                                                                                        \
    const float4* uf_ = uf0 + (size_t)(c_) * USTR;                                           \
    _Pragma("unroll") for (int mt = 0; mt < MT; ++mt) {                                      \
      float4 t = uf_[(s * MT + mt) * 64 + lane];                                             \
      upre[mt] = f32x4{t.x, t.y, t.z, t.w};                                                  \
    }                                                                                        \
    glpre = glast[chunk0 + (c_)];                                                            \
  }
  SEQ_PREFETCH(0)
#pragma unroll 1
  for (int c = 0; c < NC; ++c) {
    __syncthreads();
#pragma unroll
    for (int q = 0; q < NPRE; ++q) {
      int idx = tid + q * 256;
      if (NF * 64 % 256 == 0 || idx < NF * 64) L[idx] = pre[q];
    }
    f32x4 accV[MT], accO[MT];
#pragma unroll
    for (int mt = 0; mt < MT; ++mt) { accV[mt] = upre[mt]; accO[mt] = f32x4{0, 0, 0, 0}; }
    const float gl = glpre;
    __syncthreads();
    if (c + 1 < NC) SEQ_PREFETCH(c + 1)
    bf16x8 Sb[4];
#pragma unroll
    for (int ks = 0; ks < 4; ++ks)
      Sb[ks] = mk8(pack2(S[2 * ks][0], S[2 * ks][1]), pack2(S[2 * ks][2], S[2 * ks][3]),
                   pack2(S[2 * ks + 1][0], S[2 * ks + 1][1]), pack2(S[2 * ks + 1][2], S[2 * ks + 1][3]));
#pragma unroll
    for (int mt = 0; mt < MT; ++mt)
#pragma unroll
      for (int ks = 0; ks < 4; ++ks) {
        accV[mt] = MFMA(u4_to_b8(L[(W_OFF + mt * 4 + ks) * 64 + lane]), Sb[ks], accV[mt]);
        accO[mt] = MFMA(u4_to_b8(L[(Q_OFF + mt * 4 + ks) * 64 + lane]), Sb[ks], accO[mt]);
        if (ks == 3) __builtin_amdgcn_sched_barrier(0);
      }
    bf16x8 Vb[KS2];
#pragma unroll
    for (int ks2 = 0; ks2 < KS2; ++ks2) {
      f32x4 lo = accV[(2 * ks2 < MT) ? 2 * ks2 : 0];
      f32x4 hi = (2 * ks2 + 1 < MT) ? accV[(2 * ks2 + 1 < MT) ? 2 * ks2 + 1 : 0] : f32x4{0, 0, 0, 0};
      Vb[ks2] = mk8(pack2(lo[0], lo[1]), pack2(lo[2], lo[3]), pack2(hi[0], hi[1]), pack2(hi[2], hi[3]));
    }
#pragma unroll
    for (int mt = 0; mt < MT; ++mt)
#pragma unroll
      for (int ks2 = 0; ks2 < KS2; ++ks2)
        accO[mt] = MFMA(u4_to_b8(L[(QK_OFF + mt * KS2 + ks2) * 64 + lane]), Vb[ks2], accO[mt]);
#pragma unroll
    for (int dt = 0; dt < 8; ++dt) {
      S[dt] = S[dt] * gl;
#pragma unroll
      for (int ks2 = 0; ks2 < KS2; ++ks2)
        S[dt] = MFMA(u4_to_b8(L[(KD_OFF + dt * KS2 + ks2) * 64 + lane]), Vb[ks2], S[dt]);
      if (dt & 1) __builtin_amdgcn_sched_barrier(0);
    }
    const int rowc = row00 + c * 64;
#pragma unroll
    for (int mt = 0; mt < MT; ++mt)
#pragma unroll
      for (int r = 0; r < 4; ++r) {
        const int i = 16 * mt + 4 * g + r;
        if (i < NI) ofp[(size_t)(rowc + i) * 512 + h * 128 + 16 * s + n] = f2bf(accO[mt][r]);
      }
  }
  float* so = p.out + (SAMPLE ? O_NSS : O_NSP) + (size_t)bh * 16384;
#pragma unroll
  for (int dt = 0; dt < 8; ++dt)
#pragma unroll
    for (int r = 0; r < 4; ++r) so[(16 * dt + 4 * g + r) * 128 + 16 * s + n] = S[dt][r];
  __syncthreads();
}


__device__ __forceinline__ void delta_seq_p(const Params& p, int item, char* smem) {
  constexpr int NFH = 26, NH = 64;
  constexpr int W_OFF = 0, Q_OFF = 8, QK_OFF = 16, KD_OFF = 18;
  constexpr int NV = NFH * 64;
  constexpr int NPRE = (NV + 255) / 256;
  const int tid = threadIdx.x, lane = tid & 63, wave = tid >> 6, n = lane & 15, g = lane >> 4;
  const int bh = item >> 1, half = item & 1, b = bh >> 2, h = bh & 3;
  const int s = half * 4 + wave;
  const float* glast = (const float*)(p.ws + WS_GLAST) + (size_t)bh * 64;
  u16* ofp = (u16*)(p.ws + WS_X);
  const uint4* fa0 = (const uint4*)(p.ws + WS_FRAG + (size_t)bh * 32 * FRAG_P_BYTES);
  const float4* uf0 = (const float4*)((char*)p.out + YS_UF + (size_t)bh * 32 * UF_P_BYTES);
  const int row00 = b * SEQ;
  uint4* L = (uint4*)smem;
  f32x4 S[8];
#pragma unroll
  for (int dt = 0; dt < 8; ++dt) S[dt] = f32x4{0, 0, 0, 0};
  uint4 PA[NPRE], PB[NPRE];
  f32x4 UA[2], UB[2];
  float GA = 0.f, GB = 0.f; (void)GA; (void)GB;
  constexpr int TOUCH_AHEAD = 8;
  uint32_t TA = 0, TB = 0, tsink = 0;
#define SEQP_TOUCH(T_, hs_)                                                                     \
  {                                                                                             \
    tsink ^= T_;                                                                                \
    const int ht_ = (hs_) + TOUCH_AHEAD;                                                        \
    if (ht_ < NH) {                                                                             \
      const int c64_ = ht_ >> 1, hf_ = ht_ & 1;                                                 \
      const uint32_t* fl_ = (const uint32_t*)(fa0 + (size_t)c64_ * (FRAG_P_BYTES / 16) + hf_ * NV);  \
      const uint32_t* ul_ = (const uint32_t*)(uf0 + (size_t)c64_ * (UF_P_BYTES / 16));            \
      uint32_t t0_ = (tid < 208) ? fl_[tid * 32] : 0u;                                          \
      uint32_t t1_ = (tid < 64) ? ul_[(((half * 4 + (tid >> 4)) * 4 + 2 * hf_ + ((tid >> 3) & 1)) * 64) * 4 + (tid & 7) * 32] : 0u; \
      T_ = t0_ ^ t1_;                                                                           \
    }                                                                                           \
  }
#define SEQP_LOAD(P_, U_, G_, hs_)                                                              \
  {                                                                                             \
    const int c64_ = (hs_) >> 1, hf_ = (hs_) & 1;                                               \
    const uint4* fa_ = fa0 + (size_t)c64_ * (FRAG_P_BYTES / 16) + hf_ * NV;                     \
    _Pragma("unroll") for (int q = 0; q < NPRE; ++q) {                                          \
      int idx = tid + q * 256;                                                                  \
      P_[q] = (idx < NV) ? fa_[idx] : make_uint4(0, 0, 0, 0);                                   \
    }                                                                                           \
    const float4* uf_ = uf0 + (size_t)c64_ * (UF_P_BYTES / 16);                                 \
    _Pragma("unroll") for (int mt = 0; mt < 2; ++mt) {                                          \
      float4 t = uf_[(s * 4 + 2 * hf_ + mt) * 64 + lane];                                       \
      U_[mt] = f32x4{t.x, t.y, t.z, t.w};                                                       \
    }                                                                                           \
  }
#define SEQP_STEP(P_, U_, G_, T_, hs_, buf_)                                                        \
  {                                                                                             \
    uint4* Lb = L + (buf_) * NV;                                                                \
    _Pragma("unroll") for (int q = 0; q < NPRE; ++q) {                                          \
      int idx = tid + q * 256;                                                                  \
      if (idx < NV) Lb[idx] = P_[q];                                                            \
    }                                                                                           \
    f32x4 accV[2], accO[2];                                                                     \
    accV[0] = U_[0]; accV[1] = U_[1];                                                           \
    accO[0] = f32x4{0, 0, 0, 0}; accO[1] = f32x4{0, 0, 0, 0};                                   \
    __syncthreads();                                                                            \
    const float gl = gls[(hs_)];                                                                \
    if ((hs_) + 2 < NH) SEQP_LOAD(P_, U_, G_, (hs_) + 2)                                        \
    bf16x8 Sb[4];                                                                               \
    _Pragma("unroll") for (int ks = 0; ks < 4; ++ks)                                            \
      Sb[ks] = mk8(pack2(S[2 * ks][0], S[2 * ks][1]), pack2(S[2 * ks][2], S[2 * ks][3]),        \
                   pack2(S[2 * ks + 1][0], S[2 * ks + 1][1]), pack2(S[2 * ks + 1][2], S[2 * ks + 1][3])); \
    _Pragma("unroll") for (int mt = 0; mt < 2; ++mt)                                            \
      _Pragma("unroll") for (int ks = 0; ks < 4; ++ks) {                                        \
        accV[mt] = MFMA(u4_to_b8(Lb[(W_OFF + mt * 4 + ks) * 64 + lane]), Sb[ks], accV[mt]);     \
        accO[mt] = MFMA(u4_to_b8(Lb[(Q_OFF + mt * 4 + ks) * 64 + lane]), Sb[ks], accO[mt]);     \
      }                                                                                         \
    __builtin_amdgcn_sched_barrier(0);                                                          \
    bf16x8 Vb = mk8(pack2(accV[0][0], accV[0][1]), pack2(accV[0][2], accV[0][3]),               \
                    pack2(accV[1][0], accV[1][1]), pack2(accV[1][2], accV[1][3]));              \
    _Pragma("unroll") for (int mt = 0; mt < 2; ++mt)                                            \
      accO[mt] = MFMA(u4_to_b8(Lb[(QK_OFF + mt) * 64 + lane]), Vb, accO[mt]);                   \
    _Pragma("unroll") for (int dt = 0; dt < 8; ++dt) {                                          \
      S[dt] = S[dt] * gl;                                                                       \
      S[dt] = MFMA(u4_to_b8(Lb[(KD_OFF + dt) * 64 + lane]), Vb, S[dt]);                         \
    }                                                                                           \
    const int rowc = row00 + (hs_) * 32;                                                        \
    _Pragma("unroll") for (int mt = 0; mt < 2; ++mt)                                            \
      _Pragma("unroll") for (int r = 0; r < 4; ++r)                                             \
        ofp[(size_t)(rowc + 16 * mt + 4 * g + r) * 512 + h * 128 + 16 * s + n] = f2bf(accO[mt][r]);   \
  }
  __syncthreads();
  float* gls = (float*)(smem + 2 * NV * 16);
  if (tid < 64) gls[tid] = glast[tid];
  SEQP_LOAD(PA, UA, GA, 0)
  SEQP_LOAD(PB, UB, GB, 1)
#pragma unroll 1
  for (int hs = 0; hs < NH; hs += 2) {
    SEQP_STEP(PA, UA, GA, TA, hs, 0)
    SEQP_STEP(PB, UB, GB, TB, hs + 1, 1)
  }
  float* so = p.out + O_NSP + (size_t)bh * 16384;
#pragma unroll
  for (int dt = 0; dt < 8; ++dt)
#pragma unroll
    for (int r = 0; r < 4; ++r) so[(16 * dt + 4 * g + r) * 128 + 16 * s + n] = S[dt][r];
  __syncthreads();
}

template <int MH>
__device__ __forceinline__ void g2_tile(const Params& p, int m0, int n0, char* smem) {
  const u16* cact = (const u16*)((const char*)p.out + YS_CACT);
  const u16* pw = (const u16*)(p.ws + WS_PW);
  const u16* proj = (const u16*)(p.ws + WS_PROJ);
  u16* cmix = (u16*)(p.ws + WS_CMIX);
  f32x4 acc[4][4];
#pragma unroll
  for (int i = 0; i < 4; ++i)
#pragma unroll
    for (int j = 0; j < 4; ++j) acc[i][j] = f32x4{0, 0, 0, 0};
  gemm128<false, MH>(cact + (size_t)m0 * 512, 512, pw + (size_t)n0 * 512, 512, 512, smem, acc);
  uint2 gpre[4][4];
  GEMM_EPILOGUE_M(acc, m0, n0, MH, { (void)v; gpre[mt][nt] = *(const uint2*)(proj + (size_t)row * DPJ + C_GATE + col); })
  GEMM_EPILOGUE_M(acc, m0, n0, MH, {
    uint2 gv = gpre[mt][nt];
    float o0 = v[0] * siluf_(bflo(gv.x)), o1 = v[1] * siluf_(bfhi(gv.x));
    float o2 = v[2] * siluf_(bflo(gv.y)), o3 = v[3] * siluf_(bfhi(gv.y));
    *(uint2*)(cmix + (size_t)row * 512 + col) = make_uint2(pack2(o0, o1), pack2(o2, o3));
  })
}


__device__ __forceinline__ void phase4(const Params& p, int bid, int nb, char* smem) {
  const int nfull4 = (544 / nb) * nb, rem4 = 544 - nfull4;
  const int nhalf4 = (2 * rem4 <= nb) ? 2 * rem4 : 0;
#pragma unroll 1
  for (int it = bid; it < (nhalf4 > 0 ? nfull4 : 544); it += nb) g2_tile<4>(p, (it >> 2) * 128, (it & 3) * 128, smem);
  if (bid < nhalf4) {
    const int it = nfull4 + (bid >> 1);
    g2_tile<2>(p, (it >> 2) * 128 + (bid & 1) * 64, (it & 3) * 128, smem);
  }
  const int tid = threadIdx.x, lane = tid & 63, wave = tid >> 6;
  const u16* ofp = (const u16*)(p.ws + WS_X);
  const u16* proj = (const u16*)(p.ws + WS_PROJ);
  u16* omix = (u16*)(p.ws + WS_OMIX);
  const int nheavy4 = nhalf4 > 0 ? nhalf4 : ((544 > nb && 544 < 2 * nb) ? 544 - nb : 0);
  if (bid < nheavy4) return;
  const int ob = bid - nheavy4, onb = nb - nheavy4;
  for (int row = ob * 4 + wave; row < NT; row += onb * 4) {
    const uint4 ov = *(const uint4*)(ofp + (size_t)row * 512 + lane * 8);
    float o[8] = {bflo(ov.x), bfhi(ov.x), bflo(ov.y), bfhi(ov.y), bflo(ov.z), bfhi(ov.z), bflo(ov.w), bfhi(ov.w)};
    float ss = 0.f;
#pragma unroll
    for (int e = 0; e < 8; ++e) ss += o[e] * o[e];
    ss += __shfl_xor(ss, 1); ss += __shfl_xor(ss, 2); ss += __shfl_xor(ss, 4); ss += __shfl_xor(ss, 8);
    float r = rsqrtf(ss * (1.f / 128.f) + EPS);
    uint4 zv = *(const uint4*)(proj + (size_t)row * DPJ + C_Z + lane * 8);
    float z[8] = {bflo(zv.x), bfhi(zv.x), bflo(zv.y), bfhi(zv.y), bflo(zv.z), bfhi(zv.z), bflo(zv.w), bfhi(zv.w)};
    float4 g0 = *(const float4*)(p.dn_norm_g + (lane & 15) * 8), g1 = *(const float4*)(p.dn_norm_g + (lane & 15) * 8 + 4);
    float gg[8] = {g0.x, g0.y, g0.z, g0.w, g1.x, g1.y, g1.z, g1.w};
    float y[8];
#pragma unroll
    for (int e = 0; e < 8; ++e) y[e] = o[e] * r * gg[e] * siluf_(z[e]);
    *(uint4*)(omix + (size_t)row * 512 + lane * 8) = make_uint4(pack2(y[0], y[1]), pack2(y[2], y[3]), pack2(y[4], y[5]), pack2(y[6], y[7]));
  }
}

__device__ __forceinline__ void ple_tile(const Params& p, int t, char* smem) {
  const u16* pb = (const u16*)(p.ws + WS_PB2);
  const u16* pp = (const u16*)(p.ws + WS_PPROJ);
  u16* pl = (u16*)(p.ws + WS_PL);
  int m0 = (t >> 3) * 128, n0 = (t & 7) * 128;
  f32x4 acc[4][4];
#pragma unroll
  for (int i = 0; i < 4; ++i)
#pragma unroll
    for (int j = 0; j < 4; ++j) acc[i][j] = f32x4{0, 0, 0, 0};
  gemm128<false>(pb + (size_t)m0 * 256, 256, pp + (size_t)n0 * 256, 256, 256, smem, acc);
  GEMM_EPILOGUE(acc, m0, n0, {
    *(uint2*)(pl + (size_t)row * 1024 + col) = make_uint2(pack2(v[0], v[1]), pack2(v[2], v[3]));
  })
}

template <int MH>
__device__ __forceinline__ void g3_unit(const Params& p, int m0, int n0, char* smem, bool do_atomic) {
  const u16* cmix = (const u16*)(p.ws + WS_CMIX);
  const u16* omix = (const u16*)(p.ws + WS_OMIX);
  const u16* wo = (const u16*)(p.ws + WS_WOUT);
  u16* x1b = (u16*)(p.ws + WS_X);
  float* ss2 = (float*)(p.ws + WS_SS2);
  float* y = p.out + O_Y;
  f32x4 acc[4][4];
#pragma unroll
  for (int i = 0; i < 4; ++i)
#pragma unroll
    for (int j = 0; j < 4; ++j) acc[i][j] = f32x4{0, 0, 0, 0};
  gemm128<false, MH>(cmix + (size_t)m0 * 512, 512, wo + (size_t)n0 * 1024, 1024, 512, smem, acc);
  gemm128<false, MH>(omix + (size_t)m0 * 512, 512, wo + (size_t)n0 * 1024 + 512, 1024, 512, smem, acc);
  float rs[4] = {0, 0, 0, 0};
  float4 xpre[4][4];
  GEMM_EPILOGUE_M(acc, m0, n0, MH, { (void)v; xpre[mt][nt] = *(const float4*)(xrow(p, row) + col); })
  GEMM_EPILOGUE_M(acc, m0, n0, MH, {
    float4 xv = xpre[mt][nt];
    float o0 = xv.x + v[0], o1 = xv.y + v[1], o2 = xv.z + v[2], o3 = xv.w + v[3];
    *(uint2*)(x1b + (size_t)row * 1024 + col) = make_uint2(pack2(o0, o1), pack2(o2, o3));
    rs[mt] += o0 * o0 + o1 * o1 + o2 * o2 + o3 * o3;
  })
  {
    const int lane = threadIdx.x & 63, wave = threadIdx.x >> 6;
#pragma unroll
    for (int mt = 0; mt < MH; ++mt) {
      float sq = rs[mt];
      sq += __shfl_xor(sq, 16); sq += __shfl_xor(sq, 32);
      if (lane < 16 && do_atomic) atomicAdd(&ss2[m0 + (wave >> 1) * (16 * MH) + mt * 16 + lane], sq);
    }
  }
}

template <int MH>
__device__ __forceinline__ void g4_unit(const Params& p, int m0, int n0, char* smem, bool do_atomic) {
  const u16* x1b = (const u16*)(p.ws + WS_X);
  const u16* pl = (const u16*)(p.ws + WS_PL);
  const u16* gt = (const u16*)(p.ws + WS_GATE);
  const float* ss2 = (const float*)(p.ws + WS_SS2);
  float* ss3 = (float*)(p.ws + WS_SS3);
  const float* y = p.out + O_Y;
  u16* x2b = (u16*)(p.ws + WS_X2B);
  f32x4 acc[4][4];
#pragma unroll
  for (int i = 0; i < 4; ++i)
#pragma unroll
    for (int j = 0; j < 4; ++j) acc[i][j] = f32x4{0, 0, 0, 0};
  gemm128<false, MH>(x1b + (size_t)m0 * 1024, 1024, gt + (size_t)n0 * 1024, 1024, 1024, smem, acc);
  float rs[4] = {0, 0, 0, 0};
  uint2 ypre[4][4];
  uint2 ppre[4][4];
  float r2pre[4];
  GEMM_EPILOGUE_M(acc, m0, n0, MH, {
    (void)v;
    ypre[mt][nt] = *(const uint2*)(x1b + (size_t)row * 1024 + col);
    ppre[mt][nt] = *(const uint2*)(pl + (size_t)row * 1024 + col);
    if (nt == 0) r2pre[mt] = ss2[row];
  })
  GEMM_EPILOGUE_M(acc, m0, n0, MH, {
    float r2 = rsqrtf(r2pre[mt] * (1.f / 1024.f) + EPS);
    uint2 xv = ypre[mt][nt];
    uint2 pv = ppre[mt][nt];
    float o0 = bflo(xv.x) + sigmoidf_(v[0] * r2) * bflo(pv.x), o1 = bfhi(xv.x) + sigmoidf_(v[1] * r2) * bfhi(pv.x);
    float o2 = bflo(xv.y) + sigmoidf_(v[2] * r2) * bflo(pv.y), o3 = bfhi(xv.y) + sigmoidf_(v[3] * r2) * bfhi(pv.y);
    *(uint2*)(x2b + (size_t)row * 1024 + col) = make_uint2(pack2(o0, o1), pack2(o2, o3));
    rs[mt] += o0 * o0 + o1 * o1 + o2 * o2 + o3 * o3;
  })
  {
    const int lane = threadIdx.x & 63, wave = threadIdx.x >> 6;
#pragma unroll
    for (int mt = 0; mt < MH; ++mt) {
      float sq = rs[mt];
      sq += __shfl_xor(sq, 16); sq += __shfl_xor(sq, 32);
      if (lane < 16 && do_atomic) atomicAdd(&ss3[m0 + (wave >> 1) * (16 * MH) + mt * 16 + lane], sq);
    }
  }
}

template <int G>
__device__ __forceinline__ void g34_tiles(const Params& p, int bid, int nb, char* smem, bool do_atomic, bool& heavy, int& nlight, int& lidx) {
  const TileWalk tw = tile_walk(8, bid, nb);
  heavy = false; nlight = nb; lidx = bid;
  if (tw.banded && tw.total > tw.step) {
    const int nfull = (tw.total / tw.step) * tw.step, rem = tw.total - nfull;
#pragma unroll 1
    for (int t = tw.q; t < nfull; t += tw.step) {
      int mt_, nt_;
      tile_get(tw, t, mt_, nt_);
      if (G == 0) g3_unit<4>(p, mt_ * 128, nt_ * 128, smem, do_atomic); else g4_unit<4>(p, mt_ * 128, nt_ * 128, smem, do_atomic);
    }
    const int nhalf = 2 * rem <= tw.step ? 2 * rem : 0;
    if (nhalf > 0) {
      if (tw.q < nhalf) {
        int mt_, nt_;
        tile_get(tw, nfull + (tw.q >> 1), mt_, nt_);
        const int m0 = mt_ * 128 + (tw.q & 1) * 64;
        if (G == 0) g3_unit<2>(p, m0, nt_ * 128, smem, do_atomic); else g4_unit<2>(p, m0, nt_ * 128, smem, do_atomic);
        heavy = true;
      }
      nlight = (tw.step - nhalf) * 8; lidx = (tw.q - nhalf) * 8 + (bid & 7);
    } else {
#pragma unroll 1
      for (int t = nfull + tw.q; t < tw.total; t += tw.step) {
        int mt_, nt_;
        tile_get(tw, t, mt_, nt_);
        if (G == 0) g3_unit<4>(p, mt_ * 128, nt_ * 128, smem, do_atomic); else g4_unit<4>(p, mt_ * 128, nt_ * 128, smem, do_atomic);
      }
    }
  } else {
#pragma unroll 1
    for (int t = tw.q; t < tw.total; t += tw.step) {
      int mt_, nt_;
      tile_get(tw, t, mt_, nt_);
      if (G == 0) g3_unit<4>(p, mt_ * 128, nt_ * 128, smem, do_atomic); else g4_unit<4>(p, mt_ * 128, nt_ * 128, smem, do_atomic);
    }
  }
}
__device__ __forceinline__ void phase5(const Params& p, int bid, int nb, char* smem, bool do_atomic = true) {
  bool heavy; int nlight, lidx;
  g34_tiles<0>(p, bid, nb, smem, do_atomic, heavy, nlight, lidx);
  if (do_atomic && !heavy) {
#pragma unroll 1
    for (int it = lidx; it < 1088; it += nlight) ple_tile(p, it, smem);
  }
}
__device__ __forceinline__ void phase6(const Params& p, int bid, int nb, char* smem, bool do_atomic = true) {
  bool heavy; int nlight, lidx;
  g34_tiles<1>(p, bid, nb, smem, do_atomic, heavy, nlight, lidx);
}

__device__ __forceinline__ void phase7(const Params& p, int bid, int nb) {
  const int tid = threadIdx.x;
  const float* ss3 = (const float*)(p.ws + WS_SS3);
  const u16* x2b = (const u16*)(p.ws + WS_X2B);
  float* y = p.out + O_Y;
  for (size_t i = (size_t)bid * 256 + tid; i < (size_t)NT * 128; i += (size_t)nb * 256) {
    const int row = (int)(i >> 7), c = (int)(i & 127) * 8;
    const float r = rsqrtf(ss3[row] * (1.f / 1024.f) + EPS);
    const uint4 v = *(const uint4*)(x2b + (size_t)row * 1024 + c);
    const float4 g0 = *(const float4*)(p.final_norm_g + c), g1 = *(const float4*)(p.final_norm_g + c + 4);
    *(float4*)(y + (size_t)row * 1024 + c) = make_float4(bflo(v.x) * r * g0.x, bfhi(v.x) * r * g0.y, bflo(v.y) * r * g0.z, bfhi(v.y) * r * g0.w);
    *(float4*)(y + (size_t)row * 1024 + c + 4) = make_float4(bflo(v.z) * r * g1.x, bfhi(v.z) * r * g1.y, bflo(v.w) * r * g1.z, bfhi(v.w) * r * g1.w);
  }
}

__device__ __forceinline__ void phase2(const Params& p, int bid, int nb, char* smem) {
#pragma unroll 1
  for (int it = bid; it < 1024; it += nb) delta_prep<false>(p, it, smem);
}
__device__ __forceinline__ void phase3(const Params& p, int bid, int nb, char* smem) {
  if (nb >= 128) {
    if (bid < 64) { delta_seq_p(p, bid, smem); return; }
    bid -= 64; nb -= 64;
  } else {
    for (int it = bid; it < 64; it += nb) delta_seq_p(p, it, smem);
  }
#pragma unroll 1
  for (int it = bid; it < 512; it += nb) conv_tile<false>(p, it, smem);
#pragma unroll 1
  for (int it = nb - 1 - bid; it < 128; it += nb) conv_tile<true>(p, it, smem);
#pragma unroll 1
  for (int it = bid; it < 512; it += nb) {
    delta_prep<true>(p, it, smem);
    __threadfence_block();
    __syncthreads();
#pragma unroll 1
    for (int hf = 0; hf < 2; ++hf) delta_seq<true>(p, 2 * it + hf, smem);
  }
}

#define XB_TMO      128
#define XB_XCNT(j)  (256  + 64 * (j))
#define XB_XSUB(j)  (1280 + 64 * (j))
#define XB_XGEN(j)  (2304 + 64 * (j))
#define XB_TOP      3328
#define XB_TOPGEN   3392
#define XCD_BAR_WORDS 3456
#define XB_SPIN_CAP (1u << 22)
__device__ __forceinline__ unsigned xb_ld(unsigned* p) { return __hip_atomic_load(p, __ATOMIC_RELAXED, __HIP_MEMORY_SCOPE_AGENT); }
__device__ __forceinline__ unsigned xb_add(unsigned* p, unsigned v) { return __hip_atomic_fetch_add(p, v, __ATOMIC_RELAXED, __HIP_MEMORY_SCOPE_AGENT); }
__device__ __forceinline__ unsigned xb_xcc_id() { return (unsigned)__builtin_amdgcn_s_getreg((3 << 11) | 20) & 0xFu; }
#define XB_SPIN(cond, bar) do { unsigned _sp = 0; while (cond) { __builtin_amdgcn_s_sleep(1); \
    if ((++_sp & 255u) == 0u) { if (xb_ld(&(bar)[XB_TMO])) break; if (_sp > XB_SPIN_CAP) { atomicAdd(&(bar)[XB_TMO], 1u); break; } } } } while (0)
struct XcdBarrier { unsigned* bar; unsigned x; unsigned nloc; unsigned nx; };
__device__ __forceinline__ void xcd_barrier_complete(unsigned* bar, unsigned x, unsigned& nloc, unsigned& nx) {
  const unsigned G = gridDim.x;
  unsigned sum, cnt, mine, sp = 0u;
  for (;;) {
    sum = 0u; cnt = 0u; mine = 0u;
#pragma unroll
    for (unsigned j = 0; j < 16; ++j) { const unsigned c = xb_ld(&bar[XB_XCNT(j)]); sum += c; cnt += (c > 0u) ? 1u : 0u; mine = (j == x) ? c : mine; }
    if (sum == G) break;
    __builtin_amdgcn_s_sleep(1);
    if ((++sp & 255u) == 0u) { if (xb_ld(&bar[XB_TMO])) break; if (sp > XB_SPIN_CAP) { atomicAdd(&bar[XB_TMO], 1u); break; } }
  }
  nloc = mine > 0u ? mine : 1u; nx = cnt > 0u ? cnt : 1u;
}
__device__ __forceinline__ void xcd_barrier(XcdBarrier& b) {
  asm volatile("s_waitcnt vmcnt(0)" ::: "memory");
  __syncthreads();
  if (threadIdx.x == 0) {
    unsigned* bar = b.bar;
    __builtin_amdgcn_s_waitcnt(0);
    if (b.nloc == 0u) xcd_barrier_complete(bar, b.x, b.nloc, b.nx);
    const unsigned nloc = b.nloc, nx = b.nx;
    const unsigned old = xb_add(&bar[XB_XSUB(b.x)], 1u);
    const unsigned gen = old / nloc;
    if (old + 1u == (gen + 1u) * nloc) {
      __builtin_amdgcn_fence(__ATOMIC_RELEASE, "agent");
      asm volatile("s_waitcnt vmcnt(0)" ::: "memory");
      const unsigned og = xb_add(&bar[XB_TOP], 1u);
      const unsigned tg = og / nx;
      if (og + 1u == (tg + 1u) * nx) xb_add(&bar[XB_TOPGEN], 1u);
      else XB_SPIN(xb_ld(&bar[XB_TOPGEN]) == tg, bar);
      __builtin_amdgcn_fence(__ATOMIC_ACQUIRE, "agent");
      xb_add(&bar[XB_XGEN(b.x)], 1u);
      asm volatile("s_waitcnt vmcnt(0)" ::: "memory");
    } else {
      XB_SPIN(xb_ld(&bar[XB_XGEN(b.x)]) == gen, bar);
      __builtin_amdgcn_fence(__ATOMIC_ACQUIRE, "agent");
      asm volatile("s_waitcnt vmcnt(0)" ::: "memory");
    }
  }
  __syncthreads();
}

template <int MODE>
__global__ void __launch_bounds__(256, 2) mega(Params p) {
  __shared__ __attribute__((aligned(16))) char smem[65536];
  const int bid = blockIdx.x, nb = gridDim.x;
  if (MODE < 0) {
    XcdBarrier gb;
    gb.bar = (unsigned*)(p.ws + WS_BAR); gb.x = xb_xcc_id(); gb.nloc = 0u; gb.nx = 0u;
    if (threadIdx.x == 0) (void)xb_add(&gb.bar[XB_XCNT(gb.x)], 1u);
    phase0(p, bid, nb, smem); xcd_barrier(gb);
    if (PROBE_DUP == 0) { phase0(p, bid, nb, smem); xcd_barrier(gb); }
    phase1(p, bid, nb, smem); xcd_barrier(gb);
    if (PROBE_DUP == 1) { phase1(p, bid, nb, smem); xcd_barrier(gb); }
    phase2(p, bid, nb, smem); xcd_barrier(gb);
    if (PROBE_DUP == 2) { phase2(p, bid, nb, smem); xcd_barrier(gb); }
    phase3(p, bid, nb, smem); xcd_barrier(gb);
    if (PROBE_DUP == 3) { phase3(p, bid, nb, smem); xcd_barrier(gb); }
    phase4(p, bid, nb, smem); xcd_barrier(gb);
    if (PROBE_DUP == 4) { phase4(p, bid, nb, smem); xcd_barrier(gb); }
    if (PROBE_DUP == 11) { phase5(p, bid, nb, smem, false); xcd_barrier(gb); }
    phase5(p, bid, nb, smem); xcd_barrier(gb);
    phase6(p, bid, nb, smem); xcd_barrier(gb);
    phase7(p, bid, nb);
  } else {
    if (MODE == 0) phase0(p, bid, nb, smem);
    if (MODE == 1) phase1(p, bid, nb, smem);
    if (MODE == 2) phase2(p, bid, nb, smem);
    if (MODE == 3) phase3(p, bid, nb, smem);
    if (MODE == 4) phase4(p, bid, nb, smem);
    if (MODE == 5) phase5(p, bid, nb, smem);
    if (MODE == 6) phase6(p, bid, nb, smem);
    if (MODE == 7) phase7(p, bid, nb);
  }
}

extern "C" void kernel_launch(void* const* d_in, const int* in_sizes, int n_in, void* d_out, int out_size, void* d_ws,
                              size_t ws_size, hipStream_t stream) {
  if (ws_size < WS_END) { fprintf(stderr, "workspace too small: %zu < %zu\n", ws_size, (size_t)WS_END); return; }
  static int grid = 0;
  if (grid == 0) {
    int dev = 0, cus = 0, per_cu = 0;
    hipGetDevice(&dev);
    hipDeviceGetAttribute(&cus, hipDeviceAttributeMultiprocessorCount, dev);
    hipOccupancyMaxActiveBlocksPerMultiprocessor(&per_cu, (const void*)mega<-1>, 256, 0);
    if (per_cu > 2) per_cu = 2;
    if (per_cu < 1 || cus < 1) { fprintf(stderr, "occupancy query failed (%d, %d)\n", cus, per_cu); grid = -1; return; }
    grid = cus * per_cu;
  }
  if (grid < 0) return;
  Params p{};
  const float** f = (const float**)&p;
  for (int i = 0; i < 23; ++i) f[i] = (const float*)d_in[i];
  p.out = (float*)d_out;
  p.ws = (char*)d_ws;
  hipMemsetAsync((char*)d_ws + WS_BAR, 0, XCD_BAR_WORDS * 4, stream);
  void* args[] = {&p};
  hipError_t e = hipLaunchCooperativeKernel((const void*)mega<-1>, dim3(grid), dim3(256), args, 0, stream);
  if (e != hipSuccess) fprintf(stderr, "cooperative launch failed: %s (grid %d)\n", hipGetErrorString(e), grid);
}
```

```cpp
#include <hip/hip_runtime.h>
#include <hip/hip_bf16.h>
#include <cstdio>
#include <cstdint>

typedef __attribute__((ext_vector_type(8))) short bf16x8;
typedef __attribute__((ext_vector_type(4))) float f32x4;
typedef unsigned short u16;
#ifndef PROBE_DUP
#define PROBE_DUP -1
#endif

constexpr int DM = 1024, NP = 16384, NS = 1024, NT = 17408, SEQ = 2048;
constexpr int DIN = 3592, DPJ = 3584;
constexpr int C_GLUA = 0, C_GLUB = 512, C_GATE = 1024, C_QKV = 1536, C_Z = 3072;
constexpr float EPS = 1e-6f;

constexpr int NF_P = 52, NF_S = 17;
constexpr size_t FRAG_P_BYTES = (size_t)NF_P * 1024, FRAG_S_BYTES = (size_t)NF_S * 1024;
constexpr size_t UF_P_BYTES = 32 * 1024, UF_S_BYTES = 8 * 1024;

constexpr size_t al256(size_t x) { return (x + 255) & ~(size_t)255; }
constexpr size_t WS_X = 0;
constexpr size_t WS_PROJ = WS_X + (size_t)NT * 1024 * 2;
constexpr size_t WS_FRAG = WS_PROJ + (size_t)NT * DPJ * 2;
constexpr size_t FRAG_TOTAL = 1024 * FRAG_P_BYTES + 512 * FRAG_S_BYTES;
constexpr size_t WS_OMIX = WS_FRAG;
constexpr size_t WS_X2B = WS_PROJ;
constexpr size_t WS_PL = WS_FRAG + (size_t)NT * 512 * 2;
constexpr size_t WS_CMIX = WS_FRAG + al256(FRAG_TOTAL);
constexpr size_t WS_WIN = WS_CMIX + (size_t)NT * 512 * 2;
constexpr size_t WS_PW = WS_WIN + (size_t)DPJ * 1024 * 2;
constexpr size_t WS_WOUT = WS_PW + 512 * 512 * 2;
constexpr size_t WS_GATE = WS_WOUT + 1024 * 1024 * 2;
constexpr size_t WS_PPROJ = WS_GATE + 1024 * 1024 * 2;
constexpr size_t WS_R1 = WS_PPROJ + 1024 * 256 * 2;
constexpr size_t WS_AB = WS_R1 + al256((size_t)NT * 4);
constexpr size_t WS_SS2 = WS_AB + (size_t)NT * 8 * 4;
constexpr size_t WS_SS3 = WS_SS2 + al256((size_t)NT * 4);
constexpr size_t WS_GLAST = WS_SS3 + al256((size_t)NT * 4);
constexpr size_t WS_BAR = WS_GLAST + al256(2560 * 4);
constexpr size_t WS_PB2 = WS_BAR + al256(3456 * 4);
constexpr size_t WS_END = WS_PB2 + (size_t)NT * 256 * 2;
constexpr size_t YS_UF = 0;
constexpr size_t YS_CACT = 1024 * UF_P_BYTES + 512 * UF_S_BYTES;
static_assert(YS_CACT + (size_t)NT * 512 * 2 <= (size_t)NT * 1024 * 4, "y scratch overflow");
static_assert(WS_PL + (size_t)NT * 1024 * 2 <= WS_CMIX, "frag alias overflow");

constexpr size_t O_Y = 0;
constexpr size_t O_NCP = (size_t)NT * 1024;
constexpr size_t O_NDP = O_NCP + 8 * 30 * 512;
constexpr size_t O_NSP = O_NDP + 8 * 3 * 1536;
constexpr size_t O_NCS = O_NSP + (size_t)8 * 4 * 128 * 128;
constexpr size_t O_NDS = O_NCS + (size_t)128 * 30 * 512;
constexpr size_t O_NSS = O_NDS + (size_t)128 * 3 * 1536;

struct Params {
  const float *x_prompt, *x_sample, *state_conv, *state_dn_conv, *state_dn_S, *p_prompt, *p_sample;
  const float *norm_mix_g, *w_in, *conv_dw_w, *conv_dw_b, *conv_ln_g, *conv_ln_b, *conv_pw_w;
  const float *dn_conv_w, *dn_a_log, *dn_dt_bias, *dn_norm_g, *w_out, *ple_norm_g, *ple_gate_w, *ple_proj_w, *final_norm_g;
  float* out;
  char* ws;
};

typedef float f32x2_t __attribute__((ext_vector_type(2)));
typedef __bf16 bf16x2_t __attribute__((ext_vector_type(2)));
__device__ __forceinline__ uint32_t pack2(float a, float b) {
  f32x2_t v = {a, b};
  bf16x2_t r = __builtin_convertvector(v, bf16x2_t);
  return __builtin_bit_cast(uint32_t, r);
}
__device__ __forceinline__ u16 f2bf(float f) { return (u16)(pack2(f, f) & 0xffffu); }
__device__ __forceinline__ float bf2f(u16 h) { return __uint_as_float(((uint32_t)h) << 16); }
__device__ __forceinline__ float bflo(uint32_t u) { return __uint_as_float(u << 16); }
__device__ __forceinline__ float bfhi(uint32_t u) { return __uint_as_float(u & 0xffff0000u); }
__device__ __forceinline__ float sigmoidf_(float x) { return __builtin_amdgcn_rcpf(1.f + __expf(-x)); }
__device__ __forceinline__ float siluf_(float x) { return x * __builtin_amdgcn_rcpf(1.f + __expf(-x)); }
__device__ __forceinline__ const float* xrow(const Params& p, int row) {
  return row < NP ? p.x_prompt + (size_t)row * DM : p.x_sample + (size_t)(row - NP) * DM;
}
__device__ __forceinline__ float wave_sum(float v) {
#pragma unroll
  for (int o = 32; o >= 1; o >>= 1) v += __shfl_xor(v, o);
  return v;
}
__device__ __forceinline__ bf16x8 mk8(uint32_t a, uint32_t b, uint32_t c, uint32_t d) {
  union { uint32_t u[4]; bf16x8 v; } t;
  t.u[0] = a; t.u[1] = b; t.u[2] = c; t.u[3] = d;
  return t.v;
}
__device__ __forceinline__ bf16x8 u4_to_b8(uint4 q) { return mk8(q.x, q.y, q.z, q.w); }
#define MFMA(a, b, c) __builtin_amdgcn_mfma_f32_16x16x32_bf16((a), (b), (c), 0, 0, 0)

template <bool DEEP = false, int MH = 4>
__device__ __forceinline__ void gemm128(const u16* __restrict__ A, int lda, const u16* __restrict__ B, int ldb,
                                        int K, char* smem, f32x4 (&acc)[4][4]) {
  const int tid = threadIdx.x, lane = tid & 63, wave = tid >> 6;
  const int wm = wave >> 1, wn = wave & 1, m = lane & 15, g = lane >> 4;
  const int nkt = K >> 6;
  uint4 ra0, ra1, ra2, ra3, rb0, rb1, rb2, rb3;
  uint4 rc0, rc1, rc2, rc3, rd0, rd1, rd2, rd3;
  const int lrow = tid >> 3, lch = tid & 7;
  const u16* gA = A + (size_t)lrow * lda + lch * 8;
  const u16* gB = B + (size_t)lrow * ldb + lch * 8;
  const int soff = lrow * 128 + ((lch ^ (lrow & 7)) << 4);
#define GLOAD(...) GLOAD_I(__VA_ARGS__)
#define SSTORE(...) SSTORE_I(__VA_ARGS__)
#define GLOAD_I(a0_, a1_, a2_, a3_, b0_, b1_, b2_, b3_, kt_)             \
  {                                                                     \
    a0_ = *(const uint4*)(gA + (kt_) * 64);                             \
    a1_ = *(const uint4*)(gA + (size_t)32 * lda + (kt_) * 64);          \
    if (MH == 4) {                                                      \
      a2_ = *(const uint4*)(gA + (size_t)64 * lda + (kt_) * 64);        \
      a3_ = *(const uint4*)(gA + (size_t)96 * lda + (kt_) * 64);        \
    }                                                                   \
    b0_ = *(const uint4*)(gB + (kt_) * 64);                             \
    b1_ = *(const uint4*)(gB + (size_t)32 * ldb + (kt_) * 64);          \
    b2_ = *(const uint4*)(gB + (size_t)64 * ldb + (kt_) * 64);          \
    b3_ = *(const uint4*)(gB + (size_t)96 * ldb + (kt_) * 64);          \
  }
#define SSTORE_I(a0_, a1_, a2_, a3_, b0_, b1_, b2_, b3_, buf_)           \
  {                                                                     \
    char* sa_ = smem + (buf_) * 32768 + soff;                           \
    *(uint4*)(sa_) = a0_;                                               \
    *(uint4*)(sa_ + 4096) = a1_;                                        \
    if (MH == 4) {                                                      \
      *(uint4*)(sa_ + 8192) = a2_;                                      \
      *(uint4*)(sa_ + 12288) = a3_;                                     \
    }                                                                   \
    *(uint4*)(sa_ + 16384) = b0_;                                       \
    *(uint4*)(sa_ + 16384 + 4096) = b1_;                                \
    *(uint4*)(sa_ + 16384 + 8192) = b2_;                                \
    *(uint4*)(sa_ + 16384 + 12288) = b3_;                               \
  }
#define GEMM_COMPUTE(buf_)                                                                   \
  {                                                                                          \
    const char* sa = smem + (buf_) * 32768;                                                  \
    const char* sb = sa + 16384;                                                             \
    _Pragma("unroll") for (int ks = 0; ks < 2; ++ks) {                                       \
      bf16x8 af[4], bfr[4];                                                                  \
      _Pragma("unroll") for (int t = 0; t < 4; ++t) {                                        \
        if (t < MH) {                                                                        \
          int ra_ = wm * (16 * MH) + t * 16 + m;                                             \
          af[t] = *(const bf16x8*)(sa + ra_ * 128 + (((ks * 4 + g) ^ (ra_ & 7)) << 4));      \
        }                                                                                    \
        int rb_ = wn * 64 + t * 16 + m;                                                      \
        bfr[t] = *(const bf16x8*)(sb + rb_ * 128 + (((ks * 4 + g) ^ (rb_ & 7)) << 4));       \
      }                                                                                      \
      _Pragma("unroll") for (int mt = 0; mt < MH; ++mt)                                      \
        _Pragma("unroll") for (int nt = 0; nt < 4; ++nt) acc[mt][nt] = MFMA(bfr[nt], af[mt], acc[mt][nt]); \
    }                                                                                        \
  }
#define SETX ra0, ra1, ra2, ra3, rb0, rb1, rb2, rb3
#define SETY rc0, rc1, rc2, rc3, rd0, rd1, rd2, rd3
  __syncthreads();
  if (DEEP) {
    GLOAD(SETX, 0)
    GLOAD(SETY, 1)
    SSTORE(SETX, 0)
    __syncthreads();
#pragma unroll 1
    for (int kt = 0; kt < nkt; kt += 2) {
      if (kt + 2 < nkt) GLOAD(SETX, kt + 2)
      GEMM_COMPUTE(0)
      SSTORE(SETY, 1)
      __syncthreads();
      if (kt + 3 < nkt) GLOAD(SETY, kt + 3)
      GEMM_COMPUTE(1)
      if (kt + 2 < nkt) SSTORE(SETX, 0)
      __syncthreads();
    }
  } else {
    GLOAD(SETX, 0)
    SSTORE(SETX, 0)
    __syncthreads();
#pragma unroll 1
    for (int kt = 0; kt < nkt; ++kt) {
      if (kt + 1 < nkt) GLOAD(SETX, kt + 1)
      GEMM_COMPUTE(kt & 1)
      if (kt + 1 < nkt) SSTORE(SETX, (kt + 1) & 1)
      __syncthreads();
    }
  }
}
#define GEMM_EPILOGUE_M(acc, m0, n0, MH_, ...)                                             \
  {                                                                                        \
    const int lane_ = threadIdx.x & 63, wave_ = threadIdx.x >> 6;                          \
    const int wm_ = wave_ >> 1, wn_ = wave_ & 1, m_ = lane_ & 15, g_ = lane_ >> 4;         \
    _Pragma("unroll") for (int mt = 0; mt < (MH_); ++mt) {                                 \
      const int row = (m0) + wm_ * (16 * (MH_)) + mt * 16 + m_;                            \
      _Pragma("unroll") for (int nt = 0; nt < 4; ++nt) {                                   \
        const int col = (n0) + wn_ * 64 + (nt >> 1) * 32 + g_ * 8 + (nt & 1) * 4;     \
        f32x4 v = acc[mt][nt];                                                             \
        __VA_ARGS__                                                                        \
      }                                                                                    \
    }                                                                                      \
  }
#define GEMM_EPILOGUE(acc, m0, n0, ...) GEMM_EPILOGUE_M(acc, m0, n0, 4, __VA_ARGS__)

__device__ __forceinline__ void transpose_tile(const float* __restrict__ src, int lds_, const float* __restrict__ gv, u16* __restrict__ dst,
                               int ldd, int k0, int n0, char* smem, bool perm = false) {
  float* t = (float*)smem;
  const int tid = threadIdx.x;
  __syncthreads();
#pragma unroll
  for (int it = 0; it < 4; ++it) {
    int k = (tid >> 4) + it * 16, n = (tid & 15) * 4;
    float4 v = *(const float4*)(src + (size_t)(k0 + k) * lds_ + n0 + n);
    float gg = gv ? gv[k0 + k] : 1.f;
    t[k * 65 + n + 0] = v.x * gg; t[k * 65 + n + 1] = v.y * gg; t[k * 65 + n + 2] = v.z * gg; t[k * 65 + n + 3] = v.w * gg;
  }
  __syncthreads();
#pragma unroll
  for (int it = 0; it < 2; ++it) {
    int n = (tid >> 3) + it * 32, kc = (tid & 7) * 8;
    uint32_t w[4];
#pragma unroll
    for (int e = 0; e < 4; ++e) w[e] = pack2(t[(kc + 2 * e) * 65 + n], t[(kc + 2 * e + 1) * 65 + n]);
    const int j = n & 31;
    const int nd = perm ? ((n & ~31) + 16 * ((j >> 2) & 1) + 4 * (j >> 3) + (j & 3)) : n;
    *(uint4*)(dst + (size_t)(n0 + nd) * ldd + k0 + kc) = make_uint4(w[0], w[1], w[2], w[3]);
  }
}

__device__ __forceinline__ void phase0(const Params& p, int bid, int nb, char* smem) {
  const int tid = threadIdx.x, lane = tid & 63, wave = tid >> 6;
  u16* xb = (u16*)(p.ws + WS_X);
  float* r1 = (float*)(p.ws + WS_R1);
  float* ab = (float*)(p.ws + WS_AB);
  float* ss2 = (float*)(p.ws + WS_SS2);
  float* ss3 = (float*)(p.ws + WS_SS3);
  for (int i = bid * 256 + tid; i < NT; i += nb * 256) { ss2[i] = 0.f; ss3[i] = 0.f; }
  {
    u16* pb = (u16*)(p.ws + WS_PB2);
  for (int i = bid * 256 + tid; i < NT * 32; i += nb * 256) {
    int row = i >> 5, c = (i & 31) * 8;
    const float* pr = row < NP ? p.p_prompt + (size_t)row * 256 : p.p_sample + (size_t)(row - NP) * 256;
    float4 a = *(const float4*)(pr + c), bq = *(const float4*)(pr + c + 4);
    *(uint4*)(pb + (size_t)row * 256 + c) = make_uint4(pack2(a.x, a.y), pack2(a.z, a.w), pack2(bq.x, bq.y), pack2(bq.z, bq.w));
  }
  }
  for (int it = bid; it < 1536; it += nb) {
    if (it < 896) { int kt = it / 56, nt = it % 56; transpose_tile(p.w_in, DIN, p.norm_mix_g, (u16*)(p.ws + WS_WIN), 1024, kt * 64, nt * 64, smem, true); }
    else if (it < 960) { int j = it - 896; transpose_tile(p.conv_pw_w, 512, nullptr, (u16*)(p.ws + WS_PW), 512, (j >> 3) * 64, (j & 7) * 64, smem, true); }
    else if (it < 1216) { int j = it - 960; transpose_tile(p.w_out, 1024, nullptr, (u16*)(p.ws + WS_WOUT), 1024, (j >> 4) * 64, (j & 15) * 64, smem, true); }
    else if (it < 1472) { int j = it - 1216; transpose_tile(p.ple_gate_w, 1024, p.ple_norm_g, (u16*)(p.ws + WS_GATE), 1024, (j >> 4) * 64, (j & 15) * 64, smem, true); }
    else { int j = it - 1472; transpose_tile(p.ple_proj_w, 1024, nullptr, (u16*)(p.ws + WS_PPROJ), 256, (j >> 4) * 64, (j & 15) * 64, smem, true); }
  }
  float* tl = (float*)smem;
  __syncthreads();
#pragma unroll
  for (int it = 0; it < 4; ++it) {
    int k = tid + it * 256;
    const float4* wt = (const float4*)(p.w_in + (size_t)k * DIN + DPJ);
    float4 w0 = wt[0], w1 = wt[1];
    float gg = p.norm_mix_g[k];
    tl[0 * 1024 + k] = w0.x * gg; tl[1 * 1024 + k] = w0.y * gg; tl[2 * 1024 + k] = w0.z * gg; tl[3 * 1024 + k] = w0.w * gg;
    tl[4 * 1024 + k] = w1.x * gg; tl[5 * 1024 + k] = w1.y * gg; tl[6 * 1024 + k] = w1.z * gg; tl[7 * 1024 + k] = w1.w * gg;
  }
  __syncthreads();
  for (int row = bid * 4 + wave; row < NT; row += nb * 4) {
    const float* xr = xrow(p, row);
    float ss = 0.f;
    float d[8] = {0, 0, 0, 0, 0, 0, 0, 0};
#pragma unroll
    for (int it = 0; it < 4; ++it) {
      int k = it * 256 + lane * 4;
      float4 v = *(const float4*)(xr + k);
      ss += v.x * v.x + v.y * v.y + v.z * v.z + v.w * v.w;
      *(uint2*)(xb + (size_t)row * 1024 + k) = make_uint2(pack2(v.x, v.y), pack2(v.z, v.w));
#pragma unroll
      for (int j = 0; j < 8; ++j) {
        float4 w = *(const float4*)(tl + j * 1024 + k);
        d[j] += v.x * w.x + v.y * w.y + v.z * w.z + v.w * w.w;
      }
    }
    ss = wave_sum(ss);
#pragma unroll
    for (int j = 0; j < 8; ++j) d[j] = wave_sum(d[j]);
    float r = rsqrtf(ss * (1.f / 1024.f) + EPS);
    if (lane == 0) {
      r1[row] = r;
      *(float4*)(ab + (size_t)row * 8) = make_float4(d[0] * r, d[1] * r, d[2] * r, d[3] * r);
      *(float4*)(ab + (size_t)row * 8 + 4) = make_float4(d[4] * r, d[5] * r, d[6] * r, d[7] * r);
    }
  }
}

struct TileWalk { int q, step, total, mbase, nN; bool banded; };
__device__ __forceinline__ TileWalk tile_walk(int nN, int bid, int nb) {
  TileWalk w; w.nN = nN;
  if ((nb & 7) == 0) { w.banded = true; w.q = bid >> 3; w.step = nb >> 3; w.total = 17 * nN; w.mbase = 17 * (bid & 7); }
  else { w.banded = false; w.q = bid; w.step = nb; w.total = 136 * nN; w.mbase = 0; }
  return w;
}
__device__ __forceinline__ void tile_get(const TileWalk& w, int q, int& mt, int& nt) {
  if (w.banded) {
    if (q < 9 * w.nN) { mt = w.mbase + q % 9; nt = q / 9; }
    else { int q2 = q - 9 * w.nN; mt = w.mbase + 9 + (q2 & 7); nt = q2 >> 3; }
  } else { mt = q / w.nN; nt = q % w.nN; }
}
__device__ __forceinline__ void phase1(const Params& p, int bid, int nb, char* smem) {
  const u16* xb = (const u16*)(p.ws + WS_X);
  const u16* wt = (const u16*)(p.ws + WS_WIN);
  const float* r1 = (const float*)(p.ws + WS_R1);
  u16* proj = (u16*)(p.ws + WS_PROJ);
  const TileWalk tw = tile_walk(28, bid, nb);
  for (int t = tw.q; t < tw.total; t += tw.step) {
    int mt_, nt_;
    tile_get(tw, t, mt_, nt_);
    int m0 = mt_ * 128, n0 = nt_ * 128;
    f32x4 acc[4][4];
#pragma unroll
    for (int i = 0; i < 4; ++i)
#pragma unroll
      for (int j = 0; j < 4; ++j) acc[i][j] = f32x4{0, 0, 0, 0};
    gemm128(xb + (size_t)m0 * 1024, 1024, wt + (size_t)n0 * 1024, 1024, 1024, smem, acc);
    {
      const int lane_ = threadIdx.x & 63, wave_ = threadIdx.x >> 6;
      const int wm_ = wave_ >> 1, wn_ = wave_ & 1, m_ = lane_ & 15, g_ = lane_ >> 4;
#pragma unroll
      for (int mt = 0; mt < 4; ++mt) {
        const int row = m0 + wm_ * 64 + mt * 16 + m_;
        const float r = r1[row];
#pragma unroll
        for (int k2 = 0; k2 < 2; ++k2) {
          const int col = n0 + wn_ * 64 + 32 * k2 + 8 * g_;
          const f32x4 lo = acc[mt][2 * k2], hi = acc[mt][2 * k2 + 1];
          *(uint4*)(proj + (size_t)row * DPJ + col) =
              make_uint4(pack2(lo[0] * r, lo[1] * r), pack2(lo[2] * r, lo[3] * r), pack2(hi[0] * r, hi[1] * r), pack2(hi[2] * r, hi[3] * r));
        }
      }
    }
  }
}

template <bool SAMPLE>
__device__ __forceinline__ void conv_tile(const Params& p, int item, char* smem) {
  constexpr int NTK = SAMPLE ? 8 : 32;
  const int tid = threadIdx.x, lane = tid & 63, wave = tid >> 6;
  const u16* proj = (const u16*)(p.ws + WS_PROJ);
  u16* cact = (u16*)((char*)p.out + YS_CACT);
  int b, pos0, row0;
  if (SAMPLE) { b = item; pos0 = 0; row0 = NP + b * 8; }
  else { b = item >> 6; pos0 = (item & 63) * 32; row0 = b * SEQ + pos0; }
  float* Y = (float*)smem;
  const float* cw_ = p.conv_dw_w;
  const float* lng_ = p.conv_ln_g;
  const float* lnb_ = p.conv_ln_b;
  const float* cb_ = p.conv_dw_b;
  asm volatile("" : "+s"(cw_), "+s"(lng_), "+s"(lnb_), "+s"(cb_));
  const bool write_tail = SAMPLE || ((item & 63) == 63);
  constexpr int NR = NTK + 30, GR = 16, NG = (NR + GR - 1) / GR;
  __syncthreads();
#pragma unroll 1
  for (int cp = 0; cp < 2; ++cp) {
    const int c0 = tid + cp * 256;
    float w0[31];
#pragma unroll
    for (int j = 0; j < 31; ++j) w0[j] = cw_[j * 512 + c0];
    float a0[NTK];
#pragma unroll
    for (int t = 0; t < NTK; ++t) a0[t] = 0.f;
    uint32_t ca[GR], cb[GR], na[GR], nb2[GR];
#define CONV_LOAD(r_, A_, B_)                                                                   \
  {                                                                                             \
    A_ = 0; B_ = 0;                                                                             \
    if ((r_) < NR) {                                                                            \
      if (SAMPLE && (r_) < 30) {                                                                \
        A_ = __float_as_uint(p.state_conv[((size_t)b * 30 + (r_)) * 512 + c0]);                 \
      } else {                                                                                  \
        int pos_ = pos0 - 30 + (r_);                                                            \
        int pc_ = pos_ < 0 ? 0 : pos_;                                                          \
        size_t prow_ = SAMPLE ? (size_t)(row0 + (r_) - 30) : (size_t)(b * SEQ + pc_);           \
        uint32_t la_ = proj[prow_ * DPJ + C_GLUA + c0];                                         \
        uint32_t lb_ = proj[prow_ * DPJ + C_GLUB + c0];                                         \
        A_ = (!SAMPLE && pos_ < 0) ? 0u : la_;                                                  \
        B_ = (!SAMPLE && pos_ < 0) ? 0u : lb_;                                                  \
      }                                                                                         \
    }                                                                                           \
  }
#pragma unroll
    for (int rr = 0; rr < GR; ++rr) CONV_LOAD(rr, ca[rr], cb[rr])
#pragma unroll
    for (int gq = 0; gq < NG; ++gq) {
      if (gq + 1 < NG) {
#pragma unroll
        for (int rr = 0; rr < GR; ++rr) CONV_LOAD((gq + 1) * GR + rr, na[rr], nb2[rr])
      }
#pragma unroll
      for (int rr = 0; rr < GR; ++rr) {
        const int r = gq * GR + rr;
        if (r < NR) {
          float u0;
          if (SAMPLE && r < 30) u0 = __uint_as_float(ca[rr]);
          else u0 = bf2f((u16)ca[rr]) * sigmoidf_(bf2f((u16)cb[rr]));
          if (SAMPLE) {
            if (r >= 8) p.out[O_NCS + ((size_t)b * 30 + (r - 8)) * 512 + c0] = u0;
          } else {
            if (write_tail && r >= 32) p.out[O_NCP + ((size_t)b * 30 + (r - 32)) * 512 + c0] = u0;
          }
#pragma unroll
          for (int t = 0; t < NTK; ++t) {
            if (r - t >= 0 && r - t <= 30) a0[t] += w0[r - t] * u0;
          }
        }
      }
#pragma unroll
      for (int rr = 0; rr < GR; ++rr) { ca[rr] = na[rr]; cb[rr] = nb2[rr]; }
      __builtin_amdgcn_sched_barrier(0);
    }
    const float bias = cb_[c0];
#pragma unroll
    for (int t = 0; t < NTK; ++t) Y[t * 512 + c0] = a0[t] + bias;
  }
  __syncthreads();
  for (int t = wave; t < NTK; t += 4) {
    float4 v0 = *(const float4*)(Y + t * 512 + lane * 8);
    float4 v1 = *(const float4*)(Y + t * 512 + lane * 8 + 4);
    float xv[8] = {v0.x, v0.y, v0.z, v0.w, v1.x, v1.y, v1.z, v1.w};
    float s = 0.f;
#pragma unroll
    for (int e = 0; e < 8; ++e) s += xv[e];
    float mean = wave_sum(s) * (1.f / 512.f);
    float q = 0.f;
#pragma unroll
    for (int e = 0; e < 8; ++e) { xv[e] -= mean; q += xv[e] * xv[e]; }
    float rstd = rsqrtf(wave_sum(q) * (1.f / 512.f) + EPS);
    float4 g0 = *(const float4*)(lng_ + lane * 8), g1 = *(const float4*)(lng_ + lane * 8 + 4);
    float4 b0 = *(const float4*)(lnb_ + lane * 8), b1 = *(const float4*)(lnb_ + lane * 8 + 4);
    float gg[8] = {g0.x, g0.y, g0.z, g0.w, g1.x, g1.y, g1.z, g1.w};
    float bb[8] = {b0.x, b0.y, b0.z, b0.w, b1.x, b1.y, b1.z, b1.w};
    float o[8];
#pragma unroll
    for (int e = 0; e < 8; ++e) o[e] = siluf_(xv[e] * rstd * gg[e] + bb[e]);
    *(uint4*)(cact + (size_t)(row0 + t) * 512 + lane * 8) =
        make_uint4(pack2(o[0], o[1]), pack2(o[2], o[3]), pack2(o[4], o[5]), pack2(o[6], o[7]));
  }
}

template <bool SAMPLE> __device__ __forceinline__ constexpr int fidx_w(int mt, int ks) { return SAMPLE ? ks : (mt >> 1) * 26 + (mt & 1) * 4 + ks; }
template <bool SAMPLE> __device__ __forceinline__ constexpr int fidx_q(int mt, int ks) { return SAMPLE ? 4 + ks : (mt >> 1) * 26 + 8 + (mt & 1) * 4 + ks; }
template <bool SAMPLE> __device__ __forceinline__ constexpr int fidx_qk(int mt) { return SAMPLE ? 8 : (mt >> 1) * 26 + 16 + (mt & 1); }
template <bool SAMPLE> __device__ __forceinline__ constexpr int fidx_kd(int dt, int hf) { return SAMPLE ? 9 + dt : hf * 26 + 18 + dt; }

template <bool SAMPLE>
__device__ __forceinline__ void delta_prep(const Params& p, int item, char* smem) {
  constexpr int MT = SAMPLE ? 1 : 4, KS2 = SAMPLE ? 1 : 2, NI = SAMPLE ? 8 : 64;
  const int tid = threadIdx.x, lane = tid & 63, wave = tid >> 6, m = lane & 15, g = lane >> 4;
  const u16* proj = (const u16*)(p.ws + WS_PROJ);
  const float* ab = (const float*)(p.ws + WS_AB);
  int b, h, row0, pos0, chunk;
  uint4* fa; float4* uf;
  if (SAMPLE) {
    b = item >> 2; h = item & 3; row0 = NP + b * 8; pos0 = 0; chunk = 1024 + item;
    fa = (uint4*)(p.ws + WS_FRAG + 1024 * FRAG_P_BYTES + (size_t)item * FRAG_S_BYTES);
    uf = (float4*)((char*)p.out + YS_UF + 1024 * UF_P_BYTES + (size_t)item * UF_S_BYTES);
  } else {
    int bh = item >> 5, n = item & 31; b = bh >> 2; h = bh & 3; pos0 = n * 64; row0 = b * SEQ + pos0; chunk = item;
    fa = (uint4*)(p.ws + WS_FRAG + (size_t)item * FRAG_P_BYTES);
    uf = (float4*)((char*)p.out + YS_UF + (size_t)item * UF_P_BYTES);
  }
  u16* KN = (u16*)smem;
  u16* QN = KN + 64 * 136;
  float* AM = (float*)(QN + 64 * 136);
  float* gcs = AM + 64 * 64;
  float* bts = gcs + 64;
  __syncthreads();
  if (wave == 0) {
    int i = lane; float gi = 0.f, bi = 0.f;
    if (i < NI) {
      const float* abr = ab + (size_t)(row0 + i) * 8;
      bi = sigmoidf_(abr[h]);
      float a = abr[4 + h] + p.dn_dt_bias[h];
      float sp = a > 20.f ? a : log1pf(expf(a));
      gi = -expf(p.dn_a_log[h]) * sp;
    }
    float c = gi;
#pragma unroll
    for (int off = 1; off < 64; off <<= 1) { float t = __shfl_up(c, off); if (lane >= off) c += t; }
    if (!SAMPLE) { float c31 = __shfl(c, 31); if (lane >= 32) c -= c31; }
    gcs[i] = c; bts[i] = bi;
  }
  __syncthreads();
  if (!SAMPLE) {
    const int sec = tid >> 7, rh = (tid >> 6) & 1, cp = tid & 63;
    const int col = sec * 512 + h * 128 + 2 * cp;
    u16* dstm = sec ? KN : QN;
    const float2 w0 = *(const float2*)(p.dn_conv_w + col), w1 = *(const float2*)(p.dn_conv_w + 1536 + col);
    const float2 w2 = *(const float2*)(p.dn_conv_w + 2 * 1536 + col), w3 = *(const float2*)(p.dn_conv_w + 3 * 1536 + col);
    const u16* pcol = proj + (size_t)(row0 + 32 * rh) * DPJ + C_QKV + col;
    uint32_t hist[3];
    const bool hv = (pos0 + 32 * rh) > 0;
#pragma unroll
    for (int jj = 0; jj < 3; ++jj) hist[jj] = hv ? *(const uint32_t*)(pcol + (ptrdiff_t)(jj - 3) * DPJ) : 0u;
    uint32_t raw[32];
#pragma unroll
    for (int i = 0; i < 32; ++i) raw[i] = *(const uint32_t*)(pcol + (size_t)i * DPJ);
    uint32_t ra = hist[0], rb = hist[1], rc = hist[2];
#pragma unroll
    for (int i = 0; i < 32; ++i) {
      const uint32_t rd = raw[i];
      const float v0 = siluf_(w0.x * bflo(ra) + w1.x * bflo(rb) + w2.x * bflo(rc) + w3.x * bflo(rd));
      const float v1 = siluf_(w0.y * bfhi(ra) + w1.y * bfhi(rb) + w2.y * bfhi(rc) + w3.y * bfhi(rd));
      *(uint32_t*)(dstm + (32 * rh + i) * 136 + 2 * cp) = pack2(v0, v1);
      ra = rb; rb = rc; rc = rd;
    }
  } else {
    const int sec = tid >> 7, c = tid & 127;
    const int col = sec * 512 + h * 128 + c;
    u16* dstm = sec ? KN : QN;
    const float w0 = p.dn_conv_w[col], w1 = p.dn_conv_w[1536 + col], w2 = p.dn_conv_w[2 * 1536 + col], w3 = p.dn_conv_w[3 * 1536 + col];
    float rr[3];
#pragma unroll
    for (int jj = 0; jj < 3; ++jj) {
      if (SAMPLE) rr[jj] = p.state_dn_conv[((size_t)b * 3 + jj) * 1536 + col];
      else rr[jj] = (pos0 > 0) ? bf2f(proj[(size_t)(row0 - 3 + jj) * DPJ + C_QKV + col]) : 0.f;
    }
    float ra = rr[0], rb = rr[1], rc = rr[2];
    const u16* pcol = proj + (size_t)row0 * DPJ + C_QKV + col;
    u16 raw[NI];
#pragma unroll
    for (int i = 0; i < NI; ++i) raw[i] = pcol[(size_t)i * DPJ];
#pragma unroll
    for (int i = 0; i < NI; ++i) {
      float rd = bf2f(raw[i]);
      float v = siluf_(w0 * ra + w1 * rb + w2 * rc + w3 * rd);
      dstm[i * 136 + c] = f2bf(v);
      ra = rb; rb = rc; rc = rd;
    }
#pragma unroll
    for (int i = NI; i < 64; ++i) dstm[i * 136 + c] = 0;
  }
  __syncthreads();
  {
    const int i = wave * 16 + m;
    const bool valid = i < NI;
    float eq[32], ek[32];
#pragma unroll
    for (int kh = 0; kh < 8; ++kh) {
      const int cc = (kh >> 1) * 32 + (kh & 1) * 16 + 4 * g;
      uint2 kv = *(const uint2*)(KN + i * 136 + cc);
      uint2 qv = *(const uint2*)(QN + i * 136 + cc);
      ek[kh * 4] = bflo(kv.x); ek[kh * 4 + 1] = bfhi(kv.x); ek[kh * 4 + 2] = bflo(kv.y); ek[kh * 4 + 3] = bfhi(kv.y);
      eq[kh * 4] = bflo(qv.x); eq[kh * 4 + 1] = bfhi(qv.x); eq[kh * 4 + 2] = bflo(qv.y); eq[kh * 4 + 3] = bfhi(qv.y);
    }
    float sq = 0.f, sk = 0.f;
#pragma unroll
    for (int e = 0; e < 32; ++e) { sq += eq[e] * eq[e]; sk += ek[e] * ek[e]; }
    sq += __shfl_xor(sq, 16); sq += __shfl_xor(sq, 32);
    sk += __shfl_xor(sk, 16); sk += __shfl_xor(sk, 32);
    const float rq = valid ? rsqrtf(sq + EPS) * 0.08838834764831845f : 0.f;
    const float rk = valid ? rsqrtf(sk + EPS) : 0.f;
#pragma unroll
    for (int e = 0; e < 32; ++e) { eq[e] *= rq; ek[e] *= rk; }
#pragma unroll
    for (int kh = 0; kh < 8; ++kh) {
      const int cc = (kh >> 1) * 32 + (kh & 1) * 16 + 4 * g;
      *(uint2*)(KN + i * 136 + cc) = make_uint2(pack2(ek[kh * 4], ek[kh * 4 + 1]), pack2(ek[kh * 4 + 2], ek[kh * 4 + 3]));
      *(uint2*)(QN + i * 136 + cc) = make_uint2(pack2(eq[kh * 4], eq[kh * 4 + 1]), pack2(eq[kh * 4 + 2], eq[kh * 4 + 3]));
    }
    if (wave < MT) {
      const float ei = __expf(gcs[i]);
#pragma unroll
      for (int ks = 0; ks < 4; ++ks) {
        const int e0 = ks * 8;
        fa[fidx_q<SAMPLE>(wave, ks) * 64 + lane] =
            make_uint4(pack2(eq[e0] * ei, eq[e0 + 1] * ei), pack2(eq[e0 + 2] * ei, eq[e0 + 3] * ei),
                       pack2(eq[e0 + 4] * ei, eq[e0 + 5] * ei), pack2(eq[e0 + 6] * ei, eq[e0 + 7] * ei));
      }
    }
  }
  __syncthreads();
  if (wave < MT) {
    const int it = wave;
    bf16x8 knI[4], qnI[4];
#pragma unroll
    for (int ks = 0; ks < 4; ++ks) {
      knI[ks] = *(const bf16x8*)(KN + (16 * it + m) * 136 + 32 * ks + 8 * g);
      qnI[ks] = *(const bf16x8*)(QN + (16 * it + m) * 136 + 32 * ks + 8 * g);
    }
    f32x4 qkv_[4];
#pragma unroll
    for (int jt = 0; jt < 4; ++jt) qkv_[jt] = f32x4{0, 0, 0, 0};
    const float gi_n = gcs[16 * it + m];
#pragma unroll
    for (int jt = 0; jt < 4; ++jt) {
      if (jt <= it && (SAMPLE || (jt >> 1) == (it >> 1))) {
        bf16x8 knJ[4];
#pragma unroll
        for (int ks = 0; ks < 4; ++ks) knJ[ks] = *(const bf16x8*)(KN + (16 * jt + m) * 136 + 32 * ks + 8 * g);
        f32x4 aa = f32x4{0, 0, 0, 0}, qq = f32x4{0, 0, 0, 0};
#pragma unroll
        for (int ks = 0; ks < 4; ++ks) { aa = MFMA(knI[ks], knJ[ks], aa); qq = MFMA(knJ[ks], qnI[ks], qq); }
        const int jA = 16 * jt + m;
        const float gj = gcs[jA];
#pragma unroll
        for (int r = 0; r < 4; ++r) {
          const int iA = 16 * it + 4 * g + r;
          float val = (jA < iA) ? bts[iA] * __expf(gcs[iA] - gj) * aa[r] : 0.f;
          AM[iA * 64 + jA] = val;
        }
        const int iQ = 16 * it + m;
#pragma unroll
        for (int r = 0; r < 4; ++r) {
          const int jQ = 16 * jt + 4 * g + r;
          qkv_[jt][r] = (jQ <= iQ) ? __expf(gi_n - gcs[jQ]) * qq[r] : 0.f;
        }
      }
    }
    {
      const bool up = !SAMPLE && (it >> 1);
      f32x4 lo = up ? qkv_[2] : qkv_[0], hi = up ? qkv_[3] : qkv_[1];
      fa[fidx_qk<SAMPLE>(it) * 64 + lane] =
          make_uint4(pack2(lo[0], lo[1]), pack2(lo[2], lo[3]), pack2(hi[0], hi[1]), pack2(hi[2], hi[3]));
    }
  }
  {
#pragma unroll
    for (int dd = 0; dd < 2; ++dd) {
      const int dt = 2 * wave + dd;
#pragma unroll
      for (int hf = 0; hf < KS2; ++hf) {
        const float gl = gcs[SAMPLE ? 63 : 32 * hf + 31];
        float vv[8];
#pragma unroll
        for (int e = 0; e < 8; ++e) {
          const int i = 32 * hf + (e >> 2) * 16 + 4 * g + (e & 3);
          vv[e] = bf2f(KN[i * 136 + 16 * dt + m]) * __expf(gl - gcs[i]);
        }
        fa[fidx_kd<SAMPLE>(dt, hf) * 64 + lane] =
            make_uint4(pack2(vv[0], vv[1]), pack2(vv[2], vv[3]), pack2(vv[4], vv[5]), pack2(vv[6], vv[7]));
      }
    }
    if (tid == 0) {
      float* gla = (float*)(p.ws + WS_GLAST);
      if (SAMPLE) gla[2048 + item] = __expf(gcs[63]);
      else { gla[2 * item] = __expf(gcs[31]); gla[2 * item + 1] = __expf(gcs[63]); }
    }
  }
  __syncthreads();
  float x[NI];
  {
  if (tid < 128) {
    const int dv = tid;
    const int col = 1024 + h * 128 + dv;
    const float w0 = p.dn_conv_w[col], w1 = p.dn_conv_w[1536 + col], w2 = p.dn_conv_w[2 * 1536 + col], w3 = p.dn_conv_w[3 * 1536 + col];
    float rr[3];
#pragma unroll
    for (int jj = 0; jj < 3; ++jj) {
      if (SAMPLE) rr[jj] = p.state_dn_conv[((size_t)b * 3 + jj) * 1536 + col];
      else rr[jj] = (pos0 > 0) ? bf2f(proj[(size_t)(row0 - 3 + jj) * DPJ + C_QKV + col]) : 0.f;
    }
    float ra = rr[0], rb = rr[1], rc = rr[2];
    const u16* pcol = proj + (size_t)row0 * DPJ + C_QKV + col;
#pragma unroll
    for (int i = 0; i < NI; ++i) x[i] = bf2f(pcol[(size_t)i * DPJ]);
    __builtin_amdgcn_sched_barrier(0);
#pragma unroll
    for (int i = 0; i < NI; ++i) {
      float rd = x[i];
      float v = siluf_(w0 * ra + w1 * rb + w2 * rc + w3 * rd);
      x[i] = bts[i] * v;
      ra = rb; rb = rc; rc = rd;
    }
  } else {
    const int dk = tid - 128;
#pragma unroll
    for (int i = 0; i < NI; ++i) x[i] = bts[i] * __expf(gcs[i]) * bf2f(KN[i * 136 + dk]);
  }
  {
    constexpr int NSUB = SAMPLE ? 1 : 2, NLI = SAMPLE ? 8 : 32;
#pragma unroll
    for (int hf = 0; hf < NSUB; ++hf) {
      float4 ac[8], an[8];
#pragma unroll
      for (int j4 = 0; j4 < 8; ++j4) { ac[j4] = make_float4(0, 0, 0, 0); an[j4] = make_float4(0, 0, 0, 0); }
      ac[0] = *(const float4*)(AM + (32 * hf + 1) * 64 + 32 * hf);
#pragma unroll
      for (int li = 1; li < NLI; ++li) {
        if (li + 1 < NLI) {
#pragma unroll
          for (int j4 = 0; j4 < 8; ++j4)
            if (j4 < (li + 4) / 4) an[j4] = *(const float4*)(AM + (32 * hf + li + 1) * 64 + 32 * hf + j4 * 4);
        }
        float acc0 = x[32 * hf + li], acc1 = 0.f;
#pragma unroll
        for (int j4 = 0; j4 < 8; ++j4) {
          if (j4 < (li + 3) / 4) {
            float4 a = ac[j4];
            if (j4 * 4 + 0 < li) acc0 -= a.x * x[32 * hf + j4 * 4 + 0];
            if (j4 * 4 + 1 < li) acc1 -= a.y * x[32 * hf + j4 * 4 + 1];
            if (j4 * 4 + 2 < li) acc0 -= a.z * x[32 * hf + j4 * 4 + 2];
            if (j4 * 4 + 3 < li) acc1 -= a.w * x[32 * hf + j4 * 4 + 3];
          }
        }
        x[32 * hf + li] = acc0 + acc1;
#pragma unroll
        for (int j4 = 0; j4 < 8; ++j4) ac[j4] = an[j4];
        __builtin_amdgcn_sched_barrier(0);
      }
    }
  }
  }
  __syncthreads();
  u16* WM = KN;
  if (tid < 128) {
    const int dv = tid, s = dv >> 4, n = dv & 15;
#pragma unroll
    for (int mt = 0; mt < MT; ++mt)
#pragma unroll
      for (int g4 = 0; g4 < 4; ++g4) {
        const int i0 = 16 * mt + 4 * g4;
        float4 o;
        o.x = (i0 + 0 < NI) ? x[(i0 + 0 < NI) ? i0 + 0 : 0] : 0.f;
        o.y = (i0 + 1 < NI) ? x[(i0 + 1 < NI) ? i0 + 1 : 0] : 0.f;
        o.z = (i0 + 2 < NI) ? x[(i0 + 2 < NI) ? i0 + 2 : 0] : 0.f;
        o.w = (i0 + 3 < NI) ? x[(i0 + 3 < NI) ? i0 + 3 : 0] : 0.f;
        uf[(s * MT + mt) * 64 + g4 * 16 + n] = o;
      }
  } else {
    const int dk = tid - 128;
#pragma unroll
    for (int i = 0; i < 16 * MT; ++i) WM[i * 136 + dk] = (i < NI) ? f2bf(-x[(i < NI) ? i : 0]) : (u16)0;
  }
  __syncthreads();
  {
    const int mt = SAMPLE ? 0 : wave;
#pragma unroll
    for (int q = 0; q < (SAMPLE ? 1 : 4); ++q) {
      const int ks = SAMPLE ? wave : q;
      uint2 lo = *(const uint2*)(WM + (16 * mt + m) * 136 + 32 * ks + 4 * g);
      uint2 hi = *(const uint2*)(WM + (16 * mt + m) * 136 + 32 * ks + 16 + 4 * g);
      fa[fidx_w<SAMPLE>(mt, ks) * 64 + lane] = make_uint4(lo.x, lo.y, hi.x, hi.y);
    }
  }
  if (SAMPLE || (item & 31) == 31) {
    float* dst = p.out + (SAMPLE ? O_NDS : O_NDP);
    for (int idx = tid; idx < 3 * 384; idx += 256) {
      int j = idx / 384, cc = idx % 384, sec = cc >> 7, c = cc & 127;
      int col = sec * 512 + h * 128 + c;
      dst[((size_t)b * 3 + j) * 1536 + col] = bf2f(proj[(size_t)(row0 + NI - 3 + j) * DPJ + C_QKV + col]);
    }
  }
}

template <bool SAMPLE>
__device__ __forceinline__ void delta_seq(const Params& p, int item, char* smem) {
  constexpr int MT = SAMPLE ? 1 : 4, KS2 = SAMPLE ? 1 : 2, NI = SAMPLE ? 8 : 64, NC = SAMPLE ? 1 : 32;
  constexpr int NF = MT * 8 + MT * KS2 + 8 * KS2;
  static_assert(SAMPLE, "prompt chains use delta_seq_p");
  constexpr int W_OFF = 0, Q_OFF = MT * 4, QK_OFF = MT * 8, KD_OFF = MT * 8 + MT * KS2;
  constexpr int NPRE = (NF * 64 + 255) / 256;
  const int tid = threadIdx.x, lane = tid & 63, wave = tid >> 6, n = lane & 15, g = lane >> 4;
  const int bh = item >> 1, half = item & 1, b = bh >> 2, h = bh & 3;
  const int s = half * 4 + wave;
  const float* glast = (const float*)(p.ws + WS_GLAST);
  u16* ofp = (u16*)(p.ws + WS_X);
  const uint4* fa0; const float4* uf0; int chunk0, row00;
  if (SAMPLE) {
    fa0 = (const uint4*)(p.ws + WS_FRAG + 1024 * FRAG_P_BYTES + (size_t)bh * FRAG_S_BYTES);
    uf0 = (const float4*)((char*)p.out + YS_UF + 1024 * UF_P_BYTES + (size_t)bh * UF_S_BYTES);
    chunk0 = 2048 + bh; row00 = NP + b * 8;
  } else {
    fa0 = (const uint4*)(p.ws + WS_FRAG + (size_t)bh * 32 * FRAG_P_BYTES);
    uf0 = (const float4*)((char*)p.out + YS_UF + (size_t)bh * 32 * UF_P_BYTES);
    chunk0 = bh * 32; row00 = b * SEQ;
  }
  constexpr size_t FSTR = (SAMPLE ? FRAG_S_BYTES : FRAG_P_BYTES) / 16, USTR = (SAMPLE ? UF_S_BYTES : UF_P_BYTES) / 16;
  uint4* L = (uint4*)smem;
  f32x4 S[8];
  if (SAMPLE) {
    const float* s0 = p.state_dn_S + (size_t)bh * 16384;
#pragma unroll
    for (int dt = 0; dt < 8; ++dt)
#pragma unroll
      for (int r = 0; r < 4; ++r) S[dt][r] = s0[(16 * dt + 4 * g + r) * 128 + 16 * s + n];
  } else {
#pragma unroll
    for (int dt = 0; dt < 8; ++dt) S[dt] = f32x4{0, 0, 0, 0};
  }
  uint4 pre[NPRE];
  f32x4 upre[MT];
  float glpre;
#define SEQ_PREFETCH(c_)                                                                     \
  {                                                                                          \
    const uint4* fa_ = fa0 + (size_t)(c_) * FSTR;                                            \
    _Pragma("unroll") for (int q = 0; q < NPRE; ++q) {                                       \
      int idx = tid + q * 256;                                                               \
      pre[q] = (NF * 64 % 256 == 0 || idx < NF * 64) ? fa_[idx] : make_uint4(0, 0, 0, 0);   \
    }                                                                                        \
    const float4* uf_ = uf0 + (size_t)(c_) * USTR;                                           \
    _Pragma("unroll") for (int mt = 0; mt < MT; ++mt) {                                      \
      float4 t = uf_[(s * MT + mt) * 64 + lane];                                             \
      upre[mt] = f32x4{t.x, t.y, t.z, t.w};                                                  \
    }                                                                                        \
    glpre = glast[chunk0 + (c_)];                                                            \
  }
  SEQ_PREFETCH(0)
#pragma unroll 1
  for (int c = 0; c < NC; ++c) {
    __syncthreads();
#pragma unroll
    for (int q = 0; q < NPRE; ++q) {
      int idx = tid + q * 256;
      if (NF * 64 % 256 == 0 || idx < NF * 64) L[idx] = pre[q];
    }
    f32x4 accV[MT], accO[MT];
#pragma unroll
    for (int mt = 0; mt < MT; ++mt) { accV[mt] = upre[mt]; accO[mt] = f32x4{0, 0, 0, 0}; }
    const float gl = glpre;
    __syncthreads();
    if (c + 1 < NC) SEQ_PREFETCH(c + 1)
    bf16x8 Sb[4];
#pragma unroll
    for (int ks = 0; ks < 4; ++ks)
      Sb[ks] = mk8(pack2(S[2 * ks][0], S[2 * ks][1]), pack2(S[2 * ks][2], S[2 * ks][3]),
                   pack2(S[2 * ks + 1][0], S[2 * ks + 1][1]), pack2(S[2 * ks + 1][2], S[2 * ks + 1][3]));
#pragma unroll
    for (int mt = 0; mt < MT; ++mt)
#pragma unroll
      for (int ks = 0; ks < 4; ++ks) {
        accV[mt] = MFMA(u4_to_b8(L[(W_OFF + mt * 4 + ks) * 64 + lane]), Sb[ks], accV[mt]);
        accO[mt] = MFMA(u4_to_b8(L[(Q_OFF + mt * 4 + ks) * 64 + lane]), Sb[ks], accO[mt]);
        if (ks == 3) __builtin_amdgcn_sched_barrier(0);
      }
    bf16x8 Vb[KS2];
#pragma unroll
    for (int ks2 = 0; ks2 < KS2; ++ks2) {
      f32x4 lo = accV[(2 * ks2 < MT) ? 2 * ks2 : 0];
      f32x4 hi = (2 * ks2 + 1 < MT) ? accV[(2 * ks2 + 1 < MT) ? 2 * ks2 + 1 : 0] : f32x4{0, 0, 0, 0};
      Vb[ks2] = mk8(pack2(lo[0], lo[1]), pack2(lo[2], lo[3]), pack2(hi[0], hi[1]), pack2(hi[2], hi[3]));
    }
#pragma unroll
    for (int mt = 0; mt < MT; ++mt)
#pragma unroll
      for (int ks2 = 0; ks2 < KS2; ++ks2)
        accO[mt] = MFMA(u4_to_b8(L[(QK_OFF + mt * KS2 + ks2) * 64 + lane]), Vb[ks2], accO[mt]);
#pragma unroll
    for (int dt = 0; dt < 8; ++dt) {
      S[dt] = S[dt] * gl;
#pragma unroll
      for (int ks2 = 0; ks2 < KS2; ++ks2)
        S[dt] = MFMA(u4_to_b8(L[(KD_OFF + dt * KS2 + ks2) * 64 + lane]), Vb[ks2], S[dt]);
      if (dt & 1) __builtin_amdgcn_sched_barrier(0);
    }
    const int rowc = row00 + c * 64;
#pragma unroll
    for (int mt = 0; mt < MT; ++mt)
#pragma unroll
      for (int r = 0; r < 4; ++r) {
        const int i = 16 * mt + 4 * g + r;
        if (i < NI) ofp[(size_t)(rowc + i) * 512 + h * 128 + 16 * s + n] = f2bf(accO[mt][r]);
      }
  }
  float* so = p.out + (SAMPLE ? O_NSS : O_NSP) + (size_t)bh * 16384;
#pragma unroll
  for (int dt = 0; dt < 8; ++dt)
#pragma unroll
    for (int r = 0; r < 4; ++r) so[(16 * dt + 4 * g + r) * 128 + 16 * s + n] = S[dt][r];
  __syncthreads();
}


__device__ __forceinline__ void delta_seq_p(const Params& p, int item, char* smem) {
  constexpr int NFH = 26, NH = 64;
  constexpr int W_OFF = 0, Q_OFF = 8, QK_OFF = 16, KD_OFF = 18;
  constexpr int NV = NFH * 64;
  constexpr int NPRE = (NV + 255) / 256;
  const int tid = threadIdx.x, lane = tid & 63, wave = tid >> 6, n = lane & 15, g = lane >> 4;
  const int bh = item >> 1, half = item & 1, b = bh >> 2, h = bh & 3;
  const int s = half * 4 + wave;
  const float* glast = (const float*)(p.ws + WS_GLAST) + (size_t)bh * 64;
  u16* ofp = (u16*)(p.ws + WS_X);
  const uint4* fa0 = (const uint4*)(p.ws + WS_FRAG + (size_t)bh * 32 * FRAG_P_BYTES);
  const float4* uf0 = (const float4*)((char*)p.out + YS_UF + (size_t)bh * 32 * UF_P_BYTES);
  const int row00 = b * SEQ;
  uint4* L = (uint4*)smem;
  f32x4 S[8];
#pragma unroll
  for (int dt = 0; dt < 8; ++dt) S[dt] = f32x4{0, 0, 0, 0};
  uint4 PA[NPRE], PB[NPRE];
  f32x4 UA[2], UB[2];
  float GA = 0.f, GB = 0.f; (void)GA; (void)GB;
  constexpr int TOUCH_AHEAD = 8;
  uint32_t TA = 0, TB = 0, tsink = 0;
#define SEQP_TOUCH(T_, hs_)                                                                     \
  {                                                                                             \
    tsink ^= T_;                                                                                \
    const int ht_ = (hs_) + TOUCH_AHEAD;                                                        \
    if (ht_ < NH) {                                                                             \
      const int c64_ = ht_ >> 1, hf_ = ht_ & 1;                                                 \
      const uint32_t* fl_ = (const uint32_t*)(fa0 + (size_t)c64_ * (FRAG_P_BYTES / 16) + hf_ * NV);  \
      const uint32_t* ul_ = (const uint32_t*)(uf0 + (size_t)c64_ * (UF_P_BYTES / 16));            \
      uint32_t t0_ = (tid < 208) ? fl_[tid * 32] : 0u;                                          \
      uint32_t t1_ = (tid < 64) ? ul_[(((half * 4 + (tid >> 4)) * 4 + 2 * hf_ + ((tid >> 3) & 1)) * 64) * 4 + (tid & 7) * 32] : 0u; \
      T_ = t0_ ^ t1_;                                                                           \
    }                                                                                           \
  }
#define SEQP_LOAD(P_, U_, G_, hs_)                                                              \
  {                                                                                             \
    const int c64_ = (hs_) >> 1, hf_ = (hs_) & 1;                                               \
    const uint4* fa_ = fa0 + (size_t)c64_ * (FRAG_P_BYTES / 16) + hf_ * NV;                     \
    _Pragma("unroll") for (int q = 0; q < NPRE; ++q) {                                          \
      int idx = tid + q * 256;                                                                  \
      P_[q] = (idx < NV) ? fa_[idx] : make_uint4(0, 0, 0, 0);                                   \
    }                                                                                           \
    const float4* uf_ = uf0 + (size_t)c64_ * (UF_P_BYTES / 16);                                 \
    _Pragma("unroll") for (int mt = 0; mt < 2; ++mt) {                                          \
      float4 t = uf_[(s * 4 + 2 * hf_ + mt) * 64 + lane];                                       \
      U_[mt] = f32x4{t.x, t.y, t.z, t.w};                                                       \
    }                                                                                           \
  }
#define SEQP_STEP(P_, U_, G_, T_, hs_, buf_)                                                        \
  {                                                                                             \
    uint4* Lb = L + (buf_) * NV;                                                                \
    _Pragma("unroll") for (int q = 0; q < NPRE; ++q) {                                          \
      int idx = tid + q * 256;                                                                  \
      if (idx < NV) Lb[idx] = P_[q];                                                            \
    }                                                                                           \
    f32x4 accV[2], accO[2];                                                                     \
    accV[0] = U_[0]; accV[1] = U_[1];                                                           \
    accO[0] = f32x4{0, 0, 0, 0}; accO[1] = f32x4{0, 0, 0, 0};                                   \
    __syncthreads();                                                                            \
    const float gl = gls[(hs_)];                                                                \
    if ((hs_) + 2 < NH) SEQP_LOAD(P_, U_, G_, (hs_) + 2)                                        \
    bf16x8 Sb[4];                                                                               \
    _Pragma("unroll") for (int ks = 0; ks < 4; ++ks)                                            \
      Sb[ks] = mk8(pack2(S[2 * ks][0], S[2 * ks][1]), pack2(S[2 * ks][2], S[2 * ks][3]),        \
                   pack2(S[2 * ks + 1][0], S[2 * ks + 1][1]), pack2(S[2 * ks + 1][2], S[2 * ks + 1][3])); \
    _Pragma("unroll") for (int mt = 0; mt < 2; ++mt)                                            \
      _Pragma("unroll") for (int ks = 0; ks < 4; ++ks) {                                        \
        accV[mt] = MFMA(u4_to_b8(Lb[(W_OFF + mt * 4 + ks) * 64 + lane]), Sb[ks], accV[mt]);     \
        accO[mt] = MFMA(u4_to_b8(Lb[(Q_OFF + mt * 4 + ks) * 64 + lane]), Sb[ks], accO[mt]);     \
      }                                                                                         \
    __builtin_amdgcn_sched_barrier(0);                                                          \
    bf16x8 Vb = mk8(pack2(accV[0][0], accV[0][1]), pack2(accV[0][2], accV[0][3]),               \
                    pack2(accV[1][0], accV[1][1]), pack2(accV[1][2], accV[1][3]));              \
    _Pragma("unroll") for (int mt = 0; mt < 2; ++mt)                                            \
      accO[mt] = MFMA(u4_to_b8(Lb[(QK_OFF + mt) * 64 + lane]), Vb, accO[mt]);                   \
    _Pragma("unroll") for (int dt = 0; dt < 8; ++dt) {                                          \
      S[dt] = S[dt] * gl;                                                                       \
      S[dt] = MFMA(u4_to_b8(Lb[(KD_OFF + dt) * 64 + lane]), Vb, S[dt]);                         \
    }                                                                                           \
    const int rowc = row00 + (hs_) * 32;                                                        \
    _Pragma("unroll") for (int mt = 0; mt < 2; ++mt)                                            \
      _Pragma("unroll") for (int r = 0; r < 4; ++r)                                             \
        ofp[(size_t)(rowc + 16 * mt + 4 * g + r) * 512 + h * 128 + 16 * s + n] = f2bf(accO[mt][r]);   \
  }
  __syncthreads();
  float* gls = (float*)(smem + 2 * NV * 16);
  if (tid < 64) gls[tid] = glast[tid];
  SEQP_LOAD(PA, UA, GA, 0)
  SEQP_LOAD(PB, UB, GB, 1)
#pragma unroll 1
  for (int hs = 0; hs < NH; hs += 2) {
    SEQP_STEP(PA, UA, GA, TA, hs, 0)
    SEQP_STEP(PB, UB, GB, TB, hs + 1, 1)
  }
  float* so = p.out + O_NSP + (size_t)bh * 16384;
#pragma unroll
  for (int dt = 0; dt < 8; ++dt)
#pragma unroll
    for (int r = 0; r < 4; ++r) so[(16 * dt + 4 * g + r) * 128 + 16 * s + n] = S[dt][r];
  __syncthreads();
}

template <int MH>
__device__ __forceinline__ void g2_tile(const Params& p, int m0, int n0, char* smem) {
  const u16* cact = (const u16*)((const char*)p.out + YS_CACT);
  const u16* pw = (const u16*)(p.ws + WS_PW);
  const u16* proj = (const u16*)(p.ws + WS_PROJ);
  u16* cmix = (u16*)(p.ws + WS_CMIX);
  f32x4 acc[4][4];
#pragma unroll
  for (int i = 0; i < 4; ++i)
#pragma unroll
    for (int j = 0; j < 4; ++j) acc[i][j] = f32x4{0, 0, 0, 0};
  gemm128<false, MH>(cact + (size_t)m0 * 512, 512, pw + (size_t)n0 * 512, 512, 512, smem, acc);
  uint2 gpre[4][4];
  GEMM_EPILOGUE_M(acc, m0, n0, MH, { (void)v; gpre[mt][nt] = *(const uint2*)(proj + (size_t)row * DPJ + C_GATE + col); })
  GEMM_EPILOGUE_M(acc, m0, n0, MH, {
    uint2 gv = gpre[mt][nt];
    float o0 = v[0] * siluf_(bflo(gv.x)), o1 = v[1] * siluf_(bfhi(gv.x));
    float o2 = v[2] * siluf_(bflo(gv.y)), o3 = v[3] * siluf_(bfhi(gv.y));
    *(uint2*)(cmix + (size_t)row * 512 + col) = make_uint2(pack2(o0, o1), pack2(o2, o3));
  })
}


__device__ __forceinline__ void phase4(const Params& p, int bid, int nb, char* smem) {
  const int nfull4 = (544 / nb) * nb, rem4 = 544 - nfull4;
  const int nhalf4 = (2 * rem4 <= nb) ? 2 * rem4 : 0;
#pragma unroll 1
  for (int it = bid; it < (nhalf4 > 0 ? nfull4 : 544); it += nb) g2_tile<4>(p, (it >> 2) * 128, (it & 3) * 128, smem);
  if (bid < nhalf4) {
    const int it = nfull4 + (bid >> 1);
    g2_tile<2>(p, (it >> 2) * 128 + (bid & 1) * 64, (it & 3) * 128, smem);
  }
  const int tid = threadIdx.x, lane = tid & 63, wave = tid >> 6;
  const u16* ofp = (const u16*)(p.ws + WS_X);
  const u16* proj = (const u16*)(p.ws + WS_PROJ);
  u16* omix = (u16*)(p.ws + WS_OMIX);
  const int nheavy4 = nhalf4 > 0 ? nhalf4 : ((544 > nb && 544 < 2 * nb) ? 544 - nb : 0);
  if (bid < nheavy4) return;
  const int ob = bid - nheavy4, onb = nb - nheavy4;
  for (int row = ob * 4 + wave; row < NT; row += onb * 4) {
    const uint4 ov = *(const uint4*)(ofp + (size_t)row * 512 + lane * 8);
    float o[8] = {bflo(ov.x), bfhi(ov.x), bflo(ov.y), bfhi(ov.y), bflo(ov.z), bfhi(ov.z), bflo(ov.w), bfhi(ov.w)};
    float ss = 0.f;
#pragma unroll
    for (int e = 0; e < 8; ++e) ss += o[e] * o[e];
    ss += __shfl_xor(ss, 1); ss += __shfl_xor(ss, 2); ss += __shfl_xor(ss, 4); ss += __shfl_xor(ss, 8);
    float r = rsqrtf(ss * (1.f / 128.f) + EPS);
    uint4 zv = *(const uint4*)(proj + (size_t)row * DPJ + C_Z + lane * 8);
    float z[8] = {bflo(zv.x), bfhi(zv.x), bflo(zv.y), bfhi(zv.y), bflo(zv.z), bfhi(zv.z), bflo(zv.w), bfhi(zv.w)};
    float4 g0 = *(const float4*)(p.dn_norm_g + (lane & 15) * 8), g1 = *(const float4*)(p.dn_norm_g + (lane & 15) * 8 + 4);
    float gg[8] = {g0.x, g0.y, g0.z, g0.w, g1.x, g1.y, g1.z, g1.w};
    float y[8];
#pragma unroll
    for (int e = 0; e < 8; ++e) y[e] = o[e] * r * gg[e] * siluf_(z[e]);
    *(uint4*)(omix + (size_t)row * 512 + lane * 8) = make_uint4(pack2(y[0], y[1]), pack2(y[2], y[3]), pack2(y[4], y[5]), pack2(y[6], y[7]));
  }
}

__device__ __forceinline__ void ple_tile(const Params& p, int t, char* smem) {
  const u16* pb = (const u16*)(p.ws + WS_PB2);
  const u16* pp = (const u16*)(p.ws + WS_PPROJ);
  u16* pl = (u16*)(p.ws + WS_PL);
  int m0 = (t >> 3) * 128, n0 = (t & 7) * 128;
  f32x4 acc[4][4];
#pragma unroll
  for (int i = 0; i < 4; ++i)
#pragma unroll
    for (int j = 0; j < 4; ++j) acc[i][j] = f32x4{0, 0, 0, 0};
  gemm128<false>(pb + (size_t)m0 * 256, 256, pp + (size_t)n0 * 256, 256, 256, smem, acc);
  GEMM_EPILOGUE(acc, m0, n0, {
    *(uint2*)(pl + (size_t)row * 1024 + col) = make_uint2(pack2(v[0], v[1]), pack2(v[2], v[3]));
  })
}

template <int MH>
__device__ __forceinline__ void g3_unit(const Params& p, int m0, int n0, char* smem, bool do_atomic) {
  const u16* cmix = (const u16*)(p.ws + WS_CMIX);
  const u16* omix = (const u16*)(p.ws + WS_OMIX);
  const u16* wo = (const u16*)(p.ws + WS_WOUT);
  u16* x1b = (u16*)(p.ws + WS_X);
  float* ss2 = (float*)(p.ws + WS_SS2);
  float* y = p.out + O_Y;
  f32x4 acc[4][4];
#pragma unroll
  for (int i = 0; i < 4; ++i)
#pragma unroll
    for (int j = 0; j < 4; ++j) acc[i][j] = f32x4{0, 0, 0, 0};
  gemm128<false, MH>(cmix + (size_t)m0 * 512, 512, wo + (size_t)n0 * 1024, 1024, 512, smem, acc);
  gemm128<false, MH>(omix + (size_t)m0 * 512, 512, wo + (size_t)n0 * 1024 + 512, 1024, 512, smem, acc);
  float rs[4] = {0, 0, 0, 0};
  float4 xpre[4][4];
  GEMM_EPILOGUE_M(acc, m0, n0, MH, { (void)v; xpre[mt][nt] = *(const float4*)(xrow(p, row) + col); })
  GEMM_EPILOGUE_M(acc, m0, n0, MH, {
    float4 xv = xpre[mt][nt];
    float o0 = xv.x + v[0], o1 = xv.y + v[1], o2 = xv.z + v[2], o3 = xv.w + v[3];
    *(uint2*)(x1b + (size_t)row * 1024 + col) = make_uint2(pack2(o0, o1), pack2(o2, o3));
    rs[mt] += o0 * o0 + o1 * o1 + o2 * o2 + o3 * o3;
  })
  {
    const int lane = threadIdx.x & 63, wave = threadIdx.x >> 6;
#pragma unroll
    for (int mt = 0; mt < MH; ++mt) {
      float sq = rs[mt];
      sq += __shfl_xor(sq, 16); sq += __shfl_xor(sq, 32);
      if (lane < 16 && do_atomic) atomicAdd(&ss2[m0 + (wave >> 1) * (16 * MH) + mt * 16 + lane], sq);
    }
  }
}

template <int MH>
__device__ __forceinline__ void g4_unit(const Params& p, int m0, int n0, char* smem, bool do_atomic) {
  const u16* x1b = (const u16*)(p.ws + WS_X);
  const u16* pl = (const u16*)(p.ws + WS_PL);
  const u16* gt = (const u16*)(p.ws + WS_GATE);
  const float* ss2 = (const float*)(p.ws + WS_SS2);
  float* ss3 = (float*)(p.ws + WS_SS3);
  const float* y = p.out + O_Y;
  u16* x2b = (u16*)(p.ws + WS_X2B);
  f32x4 acc[4][4];
#pragma unroll
  for (int i = 0; i < 4; ++i)
#pragma unroll
    for (int j = 0; j < 4; ++j) acc[i][j] = f32x4{0, 0, 0, 0};
  gemm128<false, MH>(x1b + (size_t)m0 * 1024, 1024, gt + (size_t)n0 * 1024, 1024, 1024, smem, acc);
  float rs[4] = {0, 0, 0, 0};
  uint2 ypre[4][4];
  uint2 ppre[4][4];
  float r2pre[4];
  GEMM_EPILOGUE_M(acc, m0, n0, MH, {
    (void)v;
    ypre[mt][nt] = *(const uint2*)(x1b + (size_t)row * 1024 + col);
    ppre[mt][nt] = *(const uint2*)(pl + (size_t)row * 1024 + col);
    if (nt == 0) r2pre[mt] = ss2[row];
  })
  GEMM_EPILOGUE_M(acc, m0, n0, MH, {
    float r2 = rsqrtf(r2pre[mt] * (1.f / 1024.f) + EPS);
    uint2 xv = ypre[mt][nt];
    uint2 pv = ppre[mt][nt];
    float o0 = bflo(xv.x) + sigmoidf_(v[0] * r2) * bflo(pv.x), o1 = bfhi(xv.x) + sigmoidf_(v[1] * r2) * bfhi(pv.x);
    float o2 = bflo(xv.y) + sigmoidf_(v[2] * r2) * bflo(pv.y), o3 = bfhi(xv.y) + sigmoidf_(v[3] * r2) * bfhi(pv.y);
    *(uint2*)(x2b + (size_t)row * 1024 + col) = make_uint2(pack2(o0, o1), pack2(o2, o3));
    rs[mt] += o0 * o0 + o1 * o1 + o2 * o2 + o3 * o3;
  })
  {
    const int lane = threadIdx.x & 63, wave = threadIdx.x >> 6;
#pragma unroll
    for (int mt = 0; mt < MH; ++mt) {
      float sq = rs[mt];
      sq += __shfl_xor(sq, 16); sq += __shfl_xor(sq, 32);
      if (lane < 16 && do_atomic) atomicAdd(&ss3[m0 + (wave >> 1) * (16 * MH) + mt * 16 + lane], sq);
    }
  }
}

template <int G>
__device__ __forceinline__ void g34_tiles(const Params& p, int bid, int nb, char* smem, bool do_atomic, bool& heavy, int& nlight, int& lidx) {
  const TileWalk tw = tile_walk(8, bid, nb);
  heavy = false; nlight = nb; lidx = bid;
  if (tw.banded && tw.total > tw.step) {
    const int nfull = (tw.total / tw.step) * tw.step, rem = tw.total - nfull;
#pragma unroll 1
    for (int t = tw.q; t < nfull; t += tw.step) {
      int mt_, nt_;
      tile_get(tw, t, mt_, nt_);
      if (G == 0) g3_unit<4>(p, mt_ * 128, nt_ * 128, smem, do_atomic); else g4_unit<4>(p, mt_ * 128, nt_ * 128, smem, do_atomic);
    }
    const int nhalf = 2 * rem <= tw.step ? 2 * rem : 0;
    if (nhalf > 0) {
      if (tw.q < nhalf) {
        int mt_, nt_;
        tile_get(tw, nfull + (tw.q >> 1), mt_, nt_);
        const int m0 = mt_ * 128 + (tw.q & 1) * 64;
        if (G == 0) g3_unit<2>(p, m0, nt_ * 128, smem, do_atomic); else g4_unit<2>(p, m0, nt_ * 128, smem, do_atomic);
        heavy = true;
      }
      nlight = (tw.step - nhalf) * 8; lidx = (tw.q - nhalf) * 8 + (bid & 7);
    } else {
#pragma unroll 1
      for (int t = nfull + tw.q; t < tw.total; t += tw.step) {
        int mt_, nt_;
        tile_get(tw, t, mt_, nt_);
        if (G == 0) g3_unit<4>(p, mt_ * 128, nt_ * 128, smem, do_atomic); else g4_unit<4>(p, mt_ * 128, nt_ * 128, smem, do_atomic);
      }
    }
  } else {
#pragma unroll 1
    for (int t = tw.q; t < tw.total; t += tw.step) {
      int mt_, nt_;
      tile_get(tw, t, mt_, nt_);
      if (G == 0) g3_unit<4>(p, mt_ * 128, nt_ * 128, smem, do_atomic); else g4_unit<4>(p, mt_ * 128, nt_ * 128, smem, do_atomic);
    }
  }
}
__device__ __forceinline__ void phase5(const Params& p, int bid, int nb, char* smem, bool do_atomic = true) {
  bool heavy; int nlight, lidx;
  g34_tiles<0>(p, bid, nb, smem, do_atomic, heavy, nlight, lidx);
  if (do_atomic && !heavy) {
#pragma unroll 1
    for (int it = lidx; it < 1088; it += nlight) ple_tile(p, it, smem);
  }
}
__device__ __forceinline__ void phase6(const Params& p, int bid, int nb, char* smem, bool do_atomic = true) {
  bool heavy; int nlight, lidx;
  g34_tiles<1>(p, bid, nb, smem, do_atomic, heavy, nlight, lidx);
}

__device__ __forceinline__ void phase7(const Params& p, int bid, int nb) {
  const int tid = threadIdx.x;
  const float* ss3 = (const float*)(p.ws + WS_SS3);
  const u16* x2b = (const u16*)(p.ws + WS_X2B);
  float* y = p.out + O_Y;
  for (size_t i = (size_t)bid * 256 + tid; i < (size_t)NT * 128; i += (size_t)nb * 256) {
    const int row = (int)(i >> 7), c = (int)(i & 127) * 8;
    const float r = rsqrtf(ss3[row] * (1.f / 1024.f) + EPS);
    const uint4 v = *(const uint4*)(x2b + (size_t)row * 1024 + c);
    const float4 g0 = *(const float4*)(p.final_norm_g + c), g1 = *(const float4*)(p.final_norm_g + c + 4);
    *(float4*)(y + (size_t)row * 1024 + c) = make_float4(bflo(v.x) * r * g0.x, bfhi(v.x) * r * g0.y, bflo(v.y) * r * g0.z, bfhi(v.y) * r * g0.w);
    *(float4*)(y + (size_t)row * 1024 + c + 4) = make_float4(bflo(v.z) * r * g1.x, bfhi(v.z) * r * g1.y, bflo(v.w) * r * g1.z, bfhi(v.w) * r * g1.w);
  }
}

__device__ __forceinline__ void phase2(const Params& p, int bid, int nb, char* smem) {
#pragma unroll 1
  for (int it = bid; it < 1024; it += nb) delta_prep<false>(p, it, smem);
}
__device__ __forceinline__ void phase3(const Params& p, int bid, int nb, char* smem) {
  if (nb >= 128) {
    if (bid < 64) { delta_seq_p(p, bid, smem); return; }
    bid -= 64; nb -= 64;
  } else {
    for (int it = bid; it < 64; it += nb) delta_seq_p(p, it, smem);
  }
#pragma unroll 1
  for (int it = bid; it < 512; it += nb) conv_tile<false>(p, it, smem);
#pragma unroll 1
  for (int it = nb - 1 - bid; it < 128; it += nb) conv_tile<true>(p, it, smem);
#pragma unroll 1
  for (int it = bid; it < 512; it += nb) {
    delta_prep<true>(p, it, smem);
    __threadfence_block();
    __syncthreads();
#pragma unroll 1
    for (int hf = 0; hf < 2; ++hf) delta_seq<true>(p, 2 * it + hf, smem);
  }
}

#define XB_TMO      128
#define XB_XCNT(j)  (256  + 64 * (j))
#define XB_XSUB(j)  (1280 + 64 * (j))
#define XB_XGEN(j)  (2304 + 64 * (j))
#define XB_TOP      3328
#define XB_TOPGEN   3392
#define XCD_BAR_WORDS 3456
#define XB_SPIN_CAP (1u << 22)
__device__ __forceinline__ unsigned xb_ld(unsigned* p) { return __hip_atomic_load(p, __ATOMIC_RELAXED, __HIP_MEMORY_SCOPE_AGENT); }
__device__ __forceinline__ unsigned xb_add(unsigned* p, unsigned v) { return __hip_atomic_fetch_add(p, v, __ATOMIC_RELAXED, __HIP_MEMORY_SCOPE_AGENT); }
__device__ __forceinline__ unsigned xb_xcc_id() { return (unsigned)__builtin_amdgcn_s_getreg((3 << 11) | 20) & 0xFu; }
#define XB_SPIN(cond, bar) do { unsigned _sp = 0; while (cond) { __builtin_amdgcn_s_sleep(1); \
    if ((++_sp & 255u) == 0u) { if (xb_ld(&(bar)[XB_TMO])) break; if (_sp > XB_SPIN_CAP) { atomicAdd(&(bar)[XB_TMO], 1u); break; } } } } while (0)
struct XcdBarrier { unsigned* bar; unsigned x; unsigned nloc; unsigned nx; };
__device__ __forceinline__ void xcd_barrier_complete(unsigned* bar, unsigned x, unsigned& nloc, unsigned& nx) {
  const unsigned G = gridDim.x;
  unsigned sum, cnt, mine, sp = 0u;
  for (;;) {
    sum = 0u; cnt = 0u; mine = 0u;
#pragma unroll
    for (unsigned j = 0; j < 16; ++j) { const unsigned c = xb_ld(&bar[XB_XCNT(j)]); sum += c; cnt += (c > 0u) ? 1u : 0u; mine = (j == x) ? c : mine; }
    if (sum == G) break;
    __builtin_amdgcn_s_sleep(1);
    if ((++sp & 255u) == 0u) { if (xb_ld(&bar[XB_TMO])) break; if (sp > XB_SPIN_CAP) { atomicAdd(&bar[XB_TMO], 1u); break; } }
  }
  nloc = mine > 0u ? mine : 1u; nx = cnt > 0u ? cnt : 1u;
}
__device__ __forceinline__ void xcd_barrier(XcdBarrier& b) {
  asm volatile("s_waitcnt vmcnt(0)" ::: "memory");
  __syncthreads();
  if (threadIdx.x == 0) {
    unsigned* bar = b.bar;
    __builtin_amdgcn_s_waitcnt(0);
    if (b.nloc == 0u) xcd_barrier_complete(bar, b.x, b.nloc, b.nx);
    const unsigned nloc = b.nloc, nx = b.nx;
    const unsigned old = xb_add(&bar[XB_XSUB(b.x)], 1u);
    const unsigned gen = old / nloc;
    if (old + 1u == (gen + 1u) * nloc) {
      __builtin_amdgcn_fence(__ATOMIC_RELEASE, "agent");
      asm volatile("s_waitcnt vmcnt(0)" ::: "memory");
      const unsigned og = xb_add(&bar[XB_TOP], 1u);
      const unsigned tg = og / nx;
      if (og + 1u == (tg + 1u) * nx) xb_add(&bar[XB_TOPGEN], 1u);
      else XB_SPIN(xb_ld(&bar[XB_TOPGEN]) == tg, bar);
      __builtin_amdgcn_fence(__ATOMIC_ACQUIRE, "agent");
      xb_add(&bar[XB_XGEN(b.x)], 1u);
      asm volatile("s_waitcnt vmcnt(0)" ::: "memory");
    } else {
      XB_SPIN(xb_ld(&bar[XB_XGEN(b.x)]) == gen, bar);
      __builtin_amdgcn_fence(__ATOMIC_ACQUIRE, "agent");
      asm volatile("s_waitcnt vmcnt(0)" ::: "memory");
    }
  }
  __syncthreads();
}

template <int MODE>
__global__ void __launch_bounds__(256, 2) mega(Params p) {
  __shared__ __attribute__((aligned(16))) char smem[65536];
  const int bid = blockIdx.x, nb = gridDim.x;
  if (MODE < 0) {
    XcdBarrier gb;
    gb.bar = (unsigned*)(p.ws + WS_BAR); gb.x = xb_xcc_id(); gb.nloc = 0u; gb.nx = 0u;
    if (threadIdx.x == 0) (void)xb_add(&gb.bar[XB_XCNT(gb.x)], 1u);
    phase0(p, bid, nb, smem); xcd_barrier(gb);
    if (PROBE_DUP == 0) { phase0(p, bid, nb, smem); xcd_barrier(gb); }
    phase1(p, bid, nb, smem); xcd_barrier(gb);
    if (PROBE_DUP == 1) { phase1(p, bid, nb, smem); xcd_barrier(gb); }
    phase2(p, bid, nb, smem); xcd_barrier(gb);
    if (PROBE_DUP == 2) { phase2(p, bid, nb, smem); xcd_barrier(gb); }
    phase3(p, bid, nb, smem); xcd_barrier(gb);
    if (PROBE_DUP == 3) { phase3(p, bid, nb, smem); xcd_barrier(gb); }
    phase4(p, bid, nb, smem); xcd_barrier(gb);
    if (PROBE_DUP == 4) { phase4(p, bid, nb, smem); xcd_barrier(gb); }
    if (PROBE_DUP == 11) { phase5(p, bid, nb, smem, false); xcd_barrier(gb); }
    phase5(p, bid, nb, smem); xcd_barrier(gb);
    phase6(p, bid, nb, smem); xcd_barrier(gb);
    phase7(p, bid, nb);
  } else {
    if (MODE == 0) phase0(p, bid, nb, smem);
    if (MODE == 1) phase1(p, bid, nb, smem);
    if (MODE == 2) phase2(p, bid, nb, smem);
    if (MODE == 3) phase3(p, bid, nb, smem);
    if (MODE == 4) phase4(p, bid, nb, smem);
    if (MODE == 5) phase5(p, bid, nb, smem);
    if (MODE == 6) phase6(p, bid, nb, smem);
    if (MODE == 7) phase7(p, bid, nb);
  }
}

extern "C" void kernel_launch(void* const* d_in, const int* in_sizes, int n_in, void* d_out, int out_size, void* d_ws,
                              size_t ws_size, hipStream_t stream) {
  if (ws_size < WS_END) { fprintf(stderr, "workspace too small: %zu < %zu\n", ws_size, (size_t)WS_END); return; }
  static int grid = 0;
  if (grid == 0) {
    int dev = 0, cus = 0, per_cu = 0;
    hipGetDevice(&dev);
    hipDeviceGetAttribute(&cus, hipDeviceAttributeMultiprocessorCount, dev);
    hipOccupancyMaxActiveBlocksPerMultiprocessor(&per_cu, (const void*)mega<-1>, 256, 0);
    if (per_cu > 2) per_cu = 2;
    if (per_cu < 1 || cus < 1) { fprintf(stderr, "occupancy query failed (%d, %d)\n", cus, per_cu); grid = -1; return; }
    grid = cus * per_cu;
  }
  if (grid < 0) return;
  Params p{};
  const float** f = (const float**)&p;
  for (int i = 0; i < 23; ++i) f[i] = (const float*)d_in[i];
  p.out = (float*)d_out;
  p.ws = (char*)d_ws;
  hipMemsetAsync((char*)d_ws + WS_BAR, 0, XCD_BAR_WORDS * 4, stream);
  void* args[] = {&p};
  hipError_t e = hipLaunchCooperativeKernel((const void*)mega<-1>, dim3(grid), dim3(256), args, 0, stream);
  if (e != hipSuccess) fprintf(stderr, "cooperative launch failed: %s (grid %d)\n", hipGetErrorString(e), grid);
}
```

```cpp
#include <hip/hip_runtime.h>
#include <hip/hip_bf16.h>
#include <cstdio>
#include <cstdint>

typedef __attribute__((ext_vector_type(8))) short bf16x8;
typedef __attribute__((ext_vector_type(4))) float f32x4;
typedef unsigned short u16;
#ifndef PROBE_DUP
#define PROBE_DUP -1
#endif

constexpr int DM = 1024, NP = 16384, NS = 1024, NT = 17408, SEQ = 2048;
constexpr int DIN = 3592, DPJ = 3584;
constexpr int C_GLUA = 0, C_GLUB = 512, C_GATE = 1024, C_QKV = 1536, C_Z = 3072;
constexpr float EPS = 1e-6f;

constexpr int NF_P = 52, NF_S = 17;
constexpr size_t FRAG_P_BYTES = (size_t)NF_P * 1024, FRAG_S_BYTES = (size_t)NF_S * 1024;
constexpr size_t UF_P_BYTES = 32 * 1024, UF_S_BYTES = 8 * 1024;

constexpr size_t al256(size_t x) { return (x + 255) & ~(size_t)255; }
constexpr size_t WS_X = 0;
constexpr size_t WS_PROJ = WS_X + (size_t)NT * 1024 * 2;
constexpr size_t WS_FRAG = WS_PROJ + (size_t)NT * DPJ * 2;
constexpr size_t FRAG_TOTAL = 1024 * FRAG_P_BYTES + 512 * FRAG_S_BYTES;
constexpr size_t WS_OMIX = WS_FRAG;
constexpr size_t WS_X2B = WS_PROJ;
constexpr size_t WS_PL = WS_FRAG + (size_t)NT * 512 * 2;
constexpr size_t WS_CMIX = WS_FRAG + al256(FRAG_TOTAL);
constexpr size_t WS_WIN = WS_CMIX + (size_t)NT * 512 * 2;
constexpr size_t WS_PW = WS_WIN + (size_t)DPJ * 1024 * 2;
constexpr size_t WS_WOUT = WS_PW + 512 * 512 * 2;
constexpr size_t WS_GATE = WS_WOUT + 1024 * 1024 * 2;
constexpr size_t WS_PPROJ = WS_GATE + 1024 * 1024 * 2;
constexpr size_t WS_R1 = WS_PPROJ + 1024 * 256 * 2;
constexpr size_t WS_AB = WS_R1 + al256((size_t)NT * 4);
constexpr size_t WS_SS2 = WS_AB + (size_t)NT * 8 * 4;
constexpr size_t WS_SS3 = WS_SS2 + al256((size_t)NT * 4);
constexpr size_t WS_GLAST = WS_SS3 + al256((size_t)NT * 4);
constexpr size_t WS_BAR = WS_GLAST + al256(2560 * 4);
constexpr size_t WS_PB2 = WS_BAR + al256(3456 * 4);
constexpr size_t WS_END = WS_PB2 + (size_t)NT * 256 * 2;
constexpr size_t YS_UF = 0;
constexpr size_t YS_CACT = 1024 * UF_P_BYTES + 512 * UF_S_BYTES;
static_assert(YS_CACT + (size_t)NT * 512 * 2 <= (size_t)NT * 1024 * 4, "y scratch overflow");
static_assert(WS_PL + (size_t)NT * 1024 * 2 <= WS_CMIX, "frag alias overflow");

constexpr size_t O_Y = 0;
constexpr size_t O_NCP = (size_t)NT * 1024;
constexpr size_t O_NDP = O_NCP + 8 * 30 * 512;
constexpr size_t O_NSP = O_NDP + 8 * 3 * 1536;
constexpr size_t O_NCS = O_NSP + (size_t)8 * 4 * 128 * 128;
constexpr size_t O_NDS = O_NCS + (size_t)128 * 30 * 512;
constexpr size_t O_NSS = O_NDS + (size_t)128 * 3 * 1536;

struct Params {
  const float *x_prompt, *x_sample, *state_conv, *state_dn_conv, *state_dn_S, *p_prompt, *p_sample;
  const float *norm_mix_g, *w_in, *conv_dw_w, *conv_dw_b, *conv_ln_g, *conv_ln_b, *conv_pw_w;
  const float *dn_conv_w, *dn_a_log, *dn_dt_bias, *dn_norm_g, *w_out, *ple_norm_g, *ple_gate_w, *ple_proj_w, *final_norm_g;
  float* out;
  char* ws;
};

typedef float f32x2_t __attribute__((ext_vector_type(2)));
typedef __bf16 bf16x2_t __attribute__((ext_vector_type(2)));
__device__ __forceinline__ uint32_t pack2(float a, float b) {
  f32x2_t v = {a, b};
  bf16x2_t r = __builtin_convertvector(v, bf16x2_t);
  return __builtin_bit_cast(uint32_t, r);
}
__device__ __forceinline__ u16 f2bf(float f) { return (u16)(pack2(f, f) & 0xffffu); }
__device__ __forceinline__ float bf2f(u16 h) { return __uint_as_float(((uint32_t)h) << 16); }
__device__ __forceinline__ float bflo(uint32_t u) { return __uint_as_float(u << 16); }
__device__ __forceinline__ float bfhi(uint32_t u) { return __uint_as_float(u & 0xffff0000u); }
__device__ __forceinline__ float sigmoidf_(float x) { return __builtin_amdgcn_rcpf(1.f + __expf(-x)); }
__device__ __forceinline__ float siluf_(float x) { return x * __builtin_amdgcn_rcpf(1.f + __expf(-x)); }
__device__ __forceinline__ const float* xrow(const Params& p, int row) {
  return row < NP ? p.x_prompt + (size_t)row * DM : p.x_sample + (size_t)(row - NP) * DM;
}
__device__ __forceinline__ float wave_sum(float v) {
#pragma unroll
  for (int o = 32; o >= 1; o >>= 1) v += __shfl_xor(v, o);
  return v;
}
__device__ __forceinline__ bf16x8 mk8(uint32_t a, uint32_t b, uint32_t c, uint32_t d) {
  union { uint32_t u[4]; bf16x8 v; } t;
  t.u[0] = a; t.u[1] = b; t.u[2] = c; t.u[3] = d;
  return t.v;
}
__device__ __forceinline__ bf16x8 u4_to_b8(uint4 q) { return mk8(q.x, q.y, q.z, q.w); }
#define MFMA(a, b, c) __builtin_amdgcn_mfma_f32_16x16x32_bf16((a), (b), (c), 0, 0, 0)

template <bool DEEP = false, int MH = 4>
__device__ __forceinline__ void gemm128(const u16* __restrict__ A, int lda, const u16* __restrict__ B, int ldb,
                                        int K, char* smem, f32x4 (&acc)[4][4]) {
  const int tid = threadIdx.x, lane = tid & 63, wave = tid >> 6;
  const int wm = wave >> 1, wn = wave & 1, m = lane & 15, g = lane >> 4;
  const int nkt = K >> 6;
  uint4 ra0, ra1, ra2, ra3, rb0, rb1, rb2, rb3;
  uint4 rc0, rc1, rc2, rc3, rd0, rd1, rd2, rd3;
  const int lrow = tid >> 3, lch = tid & 7;
  const u16* gA = A + (size_t)lrow * lda + lch * 8;
  const u16* gB = B + (size_t)lrow * ldb + lch * 8;
  const int soff = lrow * 128 + ((lch ^ (lrow & 7)) << 4);
#define GLOAD(...) GLOAD_I(__VA_ARGS__)
#define SSTORE(...) SSTORE_I(__VA_ARGS__)
#define GLOAD_I(a0_, a1_, a2_, a3_, b0_, b1_, b2_, b3_, kt_)             \
  {                                                                     \
    a0_ = *(const uint4*)(gA + (kt_) * 64);                             \
    a1_ = *(const uint4*)(gA + (size_t)32 * lda + (kt_) * 64);          \
    if (MH == 4) {                                                      \
      a2_ = *(const uint4*)(gA + (size_t)64 * lda + (kt_) * 64);        \
      a3_ = *(const uint4*)(gA + (size_t)96 * lda + (kt_) * 64);        \
    }                                                                   \
    b0_ = *(const uint4*)(gB + (kt_) * 64);                             \
    b1_ = *(const uint4*)(gB + (size_t)32 * ldb + (kt_) * 64);          \
    b2_ = *(const uint4*)(gB + (size_t)64 * ldb + (kt_) * 64);          \
    b3_ = *(const uint4*)(gB + (size_t)96 * ldb + (kt_) * 64);          \
  }
#define SSTORE_I(a0_, a1_, a2_, a3_, b0_, b1_, b2_, b3_, buf_)           \
  {                                                                     \
    char* sa_ = smem + (buf_) * 32768 + soff;                           \
    *(uint4*)(sa_) = a0_;                                               \
    *(uint4*)(sa_ + 4096) = a1_;                                        \
    if (MH == 4) {                                                      \
      *(uint4*)(sa_ + 8192) = a2_;                                      \
      *(uint4*)(sa_ + 12288) = a3_;                                     \
    }                                                                   \
    *(uint4*)(sa_ + 16384) = b0_;                                       \
    *(uint4*)(sa_ + 16384 + 4096) = b1_;                                \
    *(uint4*)(sa_ + 16384 + 8192) = b2_;                                \
    *(uint4*)(sa_ + 16384 + 12288) = b3_;                               \
  }
#define GEMM_COMPUTE(buf_)                                                                   \
  {                                                                                          \
    const char* sa = smem + (buf_) * 32768;                                                  \
    const char* sb = sa + 16384;                                                             \
    _Pragma("unroll") for (int ks = 0; ks < 2; ++ks) {                                       \
      bf16x8 af[4], bfr[4];                                                                  \
      _Pragma("unroll") for (int t = 0; t < 4; ++t) {                                        \
        if (t < MH) {                                                                        \
          int ra_ = wm * (16 * MH) + t * 16 + m;                                             \
          af[t] = *(const bf16x8*)(sa + ra_ * 128 + (((ks * 4 + g) ^ (ra_ & 7)) << 4));      \
        }                                                                                    \
        int rb_ = wn * 64 + t * 16 + m;                                                      \
        bfr[t] = *(const bf16x8*)(sb + rb_ * 128 + (((ks * 4 + g) ^ (rb_ & 7)) << 4));       \
      }                                                                                      \
      _Pragma("unroll") for (int mt = 0; mt < MH; ++mt)                                      \
        _Pragma("unroll") for (int nt = 0; nt < 4; ++nt) acc[mt][nt] = MFMA(bfr[nt], af[mt], acc[mt][nt]); \
    }                                                                                        \
  }
#define SETX ra0, ra1, ra2, ra3, rb0, rb1, rb2, rb3
#define SETY rc0, rc1, rc2, rc3, rd0, rd1, rd2, rd3
  __syncthreads();
  if (DEEP) {
    GLOAD(SETX, 0)
    GLOAD(SETY, 1)
    SSTORE(SETX, 0)
    __syncthreads();
#pragma unroll 1
    for (int kt = 0; kt < nkt; kt += 2) {
      if (kt + 2 < nkt) GLOAD(SETX, kt + 2)
      GEMM_COMPUTE(0)
      SSTORE(SETY, 1)
      __syncthreads();
      if (kt + 3 < nkt) GLOAD(SETY, kt + 3)
      GEMM_COMPUTE(1)
      if (kt + 2 < nkt) SSTORE(SETX, 0)
      __syncthreads();
    }
  } else {
    GLOAD(SETX, 0)
    SSTORE(SETX, 0)
    __syncthreads();
#pragma unroll 1
    for (int kt = 0; kt < nkt; ++kt) {
      if (kt + 1 < nkt) GLOAD(SETX, kt + 1)
      GEMM_COMPUTE(kt & 1)
      if (kt + 1 < nkt) SSTORE(SETX, (kt + 1) & 1)
      __syncthreads();
    }
  }
}
#define GEMM_EPILOGUE_M(acc, m0, n0, MH_, ...)                                             \
  {                                                                                        \
    const int lane_ = threadIdx.x & 63, wave_ = threadIdx.x >> 6;                          \
    const int wm_ = wave_ >> 1, wn_ = wave_ & 1, m_ = lane_ & 15, g_ = lane_ >> 4;         \
    _Pragma("unroll") for (int mt = 0; mt < (MH_); ++mt) {                                 \
      const int row = (m0) + wm_ * (16 * (MH_)) + mt * 16 + m_;                            \
      _Pragma("unroll") for (int nt = 0; nt < 4; ++nt) {                                   \
        const int col = (n0) + wn_ * 64 + (nt >> 1) * 32 + g_ * 8 + (nt & 1) * 4;     \
        f32x4 v = acc[mt][nt];                                                             \
        __VA_ARGS__                                                                        \
      }                                                                                    \
    }                                                                                      \
  }
#define GEMM_EPILOGUE(acc, m0, n0, ...) GEMM_EPILOGUE_M(acc, m0, n0, 4, __VA_ARGS__)

__device__ __forceinline__ void transpose_tile(const float* __restrict__ src, int lds_, const float* __restrict__ gv, u16* __restrict__ dst,
                               int ldd, int k0, int n0, char* smem, bool perm = false) {
  float* t = (float*)smem;
  const int tid = threadIdx.x;
  __syncthreads();
#pragma unroll
  for (int it = 0; it < 4; ++it) {
    int k = (tid >> 4) + it * 16, n = (tid & 15) * 4;
    float4 v = *(const float4*)(src + (size_t)(k0 + k) * lds_ + n0 + n);
    float gg = gv ? gv[k0 + k] : 1.f;
    t[k * 65 + n + 0] = v.x * gg; t[k * 65 + n + 1] = v.y * gg; t[k * 65 + n + 2] = v.z * gg; t[k * 65 + n + 3] = v.w * gg;
  }
  __syncthreads();
#pragma unroll
  for (int it = 0; it < 2; ++it) {
    int n = (tid >> 3) + it * 32, kc = (tid & 7) * 8;
    uint32_t w[4];
#pragma unroll
    for (int e = 0; e < 4; ++e) w[e] = pack2(t[(kc + 2 * e) * 65 + n], t[(kc + 2 * e + 1) * 65 + n]);
    const int j = n & 31;
    const int nd = perm ? ((n & ~31) + 16 * ((j >> 2) & 1) + 4 * (j >> 3) + (j & 3)) : n;
    *(uint4*)(dst + (size_t)(n0 + nd) * ldd + k0 + kc) = make_uint4(w[0], w[1], w[2], w[3]);
  }
}

__device__ __forceinline__ void phase0(const Params& p, int bid, int nb, char* smem) {
  const int tid = threadIdx.x, lane = tid & 63, wave = tid >> 6;
  u16* xb = (u16*)(p.ws + WS_X);
  float* r1 = (float*)(p.ws + WS_R1);
  float* ab = (float*)(p.ws + WS_AB);
  float* ss2 = (float*)(p.ws + WS_SS2);
  float* ss3 = (float*)(p.ws + WS_SS3);
  for (int i = bid * 256 + tid; i < NT; i += nb * 256) { ss2[i] = 0.f; ss3[i] = 0.f; }
  {
    u16* pb = (u16*)(p.ws + WS_PB2);
  for (int i = bid * 256 + tid; i < NT * 32; i += nb * 256) {
    int row = i >> 5, c = (i & 31) * 8;
    const float* pr = row < NP ? p.p_prompt + (size_t)row * 256 : p.p_sample + (size_t)(row - NP) * 256;
    float4 a = *(const float4*)(pr + c), bq = *(const float4*)(pr + c + 4);
    *(uint4*)(pb + (size_t)row * 256 + c) = make_uint4(pack2(a.x, a.y), pack2(a.z, a.w), pack2(bq.x, bq.y), pack2(bq.z, bq.w));
  }
  }
  for (int it = bid; it < 1536; it += nb) {
    if (it < 896) { int kt = it / 56, nt = it % 56; transpose_tile(p.w_in, DIN, p.norm_mix_g, (u16*)(p.ws + WS_WIN), 1024, kt * 64, nt * 64, smem, true); }
    else if (it < 960) { int j = it - 896; transpose_tile(p.conv_pw_w, 512, nullptr, (u16*)(p.ws + WS_PW), 512, (j >> 3) * 64, (j & 7) * 64, smem, true); }
    else if (it < 1216) { int j = it - 960; transpose_tile(p.w_out, 1024, nullptr, (u16*)(p.ws + WS_WOUT), 1024, (j >> 4) * 64, (j & 15) * 64, smem, true); }
    else if (it < 1472) { int j = it - 1216; transpose_tile(p.ple_gate_w, 1024, p.ple_norm_g, (u16*)(p.ws + WS_GATE), 1024, (j >> 4) * 64, (j & 15) * 64, smem, true); }
    else { int j = it - 1472; transpose_tile(p.ple_proj_w, 1024, nullptr, (u16*)(p.ws + WS_PPROJ), 256, (j >> 4) * 64, (j & 15) * 64, smem, true); }
  }
  float* tl = (float*)smem;
  __syncthreads();
#pragma unroll
  for (int it = 0; it < 4; ++it) {
    int k = tid + it * 256;
    const float4* wt = (const float4*)(p.w_in + (size_t)k * DIN + DPJ);
    float4 w0 = wt[0], w1 = wt[1];
    float gg = p.norm_mix_g[k];
    tl[0 * 1024 + k] = w0.x * gg; tl[1 * 1024 + k] = w0.y * gg; tl[2 * 1024 + k] = w0.z * gg; tl[3 * 1024 + k] = w0.w * gg;
    tl[4 * 1024 + k] = w1.x * gg; tl[5 * 1024 + k] = w1.y * gg; tl[6 * 1024 + k] = w1.z * gg; tl[7 * 1024 + k] = w1.w * gg;
  }
  __syncthreads();
  for (int row = bid * 4 + wave; row < NT; row += nb * 4) {
    const float* xr = xrow(p, row);
    float ss = 0.f;
    float d[8] = {0, 0, 0, 0, 0, 0, 0, 0};
#pragma unroll
    for (int it = 0; it < 4; ++it) {
      int k = it * 256 + lane * 4;
      float4 v = *(const float4*)(xr + k);
      ss += v.x * v.x + v.y * v.y + v.z * v.z + v.w * v.w;
      *(uint2*)(xb + (size_t)row * 1024 + k) = make_uint2(pack2(v.x, v.y), pack2(v.z, v.w));
#pragma unroll
      for (int j = 0; j < 8; ++j) {
        float4 w = *(const float4*)(tl + j * 1024 + k);
        d[j] += v.x * w.x + v.y * w.y + v.z * w.z + v.w * w.w;
      }
    }
    ss = wave_sum(ss);
#pragma unroll
    for (int j = 0; j < 8; ++j) d[j] = wave_sum(d[j]);
    float r = rsqrtf(ss * (1.f / 1024.f) + EPS);
    if (lane == 0) {
      r1[row] = r;
      *(float4*)(ab + (size_t)row * 8) = make_float4(d[0] * r, d[1] * r, d[2] * r, d[3] * r);
      *(float4*)(ab + (size_t)row * 8 + 4) = make_float4(d[4] * r, d[5] * r, d[6] * r, d[7] * r);
    }
  }
}

struct TileWalk { int q, step, total, mbase, nN; bool banded; };
__device__ __forceinline__ TileWalk tile_walk(int nN, int bid, int nb) {
  TileWalk w; w.nN = nN;
  if ((nb & 7) == 0) { w.banded = true; w.q = bid >> 3; w.step = nb >> 3; w.total = 17 * nN; w.mbase = 17 * (bid & 7); }
  else { w.banded = false; w.q = bid; w.step = nb; w.total = 136 * nN; w.mbase = 0; }
  return w;
}
__device__ __forceinline__ void tile_get(const TileWalk& w, int q, int& mt, int& nt) {
  if (w.banded) {
    if (q < 9 * w.nN) { mt = w.mbase + q % 9; nt = q / 9; }
    else { int q2 = q - 9 * w.nN; mt = w.mbase + 9 + (q2 & 7); nt = q2 >> 3; }
  } else { mt = q / w.nN; nt = q % w.nN; }
}
__device__ __forceinline__ void phase1(const Params& p, int bid, int nb, char* smem) {
  const u16* xb = (const u16*)(p.ws + WS_X);
  const u16* wt = (const u16*)(p.ws + WS_WIN);
  const float* r1 = (const float*)(p.ws + WS_R1);
  u16* proj = (u16*)(p.ws + WS_PROJ);
  const TileWalk tw = tile_walk(28, bid, nb);
  for (int t = tw.q; t < tw.total; t += tw.step) {
    int mt_, nt_;
    tile_get(tw, t, mt_, nt_);
    int m0 = mt_ * 128, n0 = nt_ * 128;
    f32x4 acc[4][4];
#pragma unroll
    for (int i = 0; i < 4; ++i)
#pragma unroll
      for (int j = 0; j < 4; ++j) acc[i][j] = f32x4{0, 0, 0, 0};
    gemm128(xb + (size_t)m0 * 1024, 1024, wt + (size_t)n0 * 1024, 1024, 1024, smem, acc);
    {
      const int lane_ = threadIdx.x & 63, wave_ = threadIdx.x >> 6;
      const int wm_ = wave_ >> 1, wn_ = wave_ & 1, m_ = lane_ & 15, g_ = lane_ >> 4;
#pragma unroll
      for (int mt = 0; mt < 4; ++mt) {
        const int row = m0 + wm_ * 64 + mt * 16 + m_;
        const float r = r1[row];
#pragma unroll
        for (int k2 = 0; k2 < 2; ++k2) {
          const int col = n0 + wn_ * 64 + 32 * k2 + 8 * g_;
          const f32x4 lo = acc[mt][2 * k2], hi = acc[mt][2 * k2 + 1];
          *(uint4*)(proj + (size_t)row * DPJ + col) =
              make_uint4(pack2(lo[0] * r, lo[1] * r), pack2(lo[2] * r, lo[3] * r), pack2(hi[0] * r, hi[1] * r), pack2(hi[2] * r, hi[3] * r));
        }
      }
    }
  }
}

template <bool SAMPLE>
__device__ __forceinline__ void conv_tile(const Params& p, int item, char* smem) {
  constexpr int NTK = SAMPLE ? 8 : 32;
  const int tid = threadIdx.x, lane = tid & 63, wave = tid >> 6;
  const u16* proj = (const u16*)(p.ws + WS_PROJ);
  u16* cact = (u16*)((char*)p.out + YS_CACT);
  int b, pos0, row0;
  if (SAMPLE) { b = item; pos0 = 0; row0 = NP + b * 8; }
  else { b = item >> 6; pos0 = (item & 63) * 32; row0 = b * SEQ + pos0; }
  float* Y = (float*)smem;
  const float* cw_ = p.conv_dw_w;
  const float* lng_ = p.conv_ln_g;
  const float* lnb_ = p.conv_ln_b;
  const float* cb_ = p.conv_dw_b;
  asm volatile("" : "+s"(cw_), "+s"(lng_), "+s"(lnb_), "+s"(cb_));
  const bool write_tail = SAMPLE || ((item & 63) == 63);
  constexpr int NR = NTK + 30, GR = 16, NG = (NR + GR - 1) / GR;
  __syncthreads();
#pragma unroll 1
  for (int cp = 0; cp < 2; ++cp) {
    const int c0 = tid + cp * 256;
    float w0[31];
#pragma unroll
    for (int j = 0; j < 31; ++j) w0[j] = cw_[j * 512 + c0];
    float a0[NTK];
#pragma unroll
    for (int t = 0; t < NTK; ++t) a0[t] = 0.f;
    uint32_t ca[GR], cb[GR], na[GR], nb2[GR];
#define CONV_LOAD(r_, A_, B_)                                                                   \
  {                                                                                             \
    A_ = 0; B_ = 0;                                                                             \
    if ((r_) < NR) {                                                                            \
      if (SAMPLE && (r_) < 30) {                                                                \
        A_ = __float_as_uint(p.state_conv[((size_t)b * 30 + (r_)) * 512 + c0]);                 \
      } else {                                                                                  \
        int pos_ = pos0 - 30 + (r_);                                                            \
        int pc_ = pos_ < 0 ? 0 : pos_;                                                          \
        size_t prow_ = SAMPLE ? (size_t)(row0 + (r_) - 30) : (size_t)(b * SEQ + pc_);           \
        uint32_t la_ = proj[prow_ * DPJ + C_GLUA + c0];                                         \
        uint32_t lb_ = proj[prow_ * DPJ + C_GLUB + c0];                                         \
        A_ = (!SAMPLE && pos_ < 0) ? 0u : la_;                                                  \
        B_ = (!SAMPLE && pos_ < 0) ? 0u : lb_;                                                  \
      }                                                                                         \
    }                                                                                           \
  }
#pragma unroll
    for (int rr = 0; rr < GR; ++rr) CONV_LOAD(rr, ca[rr], cb[rr])
#pragma unroll
    for (int gq = 0; gq < NG; ++gq) {
      if (gq + 1 < NG) {
#pragma unroll
        for (int rr = 0; rr < GR; ++rr) CONV_LOAD((gq + 1) * GR + rr, na[rr], nb2[rr])
      }
#pragma unroll
      for (int rr = 0; rr < GR; ++rr) {
        const int r = gq * GR + rr;
        if (r < NR) {
          float u0;
          if (SAMPLE && r < 30) u0 = __uint_as_float(ca[rr]);
          else u0 = bf2f((u16)ca[rr]) * sigmoidf_(bf2f((u16)cb[rr]));
          if (SAMPLE) {
            if (r >= 8) p.out[O_NCS + ((size_t)b * 30 + (r - 8)) * 512 + c0] = u0;
          } else {
            if (write_tail && r >= 32) p.out[O_NCP + ((size_t)b * 30 + (r - 32)) * 512 + c0] = u0;
          }
#pragma unroll
          for (int t = 0; t < NTK; ++t) {
            if (r - t >= 0 && r - t <= 30) a0[t] += w0[r - t] * u0;
          }
        }
      }
#pragma unroll
      for (int rr = 0; rr < GR; ++rr) { ca[rr] = na[rr]; cb[rr] = nb2[rr]; }
      __builtin_amdgcn_sched_barrier(0);
    }
    const float bias = cb_[c0];
#pragma unroll
    for (int t = 0; t < NTK; ++t) Y[t * 512 + c0] = a0[t] + bias;
  }
  __syncthreads();
  for (int t = wave; t < NTK; t += 4) {
    float4 v0 = *(const float4*)(Y + t * 512 + lane * 8);
    float4 v1 = *(const float4*)(Y + t * 512 + lane * 8 + 4);
    float xv[8] = {v0.x, v0.y, v0.z, v0.w, v1.x, v1.y, v1.z, v1.w};
    float s = 0.f;
#pragma unroll
    for (int e = 0; e < 8; ++e) s += xv[e];
    float mean = wave_sum(s) * (1.f / 512.f);
    float q = 0.f;
#pragma unroll
    for (int e = 0; e < 8; ++e) { xv[e] -= mean; q += xv[e] * xv[e]; }
    float rstd = rsqrtf(wave_sum(q) * (1.f / 512.f) + EPS);
    float4 g0 = *(const float4*)(lng_ + lane * 8), g1 = *(const float4*)(lng_ + lane * 8 + 4);
    float4 b0 = *(const float4*)(lnb_ + lane * 8), b1 = *(const float4*)(lnb_ + lane * 8 + 4);
    float gg[8] = {g0.x, g0.y, g0.z, g0.w, g1.x, g1.y, g1.z, g1.w};
    float bb[8] = {b0.x, b0.y, b0.z, b0.w, b1.x, b1.y, b1.z, b1.w};
    float o[8];
#pragma unroll
    for (int e = 0; e < 8; ++e) o[e] = siluf_(xv[e] * rstd * gg[e] + bb[e]);
    *(uint4*)(cact + (size_t)(row0 + t) * 512 + lane * 8) =
        make_uint4(pack2(o[0], o[1]), pack2(o[2], o[3]), pack2(o[4], o[5]), pack2(o[6], o[7]));
  }
}

template <bool SAMPLE> __device__ __forceinline__ constexpr int fidx_w(int mt, int ks) { return SAMPLE ? ks : (mt >> 1) * 26 + (mt & 1) * 4 + ks; }
template <bool SAMPLE> __device__ __forceinline__ constexpr int fidx_q(int mt, int ks) { return SAMPLE ? 4 + ks : (mt >> 1) * 26 + 8 + (mt & 1) * 4 + ks; }
template <bool SAMPLE> __device__ __forceinline__ constexpr int fidx_qk(int mt) { return SAMPLE ? 8 : (mt >> 1) * 26 + 16 + (mt & 1); }
template <bool SAMPLE> __device__ __forceinline__ constexpr int fidx_kd(int dt, int hf) { return SAMPLE ? 9 + dt : hf * 26 + 18 + dt; }

template <bool SAMPLE>
__device__ __forceinline__ void delta_prep(const Params& p, int item, char* smem) {
  constexpr int MT = SAMPLE ? 1 : 4, KS2 = SAMPLE ? 1 : 2, NI = SAMPLE ? 8 : 64;
  const int tid = threadIdx.x, lane = tid & 63, wave = tid >> 6, m = lane & 15, g = lane >> 4;
  const u16* proj = (const u16*)(p.ws + WS_PROJ);
  const float* ab = (const float*)(p.ws + WS_AB);
  int b, h, row0, pos0, chunk;
  uint4* fa; float4* uf;
  if (SAMPLE) {
    b = item >> 2; h = item & 3; row0 = NP + b * 8; pos0 = 0; chunk = 1024 + item;
    fa = (uint4*)(p.ws + WS_FRAG + 1024 * FRAG_P_BYTES + (size_t)item * FRAG_S_BYTES);
    uf = (float4*)((char*)p.out + YS_UF + 1024 * UF_P_BYTES + (size_t)item * UF_S_BYTES);
  } else {
    int bh = item >> 5, n = item & 31; b = bh >> 2; h = bh & 3; pos0 = n * 64; row0 = b * SEQ + pos0; chunk = item;
    fa = (uint4*)(p.ws + WS_FRAG + (size_t)item * FRAG_P_BYTES);
    uf = (float4*)((char*)p.out + YS_UF + (size_t)item * UF_P_BYTES);
  }
  u16* KN = (u16*)smem;
  u16* QN = KN + 64 * 136;
  float* AM = (float*)(QN + 64 * 136);
  float* gcs = AM + 64 * 64;
  float* bts = gcs + 64;
  __syncthreads();
  if (wave == 0) {
    int i = lane; float gi = 0.f, bi = 0.f;
    if (i < NI) {
      const float* abr = ab + (size_t)(row0 + i) * 8;
      bi = sigmoidf_(abr[h]);
      float a = abr[4 + h] + p.dn_dt_bias[h];
      float sp = a > 20.f ? a : log1pf(expf(a));
      gi = -expf(p.dn_a_log[h]) * sp;
    }
    float c = gi;
#pragma unroll
    for (int off = 1; off < 64; off <<= 1) { float t = __shfl_up(c, off); if (lane >= off) c += t; }
    if (!SAMPLE) { float c31 = __shfl(c, 31); if (lane >= 32) c -= c31; }
    gcs[i] = c; bts[i] = bi;
  }
  __syncthreads();
  if (!SAMPLE) {
    const int sec = tid >> 7, rh = (tid >> 6) & 1, cp = tid & 63;
    const int col = sec * 512 + h * 128 + 2 * cp;
    u16* dstm = sec ? KN : QN;
    const float2 w0 = *(const float2*)(p.dn_conv_w + col), w1 = *(const float2*)(p.dn_conv_w + 1536 + col);
    const float2 w2 = *(const float2*)(p.dn_conv_w + 2 * 1536 + col), w3 = *(const float2*)(p.dn_conv_w + 3 * 1536 + col);
    const u16* pcol = proj + (size_t)(row0 + 32 * rh) * DPJ + C_QKV + col;
    uint32_t hist[3];
    const bool hv = (pos0 + 32 * rh) > 0;
#pragma unroll
    for (int jj = 0; jj < 3; ++jj) hist[jj] = hv ? *(const uint32_t*)(pcol + (ptrdiff_t)(jj - 3) * DPJ) : 0u;
    uint32_t raw[32];
#pragma unroll
    for (int i = 0; i < 32; ++i) raw[i] = *(const uint32_t*)(pcol + (size_t)i * DPJ);
    uint32_t ra = hist[0], rb = hist[1], rc = hist[2];
#pragma unroll
    for (int i = 0; i < 32; ++i) {
      const uint32_t rd = raw[i];
      const float v0 = siluf_(w0.x * bflo(ra) + w1.x * bflo(rb) + w2.x * bflo(rc) + w3.x * bflo(rd));
      const float v1 = siluf_(w0.y * bfhi(ra) + w1.y * bfhi(rb) + w2.y * bfhi(rc) + w3.y * bfhi(rd));
      *(uint32_t*)(dstm + (32 * rh + i) * 136 + 2 * cp) = pack2(v0, v1);
      ra = rb; rb = rc; rc = rd;
    }
  } else {
    const int sec = tid >> 7, c = tid & 127;
    const int col = sec * 512 + h * 128 + c;
    u16* dstm = sec ? KN : QN;
    const float w0 = p.dn_conv_w[col], w1 = p.dn_conv_w[1536 + col], w2 = p.dn_conv_w[2 * 1536 + col], w3 = p.dn_conv_w[3 * 1536 + col];
    float rr[3];
#pragma unroll
    for (int jj = 0; jj < 3; ++jj) {
      if (SAMPLE) rr[jj] = p.state_dn_conv[((size_t)b * 3 + jj) * 1536 + col];
      else rr[jj] = (pos0 > 0) ? bf2f(proj[(size_t)(row0 - 3 + jj) * DPJ + C_QKV + col]) : 0.f;
    }
    float ra = rr[0], rb = rr[1], rc = rr[2];
    const u16* pcol = proj + (size_t)row0 * DPJ + C_QKV + col;
    u16 raw[NI];
#pragma unroll
    for (int i = 0; i < NI; ++i) raw[i] = pcol[(size_t)i * DPJ];
#pragma unroll
    for (int i = 0; i < NI; ++i) {
      float rd = bf2f(raw[i]);
      float v = siluf_(w0 * ra + w1 * rb + w2 * rc + w3 * rd);
      dstm[i * 136 + c] = f2bf(v);
      ra = rb; rb = rc; rc = rd;
    }
#pragma unroll
    for (int i = NI; i < 64; ++i) dstm[i * 136 + c] = 0;
  }
  __syncthreads();
  {
    const int i = wave * 16 + m;
    const bool valid = i < NI;
    float eq[32], ek[32];
#pragma unroll
    for (int kh = 0; kh < 8; ++kh) {
      const int cc = (kh >> 1) * 32 + (kh & 1) * 16 + 4 * g;
      uint2 kv = *(const uint2*)(KN + i * 136 + cc);
      uint2 qv = *(const uint2*)(QN + i * 136 + cc);
      ek[kh * 4] = bflo(kv.x); ek[kh * 4 + 1] = bfhi(kv.x); ek[kh * 4 + 2] = bflo(kv.y); ek[kh * 4 + 3] = bfhi(kv.y);
      eq[kh * 4] = bflo(qv.x); eq[kh * 4 + 1] = bfhi(qv.x); eq[kh * 4 + 2] = bflo(qv.y); eq[kh * 4 + 3] = bfhi(qv.y);
    }
    float sq = 0.f, sk = 0.f;
#pragma unroll
    for (int e = 0; e < 32; ++e) { sq += eq[e] * eq[e]; sk += ek[e] * ek[e]; }
    sq += __shfl_xor(sq, 16); sq += __shfl_xor(sq, 32);
    sk += __shfl_xor(sk, 16); sk += __shfl_xor(sk, 32);
    const float rq = valid ? rsqrtf(sq + EPS) * 0.08838834764831845f : 0.f;
    const float rk = valid ? rsqrtf(sk + EPS) : 0.f;
#pragma unroll
    for (int e = 0; e < 32; ++e) { eq[e] *= rq; ek[e] *= rk; }
#pragma unroll
    for (int kh = 0; kh < 8; ++kh) {
      const int cc = (kh >> 1) * 32 + (kh & 1) * 16 + 4 * g;
      *(uint2*)(KN + i * 136 + cc) = make_uint2(pack2(ek[kh * 4], ek[kh * 4 + 1]), pack2(ek[kh * 4 + 2], ek[kh * 4 + 3]));
      *(uint2*)(QN + i * 136 + cc) = make_uint2(pack2(eq[kh * 4], eq[kh * 4 + 1]), pack2(eq[kh * 4 + 2], eq[kh * 4 + 3]));
    }
    if (wave < MT) {
      const float ei = __expf(gcs[i]);
#pragma unroll
      for (int ks = 0; ks < 4; ++ks) {
        const int e0 = ks * 8;
        fa[fidx_q<SAMPLE>(wave, ks) * 64 + lane] =
            make_uint4(pack2(eq[e0] * ei, eq[e0 + 1] * ei), pack2(eq[e0 + 2] * ei, eq[e0 + 3] * ei),
                       pack2(eq[e0 + 4] * ei, eq[e0 + 5] * ei), pack2(eq[e0 + 6] * ei, eq[e0 + 7] * ei));
      }
    }
  }
  __syncthreads();
  if (wave < MT) {
    const int it = wave;
    bf16x8 knI[4], qnI[4];
#pragma unroll
    for (int ks = 0; ks < 4; ++ks) {
      knI[ks] = *(const bf16x8*)(KN + (16 * it + m) * 136 + 32 * ks + 8 * g);
      qnI[ks] = *(const bf16x8*)(QN + (16 * it + m) * 136 + 32 * ks + 8 * g);
    }
    f32x4 qkv_[4];
#pragma unroll
    for (int jt = 0; jt < 4; ++jt) qkv_[jt] = f32x4{0, 0, 0, 0};
    const float gi_n = gcs[16 * it + m];
#pragma unroll
    for (int jt = 0; jt < 4; ++jt) {
      if (jt <= it && (SAMPLE || (jt >> 1) == (it >> 1))) {
        bf16x8 knJ[4];
#pragma unroll
        for (int ks = 0; ks < 4; ++ks) knJ[ks] = *(const bf16x8*)(KN + (16 * jt + m) * 136 + 32 * ks + 8 * g);
        f32x4 aa = f32x4{0, 0, 0, 0}, qq = f32x4{0, 0, 0, 0};
#pragma unroll
        for (int ks = 0; ks < 4; ++ks) { aa = MFMA(knI[ks], knJ[ks], aa); qq = MFMA(knJ[ks], qnI[ks], qq); }
        const int jA = 16 * jt + m;
        const float gj = gcs[jA];
#pragma unroll
        for (int r = 0; r < 4; ++r) {
          const int iA = 16 * it + 4 * g + r;
          float val = (jA < iA) ? bts[iA] * __expf(gcs[iA] - gj) * aa[r] : 0.f;
          AM[iA * 64 + jA] = val;
        }
        const int iQ = 16 * it + m;
#pragma unroll
        for (int r = 0; r < 4; ++r) {
          const int jQ = 16 * jt + 4 * g + r;
          qkv_[jt][r] = (jQ <= iQ) ? __expf(gi_n - gcs[jQ]) * qq[r] : 0.f;
        }
      }
    }
    {
      const bool up = !SAMPLE && (it >> 1);
      f32x4 lo = up ? qkv_[2] : qkv_[0], hi = up ? qkv_[3] : qkv_[1];
      fa[fidx_qk<SAMPLE>(it) * 64 + lane] =
          make_uint4(pack2(lo[0], lo[1]), pack2(lo[2], lo[3]), pack2(hi[0], hi[1]), pack2(hi[2], hi[3]));
    }
  }
  {
#pragma unroll
    for (int dd = 0; dd < 2; ++dd) {
      const int dt = 2 * wave + dd;
#pragma unroll
      for (int hf = 0; hf < KS2; ++hf) {
        const float gl = gcs[SAMPLE ? 63 : 32 * hf + 31];
        float vv[8];
#pragma unroll
        for (int e = 0; e < 8; ++e) {
          const int i = 32 * hf + (e >> 2) * 16 + 4 * g + (e & 3);
          vv[e] = bf2f(KN[i * 136 + 16 * dt + m]) * __expf(gl - gcs[i]);
        }
        fa[fidx_kd<SAMPLE>(dt, hf) * 64 + lane] =
            make_uint4(pack2(vv[0], vv[1]), pack2(vv[2], vv[3]), pack2(vv[4], vv[5]), pack2(vv[6], vv[7]));
      }
    }
    if (tid == 0) {
      float* gla = (float*)(p.ws + WS_GLAST);
      if (SAMPLE) gla[2048 + item] = __expf(gcs[63]);
      else { gla[2 * item] = __expf(gcs[31]); gla[2 * item + 1] = __expf(gcs[63]); }
    }
  }
  __syncthreads();
  float x[NI];
  {
  if (tid < 128) {
    const int dv = tid;
    const int col = 1024 + h * 128 + dv;
    const float w0 = p.dn_conv_w[col], w1 = p.dn_conv_w[1536 + col], w2 = p.dn_conv_w[2 * 1536 + col], w3 = p.dn_conv_w[3 * 1536 + col];
    float rr[3];
#pragma unroll
    for (int jj = 0; jj < 3; ++jj) {
      if (SAMPLE) rr[jj] = p.state_dn_conv[((size_t)b * 3 + jj) * 1536 + col];
      else rr[jj] = (pos0 > 0) ? bf2f(proj[(size_t)(row0 - 3 + jj) * DPJ + C_QKV + col]) : 0.f;
    }
    float ra = rr[0], rb = rr[1], rc = rr[2];
    const u16* pcol = proj + (size_t)row0 * DPJ + C_QKV + col;
#pragma unroll
    for (int i = 0; i < NI; ++i) x[i] = bf2f(pcol[(size_t)i * DPJ]);
    __builtin_amdgcn_sched_barrier(0);
#pragma unroll
    for (int i = 0; i < NI; ++i) {
      float rd = x[i];
      float v = siluf_(w0 * ra + w1 * rb + w2 * rc + w3 * rd);
      x[i] = bts[i] * v;
      ra = rb; rb = rc; rc = rd;
    }
  } else {
    const int dk = tid - 128;
#pragma unroll
    for (int i = 0; i < NI; ++i) x[i] = bts[i] * __expf(gcs[i]) * bf2f(KN[i * 136 + dk]);
  }
  {
    constexpr int NSUB = SAMPLE ? 1 : 2, NLI = SAMPLE ? 8 : 32;
#pragma unroll
    for (int hf = 0; hf < NSUB; ++hf) {
      float4 ac[8], an[8];
#pragma unroll
      for (int j4 = 0; j4 < 8; ++j4) { ac[j4] = make_float4(0, 0, 0, 0); an[j4] = make_float4(0, 0, 0, 0); }
      ac[0] = *(const float4*)(AM + (32 * hf + 1) * 64 + 32 * hf);
#pragma unroll
      for (int li = 1; li < NLI; ++li) {
        if (li + 1 < NLI) {
#pragma unroll
          for (int j4 = 0; j4 < 8; ++j4)
            if (j4 < (li + 4) / 4) an[j4] = *(const float4*)(AM + (32 * hf + li + 1) * 64 + 32 * hf + j4 * 4);
        }
        float acc0 = x[32 * hf + li], acc1 = 0.f;
#pragma unroll
        for (int j4 = 0; j4 < 8; ++j4) {
          if (j4 < (li + 3) / 4) {
            float4 a = ac[j4];
            if (j4 * 4 + 0 < li) acc0 -= a.x * x[32 * hf + j4 * 4 + 0];
            if (j4 * 4 + 1 < li) acc1 -= a.y * x[32 * hf + j4 * 4 + 1];
            if (j4 * 4 + 2 < li) acc0 -= a.z * x[32 * hf + j4 * 4 + 2];
            if (j4 * 4 + 3 < li) acc1 -= a.w * x[32 * hf + j4 * 4 + 3];
          }
        }
        x[32 * hf + li] = acc0 + acc1;
#pragma unroll
        for (int j4 = 0; j4 < 8; ++j4) ac[j4] = an[j4];
        __builtin_amdgcn_sched_barrier(0);
      }
    }
  }
  }
  __syncthreads();
  u16* WM = KN;
  if (tid < 128) {
    const int dv = tid, s = dv >> 4, n = dv & 15;
#pragma unroll
    for (int mt = 0; mt < MT; ++mt)
#pragma unroll
      for (int g4 = 0; g4 < 4; ++g4) {
        const int i0 = 16 * mt + 4 * g4;
        float4 o;
        o.x = (i0 + 0 < NI) ? x[(i0 + 0 < NI) ? i0 + 0 : 0] : 0.f;
        o.y = (i0 + 1 < NI) ? x[(i0 + 1 < NI) ? i0 + 1 : 0] : 0.f;
        o.z = (i0 + 2 < NI) ? x[(i0 + 2 < NI) ? i0 + 2 : 0] : 0.f;
        o.w = (i0 + 3 < NI) ? x[(i0 + 3 < NI) ? i0 + 3 : 0] : 0.f;
        uf[(s * MT + mt) * 64 + g4 * 16 + n] = o;
      }
  } else {
    const int dk = tid - 128;
#pragma unroll
    for (int i = 0; i < 16 * MT; ++i) WM[i * 136 + dk] = (i < NI) ? f2bf(-x[(i < NI) ? i : 0]) : (u16)0;
  }
  __syncthreads();
  {
    const int mt = SAMPLE ? 0 : wave;
#pragma unroll
    for (int q = 0; q < (SAMPLE ? 1 : 4); ++q) {
      const int ks = SAMPLE ? wave : q;
      uint2 lo = *(const uint2*)(WM + (16 * mt + m) * 136 + 32 * ks + 4 * g);
      uint2 hi = *(const uint2*)(WM + (16 * mt + m) * 136 + 32 * ks + 16 + 4 * g);
      fa[fidx_w<SAMPLE>(mt, ks) * 64 + lane] = make_uint4(lo.x, lo.y, hi.x, hi.y);
    }
  }
  if (SAMPLE || (item & 31) == 31) {
    float* dst = p.out + (SAMPLE ? O_NDS : O_NDP);
    for (int idx = tid; idx < 3 * 384; idx += 256) {
      int j = idx / 384, cc = idx % 384, sec = cc >> 7, c = cc & 127;
      int col = sec * 512 + h * 128 + c;
      dst[((size_t)b * 3 + j) * 1536 + col] = bf2f(proj[(size_t)(row0 + NI - 3 + j) * DPJ + C_QKV + col]);
    }
  }
}

template <bool SAMPLE>
__device__ __forceinline__ void delta_seq(const Params& p, int item, char* smem) {
  constexpr int MT = SAMPLE ? 1 : 4, KS2 = SAMPLE ? 1 : 2, NI = SAMPLE ? 8 : 64, NC = SAMPLE ? 1 : 32;
  constexpr int NF = MT * 8 + MT * KS2 + 8 * KS2;
  static_assert(SAMPLE, "prompt chains use delta_seq_p");
  constexpr int W_OFF = 0, Q_OFF = MT * 4, QK_OFF = MT * 8, KD_OFF = MT * 8 + MT * KS2;
  constexpr int NPRE = (NF * 64 + 255) / 256;
  const int tid = threadIdx.x, lane = tid & 63, wave = tid >> 6, n = lane & 15, g = lane >> 4;
  const int bh = item >> 1, half = item & 1, b = bh >> 2, h = bh & 3;
  const int s = half * 4 + wave;
  const float* glast = (const float*)(p.ws + WS_GLAST);
  u16* ofp = (u16*)(p.ws + WS_X);
  const uint4* fa0; const float4* uf0; int chunk0, row00;
  if (SAMPLE) {
    fa0 = (const uint4*)(p.ws + WS_FRAG + 1024 * FRAG_P_BYTES + (size_t)bh * FRAG_S_BYTES);
    uf0 = (const float4*)((char*)p.out + YS_UF + 1024 * UF_P_BYTES + (size_t)bh * UF_S_BYTES);
    chunk0 = 2048 + bh; row00 = NP + b * 8;
  } else {
    fa0 = (const uint4*)(p.ws + WS_FRAG + (size_t)bh * 32 * FRAG_P_BYTES);
    uf0 = (const float4*)((char*)p.out + YS_UF + (size_t)bh * 32 * UF_P_BYTES);
    chunk0 = bh * 32; row00 = b * SEQ;
  }
  constexpr size_t FSTR = (SAMPLE ? FRAG_S_BYTES : FRAG_P_BYTES) / 16, USTR = (SAMPLE ? UF_S_BYTES : UF_P_BYTES) / 16;
  uint4* L = (uint4*)smem;
  f32x4 S[8];
  if (SAMPLE) {
    const float* s0 = p.state_dn_S + (size_t)bh * 16384;
#pragma unroll
    for (int dt = 0; dt < 8; ++dt)
#pragma unroll
      for (int r = 0; r < 4; ++r) S[dt][r] = s0[(16 * dt + 4 * g + r) * 128 + 16 * s + n];
  } else {
#pragma unroll
    for (int dt = 0; dt < 8; ++dt) S[dt] = f32x4{0, 0, 0, 0};
  }
  uint4 pre[NPRE];
  f32x4 upre[MT];
  float glpre;
#define SEQ_PREFETCH(c_)                                                                     \
  {                                                                                          \
    const uint4* fa_ = fa0 + (size_t)(c_) * FSTR;                                            \
    _Pragma("unroll") for (int q = 0; q < NPRE; ++q) {                                       \
      int idx = tid + q * 256;                                                               \
      pre[q] = (NF * 64 % 256 == 0 || idx < NF * 64) ? fa_[idx] : make_uint4(0, 0, 0, 0);   \
    }                                                                                        \
    const float4* uf_ = uf0 + (size_t)(c_) * USTR;                                           \
    _Pragma("unroll") for (int mt = 0; mt < MT; ++mt) {                                      \
      float4 t = uf_[(s * MT + mt) * 64 + lane];                                             \
      upre[mt] = f32x4{t.x, t.y, t.z, t.w};                                                  \
    }                                                                                        \
    glpre = glast[chunk0 + (c_)];                                                            \
  }
  SEQ_PREFETCH(0)
#pragma unroll 1
  for (int c = 0; c < NC; ++c) {
    __syncthreads();
#pragma unroll
    for (int q = 0; q < NPRE; ++q) {
      int idx = tid + q * 256;
      if (NF * 64 % 256 == 0 || idx < NF * 64) L[idx] = pre[q];
    }
    f32x4 accV[MT], accO[MT];
#pragma unroll
    for (int mt = 0; mt < MT; ++mt) { accV[mt] = upre[mt]; accO[mt] = f32x4{0, 0, 0, 0}; }
    const float gl = glpre;
    __syncthreads();
    if (c + 1 < NC) SEQ_PREFETCH(c + 1)
    bf16x8 Sb[4];
#pragma unroll
    for (int ks = 0; ks < 4; ++ks)
      Sb[ks] = mk8(pack2(S[2 * ks][0], S[2 * ks][1]), pack2(S[2 * ks][2], S[2 * ks][3]),
                   pack2(S[2 * ks + 1][0], S[2 * ks + 1][1]), pack2(S[2 * ks + 1][2], S[2 * ks + 1][3]));
#pragma unroll
    for (int mt = 0; mt < MT; ++mt)
#pragma unroll
      for (int ks = 0; ks < 4; ++ks) {
        accV[mt] = MFMA(u4_to_b8(L[(W_OFF + mt * 4 + ks) * 64 + lane]), Sb[ks], accV[mt]);
        accO[mt] = MFMA(u4_to_b8(L[(Q_OFF + mt * 4 + ks) * 64 + lane]), Sb[ks], accO[mt]);
        if (ks == 3) __builtin_amdgcn_sched_barrier(0);
      }
    bf16x8 Vb[KS2];
#pragma unroll
    for (int ks2 = 0; ks2 < KS2; ++ks2) {
      f32x4 lo = accV[(2 * ks2 < MT) ? 2 * ks2 : 0];
      f32x4 hi = (2 * ks2 + 1 < MT) ? accV[(2 * ks2 + 1 < MT) ? 2 * ks2 + 1 : 0] : f32x4{0, 0, 0, 0};
      Vb[ks2] = mk8(pack2(lo[0], lo[1]), pack2(lo[2], lo[3]), pack2(hi[0], hi[1]), pack2(hi[2], hi[3]));
    }
#pragma unroll
    for (int mt = 0; mt < MT; ++mt)
#pragma unroll
      for (int ks2 = 0; ks2 < KS2; ++ks2)
        accO[mt] = MFMA(u4_to_b8(L[(QK_OFF + mt * KS2 + ks2) * 64 + lane]), Vb[ks2], accO[mt]);
#pragma unroll
    for (int dt = 0; dt < 8; ++dt) {
      S[dt] = S[dt] * gl;
#pragma unroll
      for (int ks2 = 0; ks2 < KS2; ++ks2)
        S[dt] = MFMA(u4_to_b8(L[(KD_OFF + dt * KS2 + ks2) * 64 + lane]), Vb[ks2], S[dt]);
      if (dt & 1) __builtin_amdgcn_sched_barrier(0);
    }
    const int rowc = row00 + c * 64;
#pragma unroll
    for (int mt = 0; mt < MT; ++mt)
#pragma unroll
      for (int r = 0; r < 4; ++r) {
        const int i = 16 * mt + 4 * g + r;
        if (i < NI) ofp[(size_t)(rowc + i) * 512 + h * 128 + 16 * s + n] = f2bf(accO[mt][r]);
      }
  }
  float* so = p.out + (SAMPLE ? O_NSS : O_NSP) + (size_t)bh * 16384;
#pragma unroll
  for (int dt = 0; dt < 8; ++dt)
#pragma unroll
    for (int r = 0; r < 4; ++r) so[(16 * dt + 4 * g + r) * 128 + 16 * s + n] = S[dt][r];
  __syncthreads();
}


__device__ __forceinline__ void delta_seq_p(const Params& p, int item, char* smem) {
  constexpr int NFH = 26, NH = 64;
  constexpr int W_OFF = 0, Q_OFF = 8, QK_OFF = 16, KD_OFF = 18;
  constexpr int NV = NFH * 64;
  constexpr int NPRE = (NV + 255) / 256;
  const int tid = threadIdx.x, lane = tid & 63, wave = tid >> 6, n = lane & 15, g = lane >> 4;
  const int bh = item >> 1, half = item & 1, b = bh >> 2, h = bh & 3;
  const int s = half * 4 + wave;
  const float* glast = (const float*)(p.ws + WS_GLAST) + (size_t)bh * 64;
  u16* ofp = (u16*)(p.ws + WS_X);
  const uint4* fa0 = (const uint4*)(p.ws + WS_FRAG + (size_t)bh * 32 * FRAG_P_BYTES);
  const float4* uf0 = (const float4*)((char*)p.out + YS_UF + (size_t)bh * 32 * UF_P_BYTES);
  const int row00 = b * SEQ;
  uint4* L = (uint4*)smem;
  f32x4 S[8];
#pragma unroll
  for (int dt = 0; dt < 8; ++dt) S[dt] = f32x4{0, 0, 0, 0};
  uint4 PA[NPRE], PB[NPRE], PC[NPRE];
  f32x4 UA[2], UB[2], UC[2];
  float GA = 0.f, GB = 0.f; (void)GA; (void)GB;
  constexpr int TOUCH_AHEAD = 8;
  uint32_t TA = 0, TB = 0, tsink = 0;
#define SEQP_TOUCH(T_, hs_)                                                                     \
  {                                                                                             \
    tsink ^= T_;                                                                                \
    const int ht_ = (hs_) + TOUCH_AHEAD;                                                        \
    if (ht_ < NH) {                                                                             \
      const int c64_ = ht_ >> 1, hf_ = ht_ & 1;                                                 \
      const uint32_t* fl_ = (const uint32_t*)(fa0 + (size_t)c64_ * (FRAG_P_BYTES / 16) + hf_ * NV);  \
      const uint32_t* ul_ = (const uint32_t*)(uf0 + (size_t)c64_ * (UF_P_BYTES / 16));            \
      uint32_t t0_ = (tid < 208) ? fl_[tid * 32] : 0u;                                          \
      uint32_t t1_ = (tid < 64) ? ul_[(((half * 4 + (tid >> 4)) * 4 + 2 * hf_ + ((tid >> 3) & 1)) * 64) * 4 + (tid & 7) * 32] : 0u; \
      T_ = t0_ ^ t1_;                                                                           \
    }                                                                                           \
  }
#define SEQP_LOAD(P_, U_, G_, hs_)                                                              \
  {                                                                                             \
    const int c64_ = (hs_) >> 1, hf_ = (hs_) & 1;                                               \
    const uint4* fa_ = fa0 + (size_t)c64_ * (FRAG_P_BYTES / 16) + hf_ * NV;                     \
    _Pragma("unroll") for (int q = 0; q < NPRE; ++q) {                                          \
      int idx = tid + q * 256;                                                                  \
      P_[q] = (idx < NV) ? fa_[idx] : make_uint4(0, 0, 0, 0);                                   \
    }                                                                                           \
    const float4* uf_ = uf0 + (size_t)c64_ * (UF_P_BYTES / 16);                                 \
    _Pragma("unroll") for (int mt = 0; mt < 2; ++mt) {                                          \
      float4 t = uf_[(s * 4 + 2 * hf_ + mt) * 64 + lane];                                       \
      U_[mt] = f32x4{t.x, t.y, t.z, t.w};                                                       \
    }                                                                                           \
  }
#define SEQP_STEP(P_, U_, G_, T_, hs_, buf_)                                                        \
  {                                                                                             \
    uint4* Lb = L + (buf_) * NV;                                                                \
    _Pragma("unroll") for (int q = 0; q < NPRE; ++q) {                                          \
      int idx = tid + q * 256;                                                                  \
      if (idx < NV) Lb[idx] = P_[q];                                                            \
    }                                                                                           \
    f32x4 accV[2], accO[2];                                                                     \
    accV[0] = U_[0]; accV[1] = U_[1];                                                           \
    accO[0] = f32x4{0, 0, 0, 0}; accO[1] = f32x4{0, 0, 0, 0};                                   \
    __syncthreads();                                                                            \
    const float gl = gls[(hs_)];                                                                \
    if ((hs_) + 3 < NH) SEQP_LOAD(P_, U_, G_, (hs_) + 3)                                        \
    bf16x8 Sb[4];                                                                               \
    _Pragma("unroll") for (int ks = 0; ks < 4; ++ks)                                            \
      Sb[ks] = mk8(pack2(S[2 * ks][0], S[2 * ks][1]), pack2(S[2 * ks][2], S[2 * ks][3]),        \
                   pack2(S[2 * ks + 1][0], S[2 * ks + 1][1]), pack2(S[2 * ks + 1][2], S[2 * ks + 1][3])); \
    _Pragma("unroll") for (int mt = 0; mt < 2; ++mt)                                            \
      _Pragma("unroll") for (int ks = 0; ks < 4; ++ks) {                                        \
        accV[mt] = MFMA(u4_to_b8(Lb[(W_OFF + mt * 4 + ks) * 64 + lane]), Sb[ks], accV[mt]);     \
        accO[mt] = MFMA(u4_to_b8(Lb[(Q_OFF + mt * 4 + ks) * 64 + lane]), Sb[ks], accO[mt]);     \
      }                                                                                         \
    __builtin_amdgcn_sched_barrier(0);                                                          \
    bf16x8 Vb = mk8(pack2(accV[0][0], accV[0][1]), pack2(accV[0][2], accV[0][3]),               \
                    pack2(accV[1][0], accV[1][1]), pack2(accV[1][2], accV[1][3]));              \
    _Pragma("unroll") for (int mt = 0; mt < 2; ++mt)                                            \
      accO[mt] = MFMA(u4_to_b8(Lb[(QK_OFF + mt) * 64 + lane]), Vb, accO[mt]);                   \
    _Pragma("unroll") for (int dt = 0; dt < 8; ++dt) {                                          \
      S[dt] = S[dt] * gl;                                                                       \
      S[dt] = MFMA(u4_to_b8(Lb[(KD_OFF + dt) * 64 + lane]), Vb, S[dt]);                         \
    }                                                                                           \
    const int rowc = row00 + (hs_) * 32;                                                        \
    _Pragma("unroll") for (int mt = 0; mt < 2; ++mt)                                            \
      _Pragma("unroll") for (int r = 0; r < 4; ++r)                                             \
        ofp[(size_t)(rowc + 16 * mt + 4 * g + r) * 512 + h * 128 + 16 * s + n] = f2bf(accO[mt][r]);   \
  }
  __syncthreads();
  float* gls = (float*)(smem + 2 * NV * 16);
  if (tid < 64) gls[tid] = glast[tid];
  SEQP_LOAD(PA, UA, GA, 0)
  SEQP_LOAD(PB, UB, GB, 1)
  SEQP_LOAD(PC, UC, GA, 2)
#pragma unroll 1
  for (int hs = 0; hs < NH - 1; hs += 3) {
    SEQP_STEP(PA, UA, GA, TA, hs, (hs & 1))
    SEQP_STEP(PB, UB, GB, TB, hs + 1, ((hs + 1) & 1))
    SEQP_STEP(PC, UC, GA, TA, hs + 2, (hs & 1))
  }
  SEQP_STEP(PA, UA, GA, TA, NH - 1, ((NH - 1) & 1))
  float* so = p.out + O_NSP + (size_t)bh * 16384;
#pragma unroll
  for (int dt = 0; dt < 8; ++dt)
#pragma unroll
    for (int r = 0; r < 4; ++r) so[(16 * dt + 4 * g + r) * 128 + 16 * s + n] = S[dt][r];
  __syncthreads();
}

template <int MH>
__device__ __forceinline__ void g2_tile(const Params& p, int m0, int n0, char* smem) {
  const u16* cact = (const u16*)((const char*)p.out + YS_CACT);
  const u16* pw = (const u16*)(p.ws + WS_PW);
  const u16* proj = (const u16*)(p.ws + WS_PROJ);
  u16* cmix = (u16*)(p.ws + WS_CMIX);
  f32x4 acc[4][4];
#pragma unroll
  for (int i = 0; i < 4; ++i)
#pragma unroll
    for (int j = 0; j < 4; ++j) acc[i][j] = f32x4{0, 0, 0, 0};
  gemm128<false, MH>(cact + (size_t)m0 * 512, 512, pw + (size_t)n0 * 512, 512, 512, smem, acc);
  uint2 gpre[4][4];
  GEMM_EPILOGUE_M(acc, m0, n0, MH, { (void)v; gpre[mt][nt] = *(const uint2*)(proj + (size_t)row * DPJ + C_GATE + col); })
  GEMM_EPILOGUE_M(acc, m0, n0, MH, {
    uint2 gv = gpre[mt][nt];
    float o0 = v[0] * siluf_(bflo(gv.x)), o1 = v[1] * siluf_(bfhi(gv.x));
    float o2 = v[2] * siluf_(bflo(gv.y)), o3 = v[3] * siluf_(bfhi(gv.y));
    *(uint2*)(cmix + (size_t)row * 512 + col) = make_uint2(pack2(o0, o1), pack2(o2, o3));
  })
}


__device__ __forceinline__ void phase4(const Params& p, int bid, int nb, char* smem) {
  const int nfull4 = (544 / nb) * nb, rem4 = 544 - nfull4;
  const int nhalf4 = (2 * rem4 <= nb) ? 2 * rem4 : 0;
#pragma unroll 1
  for (int it = bid; it < (nhalf4 > 0 ? nfull4 : 544); it += nb) g2_tile<4>(p, (it >> 2) * 128, (it & 3) * 128, smem);
  if (bid < nhalf4) {
    const int it = nfull4 + (bid >> 1);
    g2_tile<2>(p, (it >> 2) * 128 + (bid & 1) * 64, (it & 3) * 128, smem);
  }
  const int tid = threadIdx.x, lane = tid & 63, wave = tid >> 6;
  const u16* ofp = (const u16*)(p.ws + WS_X);
  const u16* proj = (const u16*)(p.ws + WS_PROJ);
  u16* omix = (u16*)(p.ws + WS_OMIX);
  const int nheavy4 = nhalf4 > 0 ? nhalf4 : ((544 > nb && 544 < 2 * nb) ? 544 - nb : 0);
  if (bid < nheavy4) return;
  const int ob = bid - nheavy4, onb = nb - nheavy4;
  for (int row = ob * 4 + wave; row < NT; row += onb * 4) {
    const uint4 ov = *(const uint4*)(ofp + (size_t)row * 512 + lane * 8);
    float o[8] = {bflo(ov.x), bfhi(ov.x), bflo(ov.y), bfhi(ov.y), bflo(ov.z), bfhi(ov.z), bflo(ov.w), bfhi(ov.w)};
    float ss = 0.f;
#pragma unroll
    for (int e = 0; e < 8; ++e) ss += o[e] * o[e];
    ss += __shfl_xor(ss, 1); ss += __shfl_xor(ss, 2); ss += __shfl_xor(ss, 4); ss += __shfl_xor(ss, 8);
    float r = rsqrtf(ss * (1.f / 128.f) + EPS);
    uint4 zv = *(const uint4*)(proj + (size_t)row * DPJ + C_Z + lane * 8);
    float z[8] = {bflo(zv.x), bfhi(zv.x), bflo(zv.y), bfhi(zv.y), bflo(zv.z), bfhi(zv.z), bflo(zv.w), bfhi(zv.w)};
    float4 g0 = *(const float4*)(p.dn_norm_g + (lane & 15) * 8), g1 = *(const float4*)(p.dn_norm_g + (lane & 15) * 8 + 4);
    float gg[8] = {g0.x, g0.y, g0.z, g0.w, g1.x, g1.y, g1.z, g1.w};
    float y[8];
#pragma unroll
    for (int e = 0; e < 8; ++e) y[e] = o[e] * r * gg[e] * siluf_(z[e]);
    *(uint4*)(omix + (size_t)row * 512 + lane * 8) = make_uint4(pack2(y[0], y[1]), pack2(y[2], y[3]), pack2(y[4], y[5]), pack2(y[6], y[7]));
  }
}

__device__ __forceinline__ void ple_tile(const Params& p, int t, char* smem) {
  const u16* pb = (const u16*)(p.ws + WS_PB2);
  const u16* pp = (const u16*)(p.ws + WS_PPROJ);
  u16* pl = (u16*)(p.ws + WS_PL);
  int m0 = (t >> 3) * 128, n0 = (t & 7) * 128;
  f32x4 acc[4][4];
#pragma unroll
  for (int i = 0; i < 4; ++i)
#pragma unroll
    for (int j = 0; j < 4; ++j) acc[i][j] = f32x4{0, 0, 0, 0};
  gemm128<false>(pb + (size_t)m0 * 256, 256, pp + (size_t)n0 * 256, 256, 256, smem, acc);
  GEMM_EPILOGUE(acc, m0, n0, {
    *(uint2*)(pl + (size_t)row * 1024 + col) = make_uint2(pack2(v[0], v[1]), pack2(v[2], v[3]));
  })
}

template <int MH>
__device__ __forceinline__ void g3_unit(const Params& p, int m0, int n0, char* smem, bool do_atomic) {
  const u16* cmix = (const u16*)(p.ws + WS_CMIX);
  const u16* omix = (const u16*)(p.ws + WS_OMIX);
  const u16* wo = (const u16*)(p.ws + WS_WOUT);
  u16* x1b = (u16*)(p.ws + WS_X);
  float* ss2 = (float*)(p.ws + WS_SS2);
  float* y = p.out + O_Y;
  f32x4 acc[4][4];
#pragma unroll
  for (int i = 0; i < 4; ++i)
#pragma unroll
    for (int j = 0; j < 4; ++j) acc[i][j] = f32x4{0, 0, 0, 0};
  gemm128<false, MH>(cmix + (size_t)m0 * 512, 512, wo + (size_t)n0 * 1024, 1024, 512, smem, acc);
  gemm128<false, MH>(omix + (size_t)m0 * 512, 512, wo + (size_t)n0 * 1024 + 512, 1024, 512, smem, acc);
  float rs[4] = {0, 0, 0, 0};
  float4 xpre[4][4];
  GEMM_EPILOGUE_M(acc, m0, n0, MH, { (void)v; xpre[mt][nt] = *(const float4*)(xrow(p, row) + col); })
  GEMM_EPILOGUE_M(acc, m0, n0, MH, {
    float4 xv = xpre[mt][nt];
    float o0 = xv.x + v[0], o1 = xv.y + v[1], o2 = xv.z + v[2], o3 = xv.w + v[3];
    *(uint2*)(x1b + (size_t)row * 1024 + col) = make_uint2(pack2(o0, o1), pack2(o2, o3));
    rs[mt] += o0 * o0 + o1 * o1 + o2 * o2 + o3 * o3;
  })
  {
    const int lane = threadIdx.x & 63, wave = threadIdx.x >> 6;
#pragma unroll
    for (int mt = 0; mt < MH; ++mt) {
      float sq = rs[mt];
      sq += __shfl_xor(sq, 16); sq += __shfl_xor(sq, 32);
      if (lane < 16 && do_atomic) atomicAdd(&ss2[m0 + (wave >> 1) * (16 * MH) + mt * 16 + lane], sq);
    }
  }
}

template <int MH>
__device__ __forceinline__ void g4_unit(const Params& p, int m0, int n0, char* smem, bool do_atomic) {
  const u16* x1b = (const u16*)(p.ws + WS_X);
  const u16* pl = (const u16*)(p.ws + WS_PL);
  const u16* gt = (const u16*)(p.ws + WS_GATE);
  const float* ss2 = (const float*)(p.ws + WS_SS2);
  float* ss3 = (float*)(p.ws + WS_SS3);
  const float* y = p.out + O_Y;
  u16* x2b = (u16*)(p.ws + WS_X2B);
  f32x4 acc[4][4];
#pragma unroll
  for (int i = 0; i < 4; ++i)
#pragma unroll
    for (int j = 0; j < 4; ++j) acc[i][j] = f32x4{0, 0, 0, 0};
  gemm128<false, MH>(x1b + (size_t)m0 * 1024, 1024, gt + (size_t)n0 * 1024, 1024, 1024, smem, acc);
  float rs[4] = {0, 0, 0, 0};
  uint2 ypre[4][4];
  uint2 ppre[4][4];
  float r2pre[4];
  GEMM_EPILOGUE_M(acc, m0, n0, MH, {
    (void)v;
    ypre[mt][nt] = *(const uint2*)(x1b + (size_t)row * 1024 + col);
    ppre[mt][nt] = *(const uint2*)(pl + (size_t)row * 1024 + col);
    if (nt == 0) r2pre[mt] = ss2[row];
  })
  GEMM_EPILOGUE_M(acc, m0, n0, MH, {
    float r2 = rsqrtf(r2pre[mt] * (1.f / 1024.f) + EPS);
    uint2 xv = ypre[mt][nt];
    uint2 pv = ppre[mt][nt];
    float o0 = bflo(xv.x) + sigmoidf_(v[0] * r2) * bflo(pv.x), o1 = bfhi(xv.x) + sigmoidf_(v[1] * r2) * bfhi(pv.x);
    float o2 = bflo(xv.y) + sigmoidf_(v[2] * r2) * bflo(pv.y), o3 = bfhi(xv.y) + sigmoidf_(v[3] * r2) * bfhi(pv.y);
    *(uint2*)(x2b + (size_t)row * 1024 + col) = make_uint2(pack2(o0, o1), pack2(o2, o3));
    rs[mt] += o0 * o0 + o1 * o1 + o2 * o2 + o3 * o3;
  })
  {
    const int lane = threadIdx.x & 63, wave = threadIdx.x >> 6;
#pragma unroll
    for (int mt = 0; mt < MH; ++mt) {
      float sq = rs[mt];
      sq += __shfl_xor(sq, 16); sq += __shfl_xor(sq, 32);
      if (lane < 16 && do_atomic) atomicAdd(&ss3[m0 + (wave >> 1) * (16 * MH) + mt * 16 + lane], sq);
    }
  }
}

template <int G>
__device__ __forceinline__ void g34_tiles(const Params& p, int bid, int nb, char* smem, bool do_atomic, bool& heavy, int& nlight, int& lidx) {
  const TileWalk tw = tile_walk(8, bid, nb);
  heavy = false; nlight = nb; lidx = bid;
  if (tw.banded && tw.total > tw.step) {
    const int nfull = (tw.total / tw.step) * tw.step, rem = tw.total - nfull;
#pragma unroll 1
    for (int t = tw.q; t < nfull; t += tw.step) {
      int mt_, nt_;
      tile_get(tw, t, mt_, nt_);
      if (G == 0) g3_unit<4>(p, mt_ * 128, nt_ * 128, smem, do_atomic); else g4_unit<4>(p, mt_ * 128, nt_ * 128, smem, do_atomic);
    }
    const int nhalf = 2 * rem <= tw.step ? 2 * rem : 0;
    if (nhalf > 0) {
      if (tw.q < nhalf) {
        int mt_, nt_;
        tile_get(tw, nfull + (tw.q >> 1), mt_, nt_);
        const int m0 = mt_ * 128 + (tw.q & 1) * 64;
        if (G == 0) g3_unit<2>(p, m0, nt_ * 128, smem, do_atomic); else g4_unit<2>(p, m0, nt_ * 128, smem, do_atomic);
        heavy = true;
      }
      nlight = (tw.step - nhalf) * 8; lidx = (tw.q - nhalf) * 8 + (bid & 7);
    } else {
#pragma unroll 1
      for (int t = nfull + tw.q; t < tw.total; t += tw.step) {
        int mt_, nt_;
        tile_get(tw, t, mt_, nt_);
        if (G == 0) g3_unit<4>(p, mt_ * 128, nt_ * 128, smem, do_atomic); else g4_unit<4>(p, mt_ * 128, nt_ * 128, smem, do_atomic);
      }
    }
  } else {
#pragma unroll 1
    for (int t = tw.q; t < tw.total; t += tw.step) {
      int mt_, nt_;
      tile_get(tw, t, mt_, nt_);
      if (G == 0) g3_unit<4>(p, mt_ * 128, nt_ * 128, smem, do_atomic); else g4_unit<4>(p, mt_ * 128, nt_ * 128, smem, do_atomic);
    }
  }
}
__device__ __forceinline__ void phase5(const Params& p, int bid, int nb, char* smem, bool do_atomic = true) {
  bool heavy; int nlight, lidx;
  g34_tiles<0>(p, bid, nb, smem, do_atomic, heavy, nlight, lidx);
  if (do_atomic && !heavy) {
#pragma unroll 1
    for (int it = lidx; it < 1088; it += nlight) ple_tile(p, it, smem);
  }
}
__device__ __forceinline__ void phase6(const Params& p, int bid, int nb, char* smem, bool do_atomic = true) {
  bool heavy; int nlight, lidx;
  g34_tiles<1>(p, bid, nb, smem, do_atomic, heavy, nlight, lidx);
}

__device__ __forceinline__ void phase7(const Params& p, int bid, int nb) {
  const int tid = threadIdx.x;
  const float* ss3 = (const float*)(p.ws + WS_SS3);
  const u16* x2b = (const u16*)(p.ws + WS_X2B);
  float* y = p.out + O_Y;
  for (size_t i = (size_t)bid * 256 + tid; i < (size_t)NT * 128; i += (size_t)nb * 256) {
    const int row = (int)(i >> 7), c = (int)(i & 127) * 8;
    const float r = rsqrtf(ss3[row] * (1.f / 1024.f) + EPS);
    const uint4 v = *(const uint4*)(x2b + (size_t)row * 1024 + c);
    const float4 g0 = *(const float4*)(p.final_norm_g + c), g1 = *(const float4*)(p.final_norm_g + c + 4);
    *(float4*)(y + (size_t)row * 1024 + c) = make_float4(bflo(v.x) * r * g0.x, bfhi(v.x) * r * g0.y, bflo(v.y) * r * g0.z, bfhi(v.y) * r * g0.w);
    *(float4*)(y + (size_t)row * 1024 + c + 4) = make_float4(bflo(v.z) * r * g1.x, bfhi(v.z) * r * g1.y, bflo(v.w) * r * g1.z, bfhi(v.w) * r * g1.w);
  }
}

__device__ __forceinline__ void phase2(const Params& p, int bid, int nb, char* smem) {
#pragma unroll 1
  for (int it = bid; it < 1024; it += nb) delta_prep<false>(p, it, smem);
}
__device__ __forceinline__ void phase3(const Params& p, int bid, int nb, char* smem) {
  if (nb >= 128) {
    if (bid < 64) { delta_seq_p(p, bid, smem); return; }
    bid -= 64; nb -= 64;
  } else {
    for (int it = bid; it < 64; it += nb) delta_seq_p(p, it, smem);
  }
#pragma unroll 1
  for (int it = bid; it < 512; it += nb) conv_tile<false>(p, it, smem);
#pragma unroll 1
  for (int it = nb - 1 - bid; it < 128; it += nb) conv_tile<true>(p, it, smem);
#pragma unroll 1
  for (int it = bid; it < 512; it += nb) {
    delta_prep<true>(p, it, smem);
    __threadfence_block();
    __syncthreads();
#pragma unroll 1
    for (int hf = 0; hf < 2; ++hf) delta_seq<true>(p, 2 * it + hf, smem);
  }
}

#define XB_TMO      128
#define XB_XCNT(j)  (256  + 64 * (j))
#define XB_XSUB(j)  (1280 + 64 * (j))
#define XB_XGEN(j)  (2304 + 64 * (j))
#define XB_TOP      3328
#define XB_TOPGEN   3392
#define XCD_BAR_WORDS 3456
#define XB_SPIN_CAP (1u << 22)
__device__ __forceinline__ unsigned xb_ld(unsigned* p) { return __hip_atomic_load(p, __ATOMIC_RELAXED, __HIP_MEMORY_SCOPE_AGENT); }
__device__ __forceinline__ unsigned xb_add(unsigned* p, unsigned v) { return __hip_atomic_fetch_add(p, v, __ATOMIC_RELAXED, __HIP_MEMORY_SCOPE_AGENT); }
__device__ __forceinline__ unsigned xb_xcc_id() { return (unsigned)__builtin_amdgcn_s_getreg((3 << 11) | 20) & 0xFu; }
#define XB_SPIN(cond, bar) do { unsigned _sp = 0; while (cond) { __builtin_amdgcn_s_sleep(1); \
    if ((++_sp & 255u) == 0u) { if (xb_ld(&(bar)[XB_TMO])) break; if (_sp > XB_SPIN_CAP) { atomicAdd(&(bar)[XB_TMO], 1u); break; } } } } while (0)
struct XcdBarrier { unsigned* bar; unsigned x; unsigned nloc; unsigned nx; };
__device__ __forceinline__ void xcd_barrier_complete(unsigned* bar, unsigned x, unsigned& nloc, unsigned& nx) {
  const unsigned G = gridDim.x;
  unsigned sum, cnt, mine, sp = 0u;
  for (;;) {
    sum = 0u; cnt = 0u; mine = 0u;
#pragma unroll
    for (unsigned j = 0; j < 16; ++j) { const unsigned c = xb_ld(&bar[XB_XCNT(j)]); sum += c; cnt += (c > 0u) ? 1u : 0u; mine = (j == x) ? c : mine; }
    if (sum == G) break;
    __builtin_amdgcn_s_sleep(1);
    if ((++sp & 255u) == 0u) { if (xb_ld(&bar[XB_TMO])) break; if (sp > XB_SPIN_CAP) { atomicAdd(&bar[XB_TMO], 1u); break; } }
  }
  nloc = mine > 0u ? mine : 1u; nx = cnt > 0u ? cnt : 1u;
}
__device__ __forceinline__ void xcd_barrier(XcdBarrier& b) {
  asm volatile("s_waitcnt vmcnt(0)" ::: "memory");
  __syncthreads();
  if (threadIdx.x == 0) {
    unsigned* bar = b.bar;
    __builtin_amdgcn_s_waitcnt(0);
    if (b.nloc == 0u) xcd_barrier_complete(bar, b.x, b.nloc, b.nx);
    const unsigned nloc = b.nloc, nx = b.nx;
    const unsigned old = xb_add(&bar[XB_XSUB(b.x)], 1u);
    const unsigned gen = old / nloc;
    if (old + 1u == (gen + 1u) * nloc) {
      __builtin_amdgcn_fence(__ATOMIC_RELEASE, "agent");
      asm volatile("s_waitcnt vmcnt(0)" ::: "memory");
      const unsigned og = xb_add(&bar[XB_TOP], 1u);
      const unsigned tg = og / nx;
      if (og + 1u == (tg + 1u) * nx) xb_add(&bar[XB_TOPGEN], 1u);
      else XB_SPIN(xb_ld(&bar[XB_TOPGEN]) == tg, bar);
      __builtin_amdgcn_fence(__ATOMIC_ACQUIRE, "agent");
      xb_add(&bar[XB_XGEN(b.x)], 1u);
      asm volatile("s_waitcnt vmcnt(0)" ::: "memory");
    } else {
      XB_SPIN(xb_ld(&bar[XB_XGEN(b.x)]) == gen, bar);
      __builtin_amdgcn_fence(__ATOMIC_ACQUIRE, "agent");
      asm volatile("s_waitcnt vmcnt(0)" ::: "memory");
    }
  }
  __syncthreads();
}

template <int MODE>
__global__ void __launch_bounds__(256, 2) mega(Params p) {
  __shared__ __attribute__((aligned(16))) char smem[65536];
  const int bid = blockIdx.x, nb = gridDim.x;
  if (MODE < 0) {
    XcdBarrier gb;
    gb.bar = (unsigned*)(p.ws + WS_BAR); gb.x = xb_xcc_id(); gb.nloc = 0u; gb.nx = 0u;
    if (threadIdx.x == 0) (void)xb_add(&gb.bar[XB_XCNT(gb.x)], 1u);
    phase0(p, bid, nb, smem); xcd_barrier(gb);
    if (PROBE_DUP == 0) { phase0(p, bid, nb, smem); xcd_barrier(gb); }
    phase1(p, bid, nb, smem); xcd_barrier(gb);
    if (PROBE_DUP == 1) { phase1(p, bid, nb, smem); xcd_barrier(gb); }
    phase2(p, bid, nb, smem); xcd_barrier(gb);
    if (PROBE_DUP == 2) { phase2(p, bid, nb, smem); xcd_barrier(gb); }
    phase3(p, bid, nb, smem); xcd_barrier(gb);
    if (PROBE_DUP == 3) { phase3(p, bid, nb, smem); xcd_barrier(gb); }
    phase4(p, bid, nb, smem); xcd_barrier(gb);
    if (PROBE_DUP == 4) { phase4(p, bid, nb, smem); xcd_barrier(gb); }
    if (PROBE_DUP == 11) { phase5(p, bid, nb, smem, false); xcd_barrier(gb); }
    phase5(p, bid, nb, smem); xcd_barrier(gb);
    phase6(p, bid, nb, smem); xcd_barrier(gb);
    phase7(p, bid, nb);
  } else {
    if (MODE == 0) phase0(p, bid, nb, smem);
    if (MODE == 1) phase1(p, bid, nb, smem);
    if (MODE == 2) phase2(p, bid, nb, smem);
    if (MODE == 3) phase3(p, bid, nb, smem);
    if (MODE == 4) phase4(p, bid, nb, smem);
    if (MODE == 5) phase5(p, bid, nb, smem);
    if (MODE == 6) phase6(p, bid, nb, smem);
    if (MODE == 7) phase7(p, bid, nb);
  }
}

extern "C" void kernel_launch(void* const* d_in, const int* in_sizes, int n_in, void* d_out, int out_size, void* d_ws,
                              size_t ws_size, hipStream_t stream) {
  if (ws_size < WS_END) { fprintf(stderr, "workspace too small: %zu < %zu\n", ws_size, (size_t)WS_END); return; }
  static int grid = 0;
  if (grid == 0) {
    int dev = 0, cus = 0, per_cu = 0;
    hipGetDevice(&dev);
    hipDeviceGetAttribute(&cus, hipDeviceAttributeMultiprocessorCount, dev);
    hipOccupancyMaxActiveBlocksPerMultiprocessor(&per_cu, (const void*)mega<-1>, 256, 0);
    if (per_cu > 2) per_cu = 2;
    if (per_cu < 1 || cus < 1) { fprintf(stderr, "occupancy query failed (%d, %d)\n", cus, per_cu); grid = -1; return; }
    grid = cus * per_cu;
  }
  if (grid < 0) return;
  Params p{};
  const float** f = (const float**)&p;
  for (int i = 0; i < 23; ++i) f[i] = (const float*)d_in[i];
  p.out = (float*)d_out;
  p.ws = (char*)d_ws;
  hipMemsetAsync((char*)d_ws + WS_BAR, 0, XCD_BAR_WORDS * 4, stream);
  void* args[] = {&p};
  hipError_t e = hipLaunchCooperativeKernel((const void*)mega<-1>, dim3(grid), dim3(256), args, 0, stream);
  if (e != hipSuccess) fprintf(stderr, "cooperative launch failed: %s (grid %d)\n", hipGetErrorString(e), grid);
}
```
